# Optimizing an MI355X kernel written in HIP

```python
import math
import jax, jax.numpy as jnp
from jax import lax
import numpy as np

D_MODEL = 1024
BATCH = 8
SEQ = 4096
DEPTH = 1
DEC_BATCH = 8
DEC_SEQ = 8192
PAST_LEN = 128

CHUNK = 128
SGU_WIDTH = D_MODEL
SGU_GROUPS = 8
SGU_GROUP_DIM = SGU_WIDTH // SGU_GROUPS
N_HEADS = 8
N_KV_HEADS = 2
HEAD_DIM = D_MODEL // N_HEADS
Q_PER_KV = N_HEADS // N_KV_HEADS
WINDOW = 128
BLOCK = 128
N_BUCKETS = 32
MAX_DISTANCE = 128
D_FF = 4 * D_MODEL
EPS = 1e-6
NEG_INF = -1e30
SPLITS = [SGU_WIDTH,
          2 * SGU_WIDTH,
          2 * SGU_WIDTH + N_HEADS * HEAD_DIM,
          2 * SGU_WIDTH + (N_HEADS + N_KV_HEADS) * HEAD_DIM,
          2 * SGU_WIDTH + (N_HEADS + 2 * N_KV_HEADS) * HEAD_DIM,
          2 * SGU_WIDTH + (N_HEADS + 2 * N_KV_HEADS) * HEAD_DIM + D_MODEL]
IN_COLS = SPLITS[-1] + D_MODEL

kernel_name = "hybrid_sgu_window_gqa_encoder"


def rms_norm(x, g):
    xf = x.astype(jnp.float32)
    y = xf * lax.rsqrt(jnp.mean(xf * xf, axis=-1, keepdims=True) + EPS)
    return (y * g.astype(jnp.float32)).astype(x.dtype)


def t5_bucket(rel):
    nb = N_BUCKETS // 2
    max_exact = nb // 2
    ret = jnp.where(rel > 0, nb, 0)
    n = jnp.abs(rel)
    nf = jnp.maximum(n, 1).astype(jnp.float32)
    large = max_exact + (jnp.log(nf / max_exact) / math.log(MAX_DISTANCE / max_exact)
                         * (nb - max_exact)).astype(jnp.int32)
    large = jnp.minimum(large, nb - 1)
    return ret + jnp.where(n < max_exact, n, large)


def sgu_mixer(u, v, g_norm, w_s, b_s):
    B, S, _ = u.shape
    u = jax.nn.gelu(u)
    v = rms_norm(jax.nn.gelu(v), g_norm)
    vc = v.reshape(B, S // CHUNK, CHUNK, SGU_GROUPS, SGU_GROUP_DIM)
    mixed = jnp.einsum('gpq,bnqgc->bnpgc', w_s, vc) + b_s.T[None, None, :, :, None]
    return u * mixed.reshape(B, S, SGU_WIDTH)


def band_blocks(t):
    B, S, K, D = t.shape
    nblk = S // BLOCK
    tp = jnp.pad(t, ((0, 0), (BLOCK, BLOCK), (0, 0), (0, 0))).reshape(B, nblk + 2, BLOCK, K, D)
    return jnp.concatenate([tp[:, :-2], tp[:, 1:-1], tp[:, 2:]], axis=2)


def window_attention(q, k, v, q_g, k_g, sink, rel_bias):
    B, S, _ = q.shape
    nblk = S // BLOCK
    q = rms_norm(q.reshape(B, S, N_HEADS, HEAD_DIM), q_g)
    k = rms_norm(k.reshape(B, S, N_KV_HEADS, HEAD_DIM), k_g)
    v = v.reshape(B, S, N_KV_HEADS, HEAD_DIM)
    qb = q.reshape(B, nblk, BLOCK, N_KV_HEADS, Q_PER_KV, HEAD_DIM)
    kb = band_blocks(k)
    vb = band_blocks(v)
    s = jnp.einsum('bnpkgd,bnrkd->bnkgpr', qb, kb).astype(jnp.float32) * (HEAD_DIM ** -0.5)
    p_idx = jnp.arange(BLOCK, dtype=jnp.int32)[:, None]
    r_idx = jnp.arange(3 * BLOCK, dtype=jnp.int32)[None, :]
    rel = r_idx - BLOCK - p_idx
    bias = rel_bias.astype(jnp.float32)[t5_bucket(rel)]
    bias = jnp.transpose(bias, (2, 0, 1)).reshape(N_KV_HEADS, Q_PER_KV, BLOCK, 3 * BLOCK)
    in_window = jnp.abs(rel) <= WINDOW
    key_pos = (jnp.arange(nblk, dtype=jnp.int32)[:, None] - 1) * BLOCK + r_idx
    in_range = (key_pos >= 0) & (key_pos < S)
    mask = in_window[None, :, :] & in_range[:, None, :]
    s = jnp.where(mask[None, :, None, None, :, :], s + bias[None, None], NEG_INF)
    sink_l = sink.astype(jnp.float32).reshape(N_KV_HEADS, Q_PER_KV)[None, None, :, :, None, None]
    m = jnp.maximum(jnp.max(s, axis=-1, keepdims=True), sink_l)
    e = jnp.exp(s - m)
    probs = e / (jnp.sum(e, axis=-1, keepdims=True) + jnp.exp(sink_l - m))
    o = jnp.einsum('bnkgpr,bnrkd->bnpkgd', probs.astype(vb.dtype), vb)
    return o.reshape(B, S, N_HEADS * HEAD_DIM)


def encoder_layer(x, rel_bias, norm1_g, w_in, sgu_g, w_s, b_s, q_g, k_g, sink, w_o,
                  norm2_g, w_ff1, w_ff2):
    h = rms_norm(x, norm1_g)
    z = h @ w_in
    u, v, q, k, vv, ga, gb = jnp.split(z, SPLITS, axis=-1)
    ya = sgu_mixer(u, v, sgu_g, w_s, b_s)
    yb = window_attention(q, k, vv, q_g, k_g, sink, rel_bias)
    merged = jax.nn.sigmoid(ga) * ya + jax.nn.sigmoid(gb) * yb
    x = x + merged @ w_o
    h2 = rms_norm(x, norm2_g)
    return x + jnp.square(jax.nn.relu(h2 @ w_ff1)) @ w_ff2


def setup_inputs(seed: int = 0) -> dict:
    key = jax.random.key(seed)
    ks = jax.random.split(key, 16)
    f32 = jnp.float32
    nrm = lambda k, shape, s: jax.random.normal(k, shape, f32) * s
    return {
        "x_prompt": nrm(ks[0], (BATCH, SEQ, D_MODEL), 1.0),
        "x_sample": nrm(ks[1], (DEC_BATCH, DEC_SEQ, D_MODEL), 1.0),
        "rel_bias": nrm(ks[2], (N_BUCKETS, N_HEADS), 0.5),
        "norm1_g": 1.0 + nrm(ks[3], (DEPTH, D_MODEL), 0.02),
        "w_in": nrm(ks[4], (DEPTH, D_MODEL, IN_COLS), D_MODEL ** -0.5),
        "sgu_norm_g": 1.0 + nrm(ks[5], (DEPTH, SGU_WIDTH), 0.02),
        "w_spatial": nrm(ks[6], (DEPTH, SGU_GROUPS, CHUNK, CHUNK), CHUNK ** -0.5),
        "b_spatial": 1.0 + nrm(ks[7], (DEPTH, SGU_GROUPS, CHUNK), 0.02),
        "q_norm_g": 1.0 + nrm(ks[8], (DEPTH, HEAD_DIM), 0.02),
        "k_norm_g": 1.0 + nrm(ks[9], (DEPTH, HEAD_DIM), 0.02),
        "sink_logit": nrm(ks[10], (DEPTH, N_HEADS), 0.5),
        "w_o": nrm(ks[11], (DEPTH, D_MODEL, D_MODEL), D_MODEL ** -0.5),
        "norm2_g": 1.0 + nrm(ks[12], (DEPTH, D_MODEL), 0.02),
        "w_ff1": nrm(ks[13], (DEPTH, D_MODEL, D_FF), D_MODEL ** -0.5),
        "w_ff2": nrm(ks[14], (DEPTH, D_FF, D_MODEL), D_FF ** -0.5),
    }


def reference(x_prompt, x_sample, rel_bias, norm1_g, w_in, sgu_norm_g, w_spatial, b_spatial,
              q_norm_g, k_norm_g, sink_logit, w_o, norm2_g, w_ff1, w_ff2):
    def trunk(x):
        for l in range(DEPTH):
            x = encoder_layer(x, rel_bias, norm1_g[l], w_in[l], sgu_norm_g[l], w_spatial[l],
                              b_spatial[l], q_norm_g[l], k_norm_g[l], sink_logit[l], w_o[l],
                              norm2_g[l], w_ff1[l], w_ff2[l])
        return x
    y_prompt = trunk(x_prompt)
    y_sample = trunk(x_sample)
    return (y_prompt, y_sample)
```

```cpp
#include <hip/hip_runtime.h>
#include <hip/hip_cooperative_groups.h>
#include <cstdio>
namespace cg = cooperative_groups;

#define LAS __attribute__((address_space(3)))
typedef unsigned short bf16_t;
typedef short bf16x8 __attribute__((ext_vector_type(8)));
typedef float f32x4 __attribute__((ext_vector_type(4)));
typedef float f32x16 __attribute__((ext_vector_type(16)));
typedef unsigned u32x4 __attribute__((ext_vector_type(4)));
typedef unsigned u32x2 __attribute__((ext_vector_type(2)));

#ifndef N_LAUNCHES
#define N_LAUNCHES 1
#endif

constexpr int MP = 8 * 4096, MS = 8 * 8192, MTOK = MP + MS;
constexpr int DM = 1024, NIN = 5632, DFF = 4096;
constexpr float EPS = 1e-6f;
constexpr float LOG2E = 1.4426950408889634f;
constexpr size_t MiB = 1u << 20;
constexpr size_t WS_WT = 0, WS_WOT = 12 * MiB, WS_W1T = 14 * MiB, WS_W2T = 22 * MiB;
constexpr size_t WS_Q = 32 * MiB;
constexpr size_t WS_U = 224 * MiB;
constexpr size_t WS_SA = 416 * MiB, WS_SB = 608 * MiB;
constexpr size_t WS_K = 800 * MiB;
constexpr size_t WS_VT = 848 * MiB;
constexpr size_t WS_HID = 224 * MiB;
constexpr size_t WS_PART = 992 * MiB;
constexpr size_t WS_END = 1000 * MiB;
constexpr size_t DO_H = 0, DO_GVT = 192 * MiB;

constexpr int KT_PITCH = 272, VT_PITCH = 264;
constexpr int R_KT = 0, R_VT = 34816, R_GV = 68608;
constexpr int EX_WAVE = 17408, EX_T2 = 8704;
constexpr int R_TB = 139264, TB_N = 320, R_RSTD = R_TB + 8 * TB_N * 4, R_RED = R_RSTD + 512;
constexpr int LDS_BYTES = 155648;
static_assert(R_RED + 4096 <= LDS_BYTES, "lds map");

__device__ __forceinline__ unsigned cvt_pk_bf16(float lo, float hi) { unsigned r; asm volatile("v_cvt_pk_bf16_f32 %0, %1, %2" : "=v"(r) : "v"(lo), "v"(hi)); return r; }
__device__ __forceinline__ float bf_lo(unsigned w) { return __uint_as_float(w << 16); }
__device__ __forceinline__ float bf_hi(unsigned w) { return __uint_as_float(w & 0xffff0000u); }
__device__ __forceinline__ float gelu_tanh(float x) { const float t = x * (1.0f + 0.044715f * x * x) * (-2.302208198f); return x * __builtin_amdgcn_rcpf(1.0f + __builtin_amdgcn_exp2f(t)); }
__device__ __forceinline__ float sigmoidf(float x) { return __builtin_amdgcn_rcpf(1.0f + __builtin_amdgcn_exp2f(-LOG2E * x)); }

namespace pg8 {
constexpr int BM = 256, BK = 64, HALF = 128, HTB = HALF * BK * 2, STAGE_BYTES = 8 * HTB, NXCD = 8, WGM = 8;
__host__ __device__ __forceinline__ int lds_byte(int r, int c) { const int st = (r >> 4) * 2 + (c >> 5), rr = r & 15, cc = c & 31, ob = rr * 64 + cc * 2; return st * 1024 + (ob ^ (((ob >> 9) & 1) << 5)); }
__host__ __device__ __forceinline__ void stage_rc(int b, int& R, int& C) { const int st = b / 1024, sb = b % 1024, swz = sb ^ (((sb >> 9) & 1) << 5); R = (st >> 1) * 16 + swz / 64; C = (st & 1) * 32 + (swz % 64) / 2; }
__host__ __device__ __forceinline__ int perm32(int rho) { const int n = rho >> 4, i = rho & 15; return 8 * (i >> 2) + 4 * n + (i & 3); }
struct Unit { int pm, pn; };
struct StaticOrder {
    int nM, nN, nwg, G, c;
    __device__ void init(int M, int N, int G_, int c_) { nM = M / BM; nN = N / BM; nwg = nM * nN; G = G_; c = c_; }
    __device__ bool next(int i, Unit& u) const {
        const long L = (long)i * G + c; if (L >= nwg) return false;
        int wgid = (int)L; { const int q = nwg / NXCD, r = nwg % NXCD, xcd = wgid % NXCD, off = wgid / NXCD; wgid = (xcd < r ? xcd * (q + 1) : r * (q + 1) + (xcd - r) * q) + off; }
        const int nig = WGM * nN, gid = wgid / nig, fm = gid * WGM, gsz = (nM - fm) < WGM ? (nM - fm) : WGM;
        u.pm = fm + ((wgid % nig) % gsz); u.pn = (wgid % nig) / gsz; return true;
    }
};
struct PlainPtrs { const bf16_t* A; const bf16_t* Bt; int K;
    __device__ __forceinline__ void get(const Unit& u, const char*& a, const char*& b) const { a = (const char*)A + (size_t)u.pm * 512 * K; b = (const char*)Bt + (size_t)u.pn * 512 * K; } };

template <class Epi, class Ptrs>
__device__ __forceinline__ void gemm_phase(LAS unsigned char* lds, const int K, const StaticOrder& S, const Ptrs& P, const Epi& E) {
    const int tid = threadIdx.x, wid = __builtin_amdgcn_readfirstlane(tid >> 6), lane = tid & 63, wr = wid >> 2, wc = wid & 3, fr = lane & 15, fq = lane >> 4;
    const int nt = K / BK;
    unsigned voffA[2], voffB[2];
#pragma unroll
    for (int i = 0; i < 2; ++i) { int R, C; stage_rc(tid * 16 + i * 8192, R, C); const int Rb = (R & ~31) + perm32(R & 31);
        voffA[i] = (unsigned)(R * K + C) * 2u; voffB[i] = (unsigned)(Rb * K + C) * 2u; }
    const size_t kstep = (size_t)(BK * 2);
    const size_t hstep = (size_t)HALF * K * 2;
    const unsigned ldsw = (unsigned)wid * 1024u;
    const int aoff = lds_byte(wr * 64 + fr, fq * 8), boff = lds_byte(wc * 32 + fr, fq * 8);
#define PG8_SA(b, h) (((b) * 2 + (h)) * HTB)
#define PG8_SB(b, h) ((4 + (b) * 2 + (h)) * HTB)
#define PG8_STAGE(bufoff, gbase, voff) do { _Pragma("unroll") for (int _i = 0; _i < 2; ++_i) \
        __builtin_amdgcn_global_load_lds((const unsigned*)((const char*)(gbase) + (voff)[_i]), (LAS unsigned*)(lds + (bufoff) + ldsw + _i * 8192), 16, 0, 0); } while (0)
#define PG8_LDA(dst, b, h) do { _Pragma("unroll") for (int m = 0; m < 4; ++m) _Pragma("unroll") for (int k = 0; k < 2; ++k) dst[m][k] = *(const LAS bf16x8*)(lds + PG8_SA(b, h) + aoff + m * 2048 + k * 1024); } while (0)
#define PG8_LDB(dst, b, h) do { _Pragma("unroll") for (int n = 0; n < 2; ++n) _Pragma("unroll") for (int k = 0; k < 2; ++k) dst[n][k] = *(const LAS bf16x8*)(lds + PG8_SB(b, h) + boff + n * 2048 + k * 1024); } while (0)
#define PG8_MMA(ai, bj, At, Bt) do { __builtin_amdgcn_s_setprio(1); _Pragma("unroll") for (int m = 0; m < 4; ++m) _Pragma("unroll") for (int n = 0; n < 2; ++n) _Pragma("unroll") for (int k = 0; k < 2; ++k) \
        acc[ai][bj][m][n] = __builtin_amdgcn_mfma_f32_16x16x32_bf16(Bt[n][k], At[m][k], acc[ai][bj][m][n], 0, 0, 0); __builtin_amdgcn_s_setprio(0); } while (0)
#define PG8_WAIT_V(n) asm volatile("s_waitcnt vmcnt(" #n ")" ::: "memory")
#define PG8_WAIT_L(n) asm volatile("s_waitcnt lgkmcnt(" #n ")" ::: "memory")
#define PG8_BAR __builtin_amdgcn_s_barrier()
#define PG8_SCHED __builtin_amdgcn_sched_barrier(0)
    Unit cur, nxt; int ui = 0;
    if (!S.next(0, cur)) return;
    f32x4 acc[2][2][4][2];
#pragma unroll
    for (int a = 0; a < 2; ++a)
#pragma unroll
        for (int b = 0; b < 2; ++b)
#pragma unroll
            for (int m = 0; m < 4; ++m)
#pragma unroll
                for (int n = 0; n < 2; ++n) acc[a][b][m][n] = (f32x4){0.f, 0.f, 0.f, 0.f};
    bf16x8 At[4][2], B0[2][2], B1[2][2];
    const char* cA; const char* cB; P.get(cur, cA, cB);
    PG8_STAGE(PG8_SB(0, 0), cB, voffB); PG8_STAGE(PG8_SA(0, 0), cA, voffA); PG8_STAGE(PG8_SB(0, 1), cB + hstep, voffB); PG8_STAGE(PG8_SA(0, 1), cA + hstep, voffA);
    if (wr == 1) PG8_BAR;
    PG8_WAIT_V(4); PG8_BAR;
    PG8_STAGE(PG8_SB(1, 0), cB + kstep, voffB); PG8_STAGE(PG8_SA(1, 0), cA + kstep, voffA); PG8_STAGE(PG8_SB(1, 1), cB + hstep + kstep, voffB);
    PG8_WAIT_V(6); PG8_BAR;
    for (;;) {
        const bool has_next = S.next(ui + 1, nxt);
        const char* nA = cA; const char* nB = cB; if (has_next) P.get(nxt, nA, nB);
        for (int t = 0; t < nt; t += 2) {
            const bool last = (t == nt - 2);
            const char* a1 = cA + (size_t)(t + 1) * kstep;
            const char* a2 = last ? nA : cA + (size_t)(t + 2) * kstep; const char* b2 = last ? nB : cB + (size_t)(t + 2) * kstep;
            const char* a3 = a2 + kstep; const char* b3 = b2 + kstep;
            PG8_LDB(B0, 0, 0); PG8_SCHED; PG8_LDA(At, 0, 0); PG8_STAGE(PG8_SA(1, 1), a1 + hstep, voffA);
            PG8_WAIT_L(8); PG8_BAR; PG8_WAIT_L(0); PG8_MMA(0, 0, At, B0); PG8_BAR; PG8_SCHED;
            PG8_LDB(B1, 0, 1); PG8_STAGE(PG8_SB(0, 0), b2, voffB);
            PG8_BAR; PG8_WAIT_L(0); PG8_MMA(0, 1, At, B1); PG8_BAR;
            PG8_LDA(At, 0, 1); PG8_STAGE(PG8_SA(0, 0), a2, voffA);
            PG8_BAR; PG8_WAIT_L(0); PG8_MMA(1, 0, At, B0); PG8_BAR; PG8_SCHED;
            PG8_STAGE(PG8_SB(0, 1), b2 + hstep, voffB);
            PG8_WAIT_V(6); PG8_BAR; PG8_MMA(1, 1, At, B1); PG8_BAR;
            PG8_LDB(B0, 1, 0); PG8_SCHED; PG8_LDA(At, 1, 0); PG8_STAGE(PG8_SA(0, 1), a2 + hstep, voffA);
            PG8_WAIT_L(8); PG8_BAR; PG8_WAIT_L(0); PG8_MMA(0, 0, At, B0); PG8_BAR; PG8_SCHED;
            PG8_LDB(B1, 1, 1); PG8_STAGE(PG8_SB(1, 0), b3, voffB);
            PG8_BAR; PG8_WAIT_L(0); PG8_MMA(0, 1, At, B1); PG8_BAR;
            PG8_LDA(At, 1, 1); PG8_STAGE(PG8_SA(1, 0), a3, voffA);
            PG8_BAR; PG8_WAIT_L(0); PG8_MMA(1, 0, At, B0); PG8_BAR; PG8_SCHED;
            PG8_STAGE(PG8_SB(1, 1), b3 + hstep, voffB);
            PG8_WAIT_V(6); PG8_BAR; PG8_MMA(1, 1, At, B1); PG8_BAR;
        }
        E(acc, cur, wr, wc, fr, fq);
        if (!has_next) break;
#pragma unroll
        for (int a = 0; a < 2; ++a)
#pragma unroll
            for (int b = 0; b < 2; ++b)
#pragma unroll
                for (int m = 0; m < 4; ++m)
#pragma unroll
                    for (int n = 0; n < 2; ++n) acc[a][b][m][n] = (f32x4){0.f, 0.f, 0.f, 0.f};
        cur = nxt; cA = nA; cB = nB; ++ui;
    }
    PG8_WAIT_V(0);
    if (wr == 0) PG8_BAR;
    PG8_BAR;
#undef PG8_SA
#undef PG8_SB
#undef PG8_STAGE
#undef PG8_LDA
#undef PG8_LDB
#undef PG8_MMA
#undef PG8_WAIT_V
#undef PG8_WAIT_L
#undef PG8_BAR
#undef PG8_SCHED
}
}
using pg8::Unit;

struct Args { const float* in[15]; float* out; unsigned char* ws; int ph_lo, ph_hi; };
enum { I_XP = 0, I_XS, I_RELB, I_N1G, I_WIN, I_SGUG, I_WS, I_BS, I_QG, I_KG, I_SINK, I_WO, I_N2G, I_W1, I_W2 };

struct P1Ptrs { const bf16_t* H; const bf16_t* Wt;
    __device__ __forceinline__ void get(const Unit& u, const char*& a, const char*& b) const {
        const char* hp = (const char*)H + (size_t)u.pm * 512 * DM; const char* wp = (const char*)Wt + (size_t)u.pn * 512 * DM;
        if (u.pn < 17) { a = hp; b = wp; } else { a = wp; b = hp; } } };
struct EpiP1 {
    unsigned char* ws; unsigned char* dout;
    __device__ __forceinline__ void operator()(const f32x4 (&acc)[2][2][4][2], const Unit& u, int wr, int wc, int fr, int fq) const {
        bf16_t* base; size_t ld; int row0, col0, act;
        const int pn = u.pn;
        if (pn < 4)       { base = (bf16_t*)(ws + WS_U);  ld = DM;  row0 = u.pm * 256; col0 = pn * 256;        act = 1; }
        else if (pn < 8)  { base = (bf16_t*)(ws + WS_Q);  ld = DM;  row0 = u.pm * 256; col0 = (pn - 4) * 256;  act = 0; }
        else if (pn < 9)  { base = (bf16_t*)(ws + WS_K);  ld = 256; row0 = u.pm * 256; col0 = 0;               act = 0; }
        else if (pn < 13) { base = (bf16_t*)(ws + WS_SA); ld = DM;  row0 = u.pm * 256; col0 = (pn - 9) * 256;  act = 2; }
        else if (pn < 17) { base = (bf16_t*)(ws + WS_SB); ld = DM;  row0 = u.pm * 256; col0 = (pn - 13) * 256; act = 2; }
        else if (pn < 21) { base = (bf16_t*)(dout + DO_GVT); ld = MTOK; row0 = (pn - 17) * 256; col0 = u.pm * 256; act = 1; }
        else              { base = (bf16_t*)(ws + WS_VT); ld = MTOK; row0 = 0; col0 = u.pm * 256; act = 0; }
        const int r0 = row0 + wr * 64 + fr, c0 = col0 + wc * 32 + 8 * fq;
#pragma unroll
        for (int ai = 0; ai < 2; ++ai)
#pragma unroll
            for (int m = 0; m < 4; ++m) { bf16_t* rowp = base + (size_t)(r0 + ai * 128 + m * 16) * ld + c0;
#pragma unroll
                for (int bj = 0; bj < 2; ++bj) { f32x4 v0 = acc[ai][bj][m][0], v1 = acc[ai][bj][m][1];
                    if (act == 1) {
#pragma unroll
                        for (int j = 0; j < 4; ++j) { v0[j] = gelu_tanh(v0[j]); v1[j] = gelu_tanh(v1[j]); } }
                    else if (act == 2) {
#pragma unroll
                        for (int j = 0; j < 4; ++j) { v0[j] = sigmoidf(v0[j]); v1[j] = sigmoidf(v1[j]); } }
                    u32x4 w; w.x = cvt_pk_bf16(v0[0], v0[1]); w.y = cvt_pk_bf16(v0[2], v0[3]); w.z = cvt_pk_bf16(v1[0], v1[1]); w.w = cvt_pk_bf16(v1[2], v1[3]);
                    *(u32x4*)(rowp + bj * 128) = w; } }
    }
};
struct EpiWo {
    const float* xp; const float* xs; float* out; bf16_t* xb; float* part;
    __device__ __forceinline__ void operator()(const f32x4 (&acc)[2][2][4][2], const Unit& u, int wr, int wc, int fr, int fq) const {
        const int row0 = u.pm * 256 + wr * 64 + fr, col0 = u.pn * 256 + wc * 32 + 8 * fq;
        const float* xb0 = (u.pm * 256 < MP) ? xp : xs - (size_t)MP * DM;
#pragma unroll
        for (int ai = 0; ai < 2; ++ai)
#pragma unroll
            for (int m = 0; m < 4; ++m) { const int row = row0 + ai * 128 + m * 16; const size_t off = (size_t)row * DM + col0; float ss = 0.f;
#pragma unroll
                for (int bj = 0; bj < 2; ++bj) {
                    const f32x4 x0 = *(const f32x4*)(xb0 + off + bj * 128), x1 = *(const f32x4*)(xb0 + off + bj * 128 + 4);
                    const f32x4 v0 = acc[ai][bj][m][0] + x0, v1 = acc[ai][bj][m][1] + x1;
                    *(f32x4*)(out + off + bj * 128) = v0; *(f32x4*)(out + off + bj * 128 + 4) = v1;
                    u32x4 w; w.x = cvt_pk_bf16(v0[0], v0[1]); w.y = cvt_pk_bf16(v0[2], v0[3]); w.z = cvt_pk_bf16(v1[0], v1[1]); w.w = cvt_pk_bf16(v1[2], v1[3]);
                    *(u32x4*)(xb + off + bj * 128) = w;
                    ss += (v0[0] * v0[0] + v0[1] * v0[1]) + (v0[2] * v0[2] + v0[3] * v0[3]) + (v1[0] * v1[0] + v1[1] * v1[1]) + (v1[2] * v1[2] + v1[3] * v1[3]); }
                ss += __shfl_xor(ss, 16); ss += __shfl_xor(ss, 32);
                if (fq == 0) part[(size_t)row * 16 + u.pn * 4 + wc] = ss; }
    }
};
struct EpiFF1 {
    const float* part; bf16_t* hid;
    __device__ __forceinline__ void operator()(const f32x4 (&acc)[2][2][4][2], const Unit& u, int wr, int wc, int fr, int fq) const {
        const int row0 = u.pm * 256 + wr * 64 + fr, col0 = u.pn * 256 + wc * 32 + 8 * fq;
#pragma unroll
        for (int ai = 0; ai < 2; ++ai)
#pragma unroll
            for (int m = 0; m < 4; ++m) { const int row = row0 + ai * 128 + m * 16;
                const f32x4* pp = (const f32x4*)(part + (size_t)row * 16); const f32x4 p0 = pp[0], p1 = pp[1], p2 = pp[2], p3 = pp[3];
                const float ss = ((p0[0] + p0[1]) + (p0[2] + p0[3])) + ((p1[0] + p1[1]) + (p1[2] + p1[3])) + ((p2[0] + p2[1]) + (p2[2] + p2[3])) + ((p3[0] + p3[1]) + (p3[2] + p3[3]));
                const float rstd = __builtin_amdgcn_rsqf(ss * (1.0f / DM) + EPS);
                bf16_t* rowp = hid + (size_t)row * DFF + col0;
#pragma unroll
                for (int bj = 0; bj < 2; ++bj) { f32x4 v0 = acc[ai][bj][m][0] * rstd, v1 = acc[ai][bj][m][1] * rstd;
#pragma unroll
                    for (int j = 0; j < 4; ++j) { const float a = fmaxf(v0[j], 0.f), b = fmaxf(v1[j], 0.f); v0[j] = a * a; v1[j] = b * b; }
                    u32x4 w; w.x = cvt_pk_bf16(v0[0], v0[1]); w.y = cvt_pk_bf16(v0[2], v0[3]); w.z = cvt_pk_bf16(v1[0], v1[1]); w.w = cvt_pk_bf16(v1[2], v1[3]);
                    *(u32x4*)(rowp + bj * 128) = w; } }
    }
};
struct EpiFF2 {
    float* out;
    __device__ __forceinline__ void operator()(const f32x4 (&acc)[2][2][4][2], const Unit& u, int wr, int wc, int fr, int fq) const {
        const int row0 = u.pm * 256 + wr * 64 + fr, col0 = u.pn * 256 + wc * 32 + 8 * fq;
#pragma unroll
        for (int ai = 0; ai < 2; ++ai)
#pragma unroll
            for (int m = 0; m < 4; ++m) { float* rowp = out + (size_t)(row0 + ai * 128 + m * 16) * DM + col0;
#pragma unroll
                for (int bj = 0; bj < 2; ++bj) { const f32x4 x0 = *(const f32x4*)(rowp + bj * 128), x1 = *(const f32x4*)(rowp + bj * 128 + 4);
                    *(f32x4*)(rowp + bj * 128) = acc[ai][bj][m][0] + x0; *(f32x4*)(rowp + bj * 128 + 4) = acc[ai][bj][m][1] + x1; } }
    }
};

__device__ __forceinline__ void p0_transpose_item(const float* W, int ldw, int ncols, const float* kscale, bf16_t* WT, int K, int row_off, LAS float* scr, int item, int lane) {
    const int nblk = ncols / 32, kb = item / nblk, nb = item % nblk, k0 = 64 * kb, n0 = 32 * nb;
#pragma unroll 8
    for (int i = 0; i < 32; ++i) { const int kk = 2 * i + (lane >> 5); float v = W[(size_t)(k0 + kk) * ldw + n0 + (lane & 31)]; if (kscale) v *= kscale[k0 + kk]; scr[kk * 33 + (lane & 31)] = v; }
    asm volatile("s_waitcnt lgkmcnt(0)" ::: "memory");
    const int c = lane & 7;
#pragma unroll
    for (int j = 0; j < 4; ++j) { const int n = (lane >> 3) + 8 * j; const LAS float* s = scr + (8 * c) * 33 + n;
        u32x4 o; o.x = cvt_pk_bf16(s[0 * 33], s[1 * 33]); o.y = cvt_pk_bf16(s[2 * 33], s[3 * 33]); o.z = cvt_pk_bf16(s[4 * 33], s[5 * 33]); o.w = cvt_pk_bf16(s[6 * 33], s[7 * 33]);
        *(u32x4*)(WT + (size_t)(row_off + n0 + n) * K + k0 + 8 * c) = o; }
    asm volatile("s_waitcnt lgkmcnt(0)" ::: "memory");
}
__device__ __forceinline__ float wave_sum(float v) {
#pragma unroll
    for (int o = 1; o < 64; o <<= 1) v += __shfl_xor(v, o);
    return v;
}
__device__ __forceinline__ void p0_phase(LAS unsigned char* lds, const Args& a, int vcu, int G, int wave, int lane) {
    LAS float* scr = (LAS float*)(lds + wave * 16384);
    const int gw = vcu * 8 + wave, NGW = G * 8;
    bf16_t* Wt = (bf16_t*)(a.ws + WS_WT);
    const float* win = a.in[I_WIN];
    constexpr int SEG_SRC[7] = {0, 2048, 3072, 3584, 4608, 1024, 3328};
    constexpr int SEG_N[7]   = {1024, 1024, 256, 1024, 1024, 1024, 256};
    constexpr int SEG_DST[7] = {0, 1024, 2048, 2304, 3328, 4352, 5376};
    constexpr int I_IN = 16 * (NIN / 32), I_O = 16 * 32, I_1 = 16 * (DFF / 32), I_2 = 64 * 32;
    for (int it = gw; it < I_IN + I_O + I_1 + I_2; it += NGW) {
        int r = it;
        if (r < I_IN) {
            int src = 0, n = 1024, dst = 0, base = 0, rb = 0; bool found = false;
#pragma unroll
            for (int s = 0; s < 7; ++s) { const int cnt = 16 * (SEG_N[s] / 32); if (!found && r < base + cnt) { found = true; src = SEG_SRC[s]; n = SEG_N[s]; dst = SEG_DST[s]; rb = r - base; } base += cnt; }
            p0_transpose_item(win + src, NIN, n, nullptr, Wt, DM, dst, scr, rb, lane); continue; }
        r -= I_IN;
        if (r < I_O) { p0_transpose_item(a.in[I_WO], DM, DM, nullptr, (bf16_t*)(a.ws + WS_WOT), DM, 0, scr, r, lane); continue; } r -= I_O;
        if (r < I_1) { p0_transpose_item(a.in[I_W1], DFF, DFF, a.in[I_N2G], (bf16_t*)(a.ws + WS_W1T), DM, 0, scr, r, lane); continue; } r -= I_1;
        p0_transpose_item(a.in[I_W2], DM, DM, nullptr, (bf16_t*)(a.ws + WS_W2T), DFF, 0, scr, r, lane);
    }
    bf16_t* H = (bf16_t*)((unsigned char*)a.out + DO_H);
    const f32x4* g4 = (const f32x4*)a.in[I_N1G] + lane;
    f32x4 g[4];
#pragma unroll
    for (int j = 0; j < 4; ++j) g[j] = g4[64 * j];
    for (int m = gw; m < MTOK; m += NGW) {
        const float* xrow = (m < MP) ? a.in[I_XP] + (size_t)m * DM : a.in[I_XS] + (size_t)(m - MP) * DM;
        const f32x4* xr = (const f32x4*)xrow + lane;
        f32x4 v[4]; float s = 0.f;
#pragma unroll
        for (int j = 0; j < 4; ++j) { v[j] = xr[64 * j]; s += (v[j].x * v[j].x + v[j].y * v[j].y) + (v[j].z * v[j].z + v[j].w * v[j].w); }
        const float rstd = __builtin_amdgcn_rsqf(wave_sum(s) * (1.f / DM) + EPS);
        u32x2* o8 = (u32x2*)(H + (size_t)m * DM) + lane;
#pragma unroll
        for (int j = 0; j < 4; ++j) { const f32x4 y = v[j] * rstd * g[j]; u32x2 w; w.x = cvt_pk_bf16(y.x, y.y); w.y = cvt_pk_bf16(y.z, y.w); o8[64 * j] = w; }
    }
}

__device__ __forceinline__ int t5_bucket(int rel) {
    const int n = rel < 0 ? -rel : rel; int b = rel > 0 ? 16 : 0;
    if (n < 8) return b + n;
    int k = (n >= 12) + (n >= 16) + (n >= 23) + (n >= 32) + (n >= 46) + (n >= 64) + (n >= 91);
    return b + 8 + k;
}
__device__ __forceinline__ void p2_phase(LAS unsigned char* lds, const Args& a, int vcu, int G) {
    const int tid = threadIdx.x, wave = __builtin_amdgcn_readfirstlane(tid >> 6), lane = tid & 63, c = lane & 31, h = lane >> 5;
    const int qt = wave & 3, hsel = wave >> 2;
    const bf16_t* Qg = (const bf16_t*)(a.ws + WS_Q); const bf16_t* Kg = (const bf16_t*)(a.ws + WS_K); const bf16_t* VTg = (const bf16_t*)(a.ws + WS_VT);
    const bf16_t* GVTg = (const bf16_t*)((unsigned char*)a.out + DO_GVT);
    bf16_t* Ug = (bf16_t*)(a.ws + WS_U); const bf16_t* SAg = (const bf16_t*)(a.ws + WS_SA); const bf16_t* SBg = (const bf16_t*)(a.ws + WS_SB);
    LAS float* tb = (LAS float*)(lds + R_TB); LAS float* rstd_l = (LAS float*)(lds + R_RSTD); LAS float* red = (LAS float*)(lds + R_RED);
    for (int i = tid; i < 8 * TB_N; i += 512) { const int hd = i / TB_N, rel = (i % TB_N) - 160; const int ar = rel < 0 ? -rel : rel;
        tb[i] = (ar <= 128) ? a.in[I_RELB][t5_bucket(rel) * 8 + hd] * LOG2E : -1e30f; }
    for (int unit = vcu; unit < MTOK / 128; unit += G) {
        const int tok0 = unit * 128;
        int n, nblk; if (unit < MP / 128) { n = unit & 31; nblk = 32; } else { n = (unit - MP / 128) & 63; nblk = 64; }
        { const int tg = tid & 15, cl = tid >> 4; float ss[8];
#pragma unroll
          for (int e = 0; e < 8; ++e) ss[e] = 0.f;
#pragma unroll 4
          for (int i = 0; i < 32; ++i) { const u32x4 w = *(const u32x4*)(GVTg + (size_t)(cl + 32 * i) * MTOK + tok0 + 8 * tg);
#pragma unroll
              for (int e = 0; e < 4; ++e) { const float lo = bf_lo(w[e]), hi = bf_hi(w[e]); ss[2 * e] += lo * lo; ss[2 * e + 1] += hi * hi; } }
#pragma unroll
          for (int e = 0; e < 8; ++e) { ss[e] += __shfl_xor(ss[e], 16); ss[e] += __shfl_xor(ss[e], 32); }
          __syncthreads();
          if (lane < 16) {
#pragma unroll
              for (int e = 0; e < 8; ++e) red[wave * 128 + lane * 8 + e] = ss[e]; }
          __syncthreads();
          if (tid < 128) { float s = 0.f;
#pragma unroll
              for (int w = 0; w < 8; ++w) s += red[w * 128 + tid];
              rstd_l[tid] = __builtin_amdgcn_rsqf(s * (1.0f / 1024.0f) + EPS); }
        }
        for (int pr = 0; pr < 4; ++pr) {
            const int hd = 2 * pr + hsel, kvh = pr >> 1;
            bf16x8 Qf[8];
            { const bf16_t* qrow = Qg + (size_t)(tok0 + 32 * qt + c) * DM + hd * 128 + 8 * h; u32x4 raw[8]; float ss = 0.f;
#pragma unroll
              for (int s = 0; s < 8; ++s) { raw[s] = *(const u32x4*)(qrow + 16 * s);
#pragma unroll
                  for (int e = 0; e < 4; ++e) { const float lo = bf_lo(raw[s][e]), hi = bf_hi(raw[s][e]); ss += lo * lo + hi * hi; } }
              ss += __shfl_xor(ss, 32);
              const float sc = __builtin_amdgcn_rsqf(ss * (1.0f / 128.0f) + EPS) * (0.08838834764831845f * LOG2E);
              const float* qg = a.in[I_QG] + 8 * h;
#pragma unroll
              for (int s = 0; s < 8; ++s) { const f32x4 g0 = *(const f32x4*)(qg + 16 * s), g1 = *(const f32x4*)(qg + 16 * s + 4); u32x4 w;
                  w.x = cvt_pk_bf16(bf_lo(raw[s][0]) * sc * g0[0], bf_hi(raw[s][0]) * sc * g0[1]); w.y = cvt_pk_bf16(bf_lo(raw[s][1]) * sc * g0[2], bf_hi(raw[s][1]) * sc * g0[3]);
                  w.z = cvt_pk_bf16(bf_lo(raw[s][2]) * sc * g1[0], bf_hi(raw[s][2]) * sc * g1[1]); w.w = cvt_pk_bf16(bf_lo(raw[s][3]) * sc * g1[2], bf_hi(raw[s][3]) * sc * g1[3]);
                  Qf[s] = __builtin_bit_cast(bf16x8, w); } }
            float m_run = a.in[I_SINK][hd] * LOG2E, l_run = (h == 0) ? 1.0f : 0.0f;
            f32x16 O[4];
#pragma unroll
            for (int dt = 0; dt < 4; ++dt)
#pragma unroll
                for (int i = 0; i < 16; ++i) O[dt][i] = 0.f;
            bool first = true;
            for (int kb = -1; kb <= 1; ++kb) {
                if (n + kb < 0 || n + kb >= nblk) continue;
                const int ktok0 = tok0 + kb * 128;
                __syncthreads();
#pragma unroll
                for (int i = 0; i < 4; ++i) { const int id = tid + 512 * i, key = id >> 4, ch = id & 15;
                    const u32x4 w = *(const u32x4*)(Kg + (size_t)(ktok0 + key) * 256 + kvh * 128 + ch * 8);
                    float v[8]; float ss = 0.f;
#pragma unroll
                    for (int e = 0; e < 4; ++e) { v[2 * e] = bf_lo(w[e]); v[2 * e + 1] = bf_hi(w[e]); ss += v[2 * e] * v[2 * e] + v[2 * e + 1] * v[2 * e + 1]; }
                    ss += __shfl_xor(ss, 1); ss += __shfl_xor(ss, 2); ss += __shfl_xor(ss, 4); ss += __shfl_xor(ss, 8);
                    const float sc = __builtin_amdgcn_rsqf(ss * (1.0f / 128.0f) + EPS);
                    const f32x4 g0 = *(const f32x4*)(a.in[I_KG] + ch * 8), g1 = *(const f32x4*)(a.in[I_KG] + ch * 8 + 4);
                    u32x4 o; o.x = cvt_pk_bf16(v[0] * sc * g0[0], v[1] * sc * g0[1]); o.y = cvt_pk_bf16(v[2] * sc * g0[2], v[3] * sc * g0[3]);
                    o.z = cvt_pk_bf16(v[4] * sc * g1[0], v[5] * sc * g1[1]); o.w = cvt_pk_bf16(v[6] * sc * g1[2], v[7] * sc * g1[3]);
                    *(LAS u32x4*)(lds + R_KT + key * KT_PITCH + ch * 16) = o; }
#pragma unroll
                for (int i = 0; i < 4; ++i) { const int id = tid + 512 * i, d = id >> 4, ch = id & 15;
                    const u32x4 w = *(const u32x4*)(VTg + (size_t)(kvh * 128 + d) * MTOK + ktok0 + ch * 8);
                    LAS u32x2* p = (LAS u32x2*)(lds + R_VT + d * VT_PITCH + ch * 16); p[0] = (u32x2){w.x, w.y}; p[1] = (u32x2){w.z, w.w}; }
                if (first) { first = false;
#pragma unroll
                    for (int i = 0; i < 8; ++i) { const int id = tid + 512 * i, ci = id >> 4, ch = id & 15;
                        const u32x4 w = *(const u32x4*)(GVTg + (size_t)(pr * 256 + ci) * MTOK + tok0 + ch * 8);
                        *(LAS u32x4*)(lds + R_GV + ci * KT_PITCH + ch * 16) = w; } }
                __syncthreads();
                const int kt_lo = (kb < 0) ? qt : 0, kt_hi = (kb > 0) ? qt : 3;
                for (int kt = kt_lo; kt <= kt_hi; ++kt) {
                    f32x16 s;
#pragma unroll
                    for (int i = 0; i < 16; ++i) s[i] = 0.f;
#pragma unroll
                    for (int s8 = 0; s8 < 8; ++s8) { const bf16x8 kf = *(const LAS bf16x8*)(lds + R_KT + (32 * kt + c) * KT_PITCH + (16 * s8 + 8 * h) * 2);
                        s = __builtin_amdgcn_mfma_f32_32x32x16_bf16(kf, Qf[s8], s, 0, 0, 0); }
                    const LAS float* tbp = tb + hd * TB_N + (kb * 128 + 32 * kt + 4 * h - 32 * qt - c + 160);
                    float mx = -3.0e38f;
#pragma unroll
                    for (int i = 0; i < 16; ++i) { s[i] += tbp[8 * (i >> 2) + (i & 3)]; mx = fmaxf(mx, s[i]); }
                    mx = fmaxf(mx, __shfl_xor(mx, 32));
                    const float m_new = fmaxf(m_run, mx), alpha = __builtin_amdgcn_exp2f(m_run - m_new); m_run = m_new;
                    float ls = 0.f;
#pragma unroll
                    for (int i = 0; i < 16; ++i) { s[i] = __builtin_amdgcn_exp2f(s[i] - m_new); ls += s[i]; }
                    l_run = l_run * alpha + ls;
#pragma unroll
                    for (int dt = 0; dt < 4; ++dt)
#pragma unroll
                        for (int i = 0; i < 16; ++i) O[dt][i] *= alpha;
                    bf16x8 Pf[2];
#pragma unroll
                    for (int s2 = 0; s2 < 2; ++s2) { u32x4 w; w.x = cvt_pk_bf16(s[8 * s2 + 0], s[8 * s2 + 1]); w.y = cvt_pk_bf16(s[8 * s2 + 2], s[8 * s2 + 3]);
                        w.z = cvt_pk_bf16(s[8 * s2 + 4], s[8 * s2 + 5]); w.w = cvt_pk_bf16(s[8 * s2 + 6], s[8 * s2 + 7]); Pf[s2] = __builtin_bit_cast(bf16x8, w); }
#pragma unroll
                    for (int dt = 0; dt < 4; ++dt)
#pragma unroll
                        for (int s2 = 0; s2 < 2; ++s2) { const LAS unsigned char* vp = lds + R_VT + (32 * dt + c) * VT_PITCH + (32 * kt + 16 * s2 + 4 * h) * 2;
                            const u32x2 lo = *(const LAS u32x2*)vp, hi = *(const LAS u32x2*)(vp + 16);
                            const u32x4 w = {lo.x, lo.y, hi.x, hi.y};
                            O[dt] = __builtin_amdgcn_mfma_f32_32x32x16_bf16(__builtin_bit_cast(bf16x8, w), Pf[s2], O[dt], 0, 0, 0); }
                }
            }
            const float inv = __builtin_amdgcn_rcpf(l_run + __shfl_xor(l_run, 32));
            u32x2 t2[4][4];
#pragma unroll
            for (int dt = 0; dt < 4; ++dt)
#pragma unroll
                for (int g4 = 0; g4 < 4; ++g4) { t2[dt][g4].x = cvt_pk_bf16(O[dt][4 * g4] * inv, O[dt][4 * g4 + 1] * inv); t2[dt][g4].y = cvt_pk_bf16(O[dt][4 * g4 + 2] * inv, O[dt][4 * g4 + 3] * inv); }
            bf16x8 Wf[8];
            { const float* wrow = a.in[I_WS] + (size_t)(hd * 128 + 32 * qt + c) * 128 + 8 * h;
#pragma unroll
              for (int s8 = 0; s8 < 8; ++s8) { const f32x4 w0 = *(const f32x4*)(wrow + 16 * s8), w1 = *(const f32x4*)(wrow + 16 * s8 + 4);
                  const f32x4 r0 = *(const LAS f32x4*)(rstd_l + 16 * s8 + 8 * h), r1 = *(const LAS f32x4*)(rstd_l + 16 * s8 + 8 * h + 4);
                  u32x4 w; w.x = cvt_pk_bf16(w0[0] * r0[0], w0[1] * r0[1]); w.y = cvt_pk_bf16(w0[2] * r0[2], w0[3] * r0[3]);
                  w.z = cvt_pk_bf16(w1[0] * r1[0], w1[1] * r1[1]); w.w = cvt_pk_bf16(w1[2] * r1[2], w1[3] * r1[3]); Wf[s8] = __builtin_bit_cast(bf16x8, w); } }
            const float bsp = a.in[I_BS][hd * 128 + 32 * qt + c];
            u32x2 t1[4][4];
#pragma unroll
            for (int ct = 0; ct < 4; ++ct) { f32x16 acc;
#pragma unroll
                for (int i = 0; i < 16; ++i) acc[i] = 0.f;
#pragma unroll
                for (int s8 = 0; s8 < 8; ++s8) { const bf16x8 gf = *(const LAS bf16x8*)(lds + R_GV + (hsel * 128 + 32 * ct + c) * KT_PITCH + (16 * s8 + 8 * h) * 2);
                    acc = __builtin_amdgcn_mfma_f32_32x32x16_bf16(gf, Wf[s8], acc, 0, 0, 0); }
#pragma unroll
                for (int g4 = 0; g4 < 4; ++g4) { const f32x4 gn = *(const f32x4*)(a.in[I_SGUG] + hd * 128 + 32 * ct + 8 * g4 + 4 * h);
                    t1[ct][g4].x = cvt_pk_bf16(acc[4 * g4] * gn[0] + bsp, acc[4 * g4 + 1] * gn[1] + bsp); t1[ct][g4].y = cvt_pk_bf16(acc[4 * g4 + 2] * gn[2] + bsp, acc[4 * g4 + 3] * gn[3] + bsp); } }
            __syncthreads();
            LAS unsigned char* ex = lds + wave * EX_WAVE;
#pragma unroll
            for (int ct = 0; ct < 4; ++ct)
#pragma unroll
                for (int g4 = 0; g4 < 4; ++g4) { const int off = c * KT_PITCH + (32 * ct + 8 * g4 + 4 * h) * 2;
                    *(LAS u32x2*)(ex + off) = t1[ct][g4]; *(LAS u32x2*)(ex + EX_T2 + off) = t2[ct][g4]; }
            asm volatile("s_waitcnt lgkmcnt(0)" ::: "memory");
#pragma unroll 2
            for (int k = 0; k < 8; ++k) { const int id = lane + 64 * k, tl = id >> 4, ch8 = id & 15;
                const u32x4 a1 = *(const LAS u32x4*)(ex + tl * KT_PITCH + ch8 * 16), a2 = *(const LAS u32x4*)(ex + EX_T2 + tl * KT_PITCH + ch8 * 16);
                const size_t go = (size_t)(tok0 + 32 * qt + tl) * DM + hd * 128 + ch8 * 8;
                const u32x4 uu = *(const u32x4*)(Ug + go), sa = *(const u32x4*)(SAg + go), sb = *(const u32x4*)(SBg + go);
                u32x4 o;
#pragma unroll
                for (int e = 0; e < 4; ++e) {
                    const float lo = bf_lo(sa[e]) * (bf_lo(uu[e]) * bf_lo(a1[e])) + bf_lo(sb[e]) * bf_lo(a2[e]);
                    const float hi = bf_hi(sa[e]) * (bf_hi(uu[e]) * bf_hi(a1[e])) + bf_hi(sb[e]) * bf_hi(a2[e]);
                    o[e] = cvt_pk_bf16(lo, hi); }
                *(u32x4*)(Ug + go) = o; }
        }
    }
    __syncthreads();
}

__global__ void __launch_bounds__(512, 2) fwd_megakernel(Args a) {
    extern __shared__ __attribute__((aligned(16))) unsigned char shm[];
    LAS unsigned char* lds = (LAS unsigned char*)shm;
    const int tid = threadIdx.x, lane = tid & 63, wave = __builtin_amdgcn_readfirstlane(tid >> 6);
    const int G = gridDim.x, bx = blockIdx.x;
    const int vcu = (G % 8 == 0) ? (bx % 8) * (G / 8) + bx / 8 : bx;
    const int lo = a.ph_lo, hi = a.ph_hi;
#define IN(k) (lo <= (k) && (k) < hi)
#define SEAM(k) do { if (IN(k) && IN((k) + 1)) { cg::this_grid().sync(); } } while (0)
    if (IN(0)) { p0_phase(lds, a, vcu, G, wave, lane); __syncthreads(); }
    SEAM(0);
    if (IN(1)) {
        pg8::StaticOrder S; S.init(MTOK, NIN, G, bx);
        P1Ptrs P{(const bf16_t*)((unsigned char*)a.out + DO_H), (const bf16_t*)(a.ws + WS_WT)};
        EpiP1 E{a.ws, (unsigned char*)a.out};
        pg8::gemm_phase(lds, DM, S, P, E);
    }
    SEAM(1);
    if (IN(2)) p2_phase(lds, a, vcu, G);
    SEAM(2);
    if (IN(3)) {
        pg8::StaticOrder S; S.init(MTOK, DM, G, bx);
        pg8::PlainPtrs P{(const bf16_t*)(a.ws + WS_U), (const bf16_t*)(a.ws + WS_WOT), DM};
        EpiWo E{a.in[I_XP], a.in[I_XS], a.out, (bf16_t*)(a.ws + WS_Q), (float*)(a.ws + WS_PART)};
        pg8::gemm_phase(lds, DM, S, P, E);
    }
    SEAM(3);
    if (IN(4)) {
        pg8::StaticOrder S; S.init(MTOK, DFF, G, bx);
        pg8::PlainPtrs P{(const bf16_t*)(a.ws + WS_Q), (const bf16_t*)(a.ws + WS_W1T), DM};
        EpiFF1 E{(const float*)(a.ws + WS_PART), (bf16_t*)(a.ws + WS_HID)};
        pg8::gemm_phase(lds, DM, S, P, E);
    }
    SEAM(4);
    if (IN(5)) {
        pg8::StaticOrder S; S.init(MTOK, DM, G, bx);
        pg8::PlainPtrs P{(const bf16_t*)(a.ws + WS_HID), (const bf16_t*)(a.ws + WS_W2T), DFF};
        EpiFF2 E{a.out};
        pg8::gemm_phase(lds, DFF, S, P, E);
    }
#undef IN
#undef SEAM
}

extern "C" void kernel_launch(void* const* d_in, const int* in_sizes, int n_in, void* d_out, int out_size, void* d_ws, size_t ws_size, hipStream_t stream) {
    static int grid = 0;
    if (grid == 0) {
        if (n_in != 15 || out_size != MTOK * DM || ws_size < WS_END) { fprintf(stderr, "kernel_launch: unexpected shapes (n_in %d out %d ws %zu)\n", n_in, out_size, ws_size); grid = -1; return; }
        int dev = 0, cus = 0, per_cu = 0;
        hipGetDevice(&dev); hipDeviceGetAttribute(&cus, hipDeviceAttributeMultiprocessorCount, dev);
        if (hipFuncSetAttribute((const void*)fwd_megakernel, hipFuncAttributeMaxDynamicSharedMemorySize, LDS_BYTES) != hipSuccess) { fprintf(stderr, "kernel_launch: hipFuncSetAttribute failed\n"); grid = -1; return; }
        hipOccupancyMaxActiveBlocksPerMultiprocessor(&per_cu, (const void*)fwd_megakernel, 512, LDS_BYTES);
        if (per_cu < 1) { fprintf(stderr, "kernel_launch: occupancy query says %d blocks/CU\n", per_cu); per_cu = 1; }
        (void)hipGetLastError();
        grid = cus * per_cu;
    }
    if (grid < 0) return;
    Args a{};
    for (int i = 0; i < 15; ++i) a.in[i] = (const float*)d_in[i];
    a.out = (float*)d_out; a.ws = (unsigned char*)d_ws;
    if (N_LAUNCHES == 1) {
        a.ph_lo = 0; a.ph_hi = 6;
        void* args[] = {&a};
        hipError_t e = hipLaunchCooperativeKernel((const void*)fwd_megakernel, dim3(grid), dim3(512), args, LDS_BYTES, stream);
        if (e != hipSuccess) fprintf(stderr, "cooperative launch failed: %s (grid %d)\n", hipGetErrorString(e), grid);
    } else {
        for (int p = 0; p < 6; ++p) { a.ph_lo = p; a.ph_hi = p + 1; hipLaunchKernelGGL(fwd_megakernel, dim3(grid), dim3(512), LDS_BYTES, stream, a); }
    }
}
```

```cpp
#include <hip/hip_runtime.h>
#include <hip/hip_cooperative_groups.h>
#include <cstdio>
namespace cg = cooperative_groups;

#define LAS __attribute__((address_space(3)))
typedef unsigned short bf16_t;
typedef short bf16x8 __attribute__((ext_vector_type(8)));
typedef float f32x4 __attribute__((ext_vector_type(4)));
typedef float f32x16 __attribute__((ext_vector_type(16)));
typedef unsigned u32x4 __attribute__((ext_vector_type(4)));
typedef unsigned u32x2 __attribute__((ext_vector_type(2)));

#ifndef PROBE_DUP
#define PROBE_DUP -1
#endif
#ifndef N_LAUNCHES
#define N_LAUNCHES 1
#endif

constexpr int MP = 8 * 4096, MS = 8 * 8192, MTOK = MP + MS;
constexpr int DM = 1024, NIN = 5632, DFF = 4096;
constexpr float EPS = 1e-6f;
constexpr float LOG2E = 1.4426950408889634f;
constexpr size_t MiB = 1u << 20;
constexpr size_t WS_WT = 0, WS_WOT = 12 * MiB, WS_W1T = 14 * MiB, WS_W2T = 22 * MiB;
constexpr size_t WS_Q = 32 * MiB;
constexpr size_t WS_U = 224 * MiB;
constexpr size_t WS_SA = 416 * MiB, WS_SB = 608 * MiB;
constexpr size_t WS_K = 800 * MiB;
constexpr size_t WS_VT = 848 * MiB;
constexpr size_t WS_HID = 224 * MiB;
constexpr size_t WS_PART = 992 * MiB;
constexpr size_t WS_END = 1000 * MiB;
constexpr size_t DO_H = 0, DO_GVT = 192 * MiB;

constexpr int KT_PITCH = 272, VT_PITCH = 264;
constexpr int R_KT = 0, R_VT = 34816, R_GV = 68608;
constexpr int EX_WAVE = 17408, EX_T2 = 8704;
constexpr int R_TB = 139264, TB_N = 320, R_RSTD = R_TB + 8 * TB_N * 4, R_RED = R_RSTD + 512;
constexpr int LDS_BYTES = 155648;
static_assert(R_RED + 4096 <= LDS_BYTES, "lds map");

__device__ __forceinline__ unsigned cvt_pk_bf16(float lo, float hi) { unsigned r; asm volatile("v_cvt_pk_bf16_f32 %0, %1, %2" : "=v"(r) : "v"(lo), "v"(hi)); return r; }
__device__ __forceinline__ float bf_lo(unsigned w) { return __uint_as_float(w << 16); }
__device__ __forceinline__ float bf_hi(unsigned w) { return __uint_as_float(w & 0xffff0000u); }
__device__ __forceinline__ float gelu_tanh(float x) { const float t = x * (1.0f + 0.044715f * x * x) * (-2.302208198f); return x * __builtin_amdgcn_rcpf(1.0f + __builtin_amdgcn_exp2f(t)); }
__device__ __forceinline__ float sigmoidf(float x) { return __builtin_amdgcn_rcpf(1.0f + __builtin_amdgcn_exp2f(-LOG2E * x)); }

namespace pg8 {
constexpr int BM = 256, BK = 64, HALF = 128, HTB = HALF * BK * 2, STAGE_BYTES = 8 * HTB, NXCD = 8, WGM = 8;
__host__ __device__ __forceinline__ int lds_byte(int r, int c) { const int st = (r >> 4) * 2 + (c >> 5), rr = r & 15, cc = c & 31, ob = rr * 64 + cc * 2; return st * 1024 + (ob ^ (((ob >> 9) & 1) << 5)); }
__host__ __device__ __forceinline__ void stage_rc(int b, int& R, int& C) { const int st = b / 1024, sb = b % 1024, swz = sb ^ (((sb >> 9) & 1) << 5); R = (st >> 1) * 16 + swz / 64; C = (st & 1) * 32 + (swz % 64) / 2; }
__host__ __device__ __forceinline__ int perm32(int rho) { const int n = rho >> 4, i = rho & 15; return 8 * (i >> 2) + 4 * n + (i & 3); }
struct Unit { int pm, pn; };
struct StaticOrder {
    int nM, nN, nwg, G, c;
    __device__ void init(int M, int N, int G_, int c_) { nM = M / BM; nN = N / BM; nwg = nM * nN; G = G_; c = c_; }
    __device__ bool next(int i, Unit& u) const {
        const long L = (long)i * G + c; if (L >= nwg) return false;
        int wgid = (int)L; { const int q = nwg / NXCD, r = nwg % NXCD, xcd = wgid % NXCD, off = wgid / NXCD; wgid = (xcd < r ? xcd * (q + 1) : r * (q + 1) + (xcd - r) * q) + off; }
        const int nig = WGM * nN, gid = wgid / nig, fm = gid * WGM, gsz = (nM - fm) < WGM ? (nM - fm) : WGM;
        u.pm = fm + ((wgid % nig) % gsz); u.pn = (wgid % nig) / gsz; return true;
    }
};
struct PlainPtrs { const bf16_t* A; const bf16_t* Bt; int K;
    __device__ __forceinline__ void get(const Unit& u, const char*& a, const char*& b) const { a = (const char*)A + (size_t)u.pm * 512 * K; b = (const char*)Bt + (size_t)u.pn * 512 * K; } };

template <class Epi, class Ptrs>
__device__ __forceinline__ void gemm_phase(LAS unsigned char* lds, const int K, const StaticOrder& S, const Ptrs& P, const Epi& E) {
    const int tid = threadIdx.x, wid = __builtin_amdgcn_readfirstlane(tid >> 6), lane = tid & 63, wr = wid >> 2, wc = wid & 3, fr = lane & 15, fq = lane >> 4;
    const int nt = K / BK;
    unsigned voffA[2], voffB[2];
#pragma unroll
    for (int i = 0; i < 2; ++i) { int R, C; stage_rc(tid * 16 + i * 8192, R, C); const int Rb = (R & ~31) + perm32(R & 31);
        voffA[i] = (unsigned)(R * K + C) * 2u; voffB[i] = (unsigned)(Rb * K + C) * 2u; }
    const size_t kstep = (size_t)(BK * 2);
    const size_t hstep = (size_t)HALF * K * 2;
    const unsigned ldsw = (unsigned)wid * 1024u;
    const int aoff = lds_byte(wr * 64 + fr, fq * 8), boff = lds_byte(wc * 32 + fr, fq * 8);
#define PG8_SA(b, h) (((b) * 2 + (h)) * HTB)
#define PG8_SB(b, h) ((4 + (b) * 2 + (h)) * HTB)
#define PG8_STAGE(bufoff, gbase, voff) do { _Pragma("unroll") for (int _i = 0; _i < 2; ++_i) \
        __builtin_amdgcn_global_load_lds((const unsigned*)((const char*)(gbase) + (voff)[_i]), (LAS unsigned*)(lds + (bufoff) + ldsw + _i * 8192), 16, 0, 0); } while (0)
#define PG8_LDA(dst, b, h) do { _Pragma("unroll") for (int m = 0; m < 4; ++m) _Pragma("unroll") for (int k = 0; k < 2; ++k) dst[m][k] = *(const LAS bf16x8*)(lds + PG8_SA(b, h) + aoff + m * 2048 + k * 1024); } while (0)
#define PG8_LDB(dst, b, h) do { _Pragma("unroll") for (int n = 0; n < 2; ++n) _Pragma("unroll") for (int k = 0; k < 2; ++k) dst[n][k] = *(const LAS bf16x8*)(lds + PG8_SB(b, h) + boff + n * 2048 + k * 1024); } while (0)
#define PG8_MMA(ai, bj, At, Bt) do { __builtin_amdgcn_s_setprio(1); _Pragma("unroll") for (int m = 0; m < 4; ++m) _Pragma("unroll") for (int n = 0; n < 2; ++n) _Pragma("unroll") for (int k = 0; k < 2; ++k) \
        acc[ai][bj][m][n] = __builtin_amdgcn_mfma_f32_16x16x32_bf16(Bt[n][k], At[m][k], acc[ai][bj][m][n], 0, 0, 0); __builtin_amdgcn_s_setprio(0); } while (0)
#define PG8_WAIT_V(n) asm volatile("s_waitcnt vmcnt(" #n ")" ::: "memory")
#define PG8_WAIT_L(n) asm volatile("s_waitcnt lgkmcnt(" #n ")" ::: "memory")
#define PG8_BAR __builtin_amdgcn_s_barrier()
#define PG8_SCHED __builtin_amdgcn_sched_barrier(0)
    Unit cur, nxt; int ui = 0;
    if (!S.next(0, cur)) return;
    f32x4 acc[2][2][4][2];
#pragma unroll
    for (int a = 0; a < 2; ++a)
#pragma unroll
        for (int b = 0; b < 2; ++b)
#pragma unroll
            for (int m = 0; m < 4; ++m)
#pragma unroll
                for (int n = 0; n < 2; ++n) acc[a][b][m][n] = (f32x4){0.f, 0.f, 0.f, 0.f};
    bf16x8 At[4][2], B0[2][2], B1[2][2];
    const char* cA; const char* cB; P.get(cur, cA, cB);
    PG8_STAGE(PG8_SB(0, 0), cB, voffB); PG8_STAGE(PG8_SA(0, 0), cA, voffA); PG8_STAGE(PG8_SB(0, 1), cB + hstep, voffB); PG8_STAGE(PG8_SA(0, 1), cA + hstep, voffA);
    if (wr == 1) PG8_BAR;
    PG8_WAIT_V(4); PG8_BAR;
    PG8_STAGE(PG8_SB(1, 0), cB + kstep, voffB); PG8_STAGE(PG8_SA(1, 0), cA + kstep, voffA); PG8_STAGE(PG8_SB(1, 1), cB + hstep + kstep, voffB);
    PG8_WAIT_V(6); PG8_BAR;
    for (;;) {
        const bool has_next = S.next(ui + 1, nxt);
        const char* nA = cA; const char* nB = cB; if (has_next) P.get(nxt, nA, nB);
        for (int t = 0; t < nt; t += 2) {
            const bool last = (t == nt - 2);
            const char* a1 = cA + (size_t)(t + 1) * kstep;
            const char* a2 = last ? nA : cA + (size_t)(t + 2) * kstep; const char* b2 = last ? nB : cB + (size_t)(t + 2) * kstep;
            const char* a3 = a2 + kstep; const char* b3 = b2 + kstep;
            PG8_LDB(B0, 0, 0); PG8_SCHED; PG8_LDA(At, 0, 0); PG8_STAGE(PG8_SA(1, 1), a1 + hstep, voffA);
            PG8_WAIT_L(8); PG8_BAR; PG8_WAIT_L(0); PG8_MMA(0, 0, At, B0); PG8_BAR; PG8_SCHED;
            PG8_LDB(B1, 0, 1); PG8_STAGE(PG8_SB(0, 0), b2, voffB);
            PG8_BAR; PG8_WAIT_L(0); PG8_MMA(0, 1, At, B1); PG8_BAR;
            PG8_LDA(At, 0, 1); PG8_STAGE(PG8_SA(0, 0), a2, voffA);
            PG8_BAR; PG8_WAIT_L(0); PG8_MMA(1, 0, At, B0); PG8_BAR; PG8_SCHED;
            PG8_STAGE(PG8_SB(0, 1), b2 + hstep, voffB);
            PG8_WAIT_V(6); PG8_BAR; PG8_MMA(1, 1, At, B1); PG8_BAR;
            PG8_LDB(B0, 1, 0); PG8_SCHED; PG8_LDA(At, 1, 0); PG8_STAGE(PG8_SA(0, 1), a2 + hstep, voffA);
            PG8_WAIT_L(8); PG8_BAR; PG8_WAIT_L(0); PG8_MMA(0, 0, At, B0); PG8_BAR; PG8_SCHED;
            PG8_LDB(B1, 1, 1); PG8_STAGE(PG8_SB(1, 0), b3, voffB);
            PG8_BAR; PG8_WAIT_L(0); PG8_MMA(0, 1, At, B1); PG8_BAR;
            PG8_LDA(At, 1, 1); PG8_STAGE(PG8_SA(1, 0), a3, voffA);
            PG8_BAR; PG8_WAIT_L(0); PG8_MMA(1, 0, At, B0); PG8_BAR; PG8_SCHED;
            PG8_STAGE(PG8_SB(1, 1), b3 + hstep, voffB);
            PG8_WAIT_V(6); PG8_BAR; PG8_MMA(1, 1, At, B1); PG8_BAR;
        }
        E(acc, cur, ui, wr, wc, fr, fq);
        if (!has_next) break;
#pragma unroll
        for (int a = 0; a < 2; ++a)
#pragma unroll
            for (int b = 0; b < 2; ++b)
#pragma unroll
                for (int m = 0; m < 4; ++m)
#pragma unroll
                    for (int n = 0; n < 2; ++n) acc[a][b][m][n] = (f32x4){0.f, 0.f, 0.f, 0.f};
        cur = nxt; cA = nA; cB = nB; ++ui;
    }
    PG8_WAIT_V(0);
    if (wr == 0) PG8_BAR;
    PG8_BAR;
#undef PG8_SA
#undef PG8_SB
#undef PG8_STAGE
#undef PG8_LDA
#undef PG8_LDB
#undef PG8_MMA
#undef PG8_WAIT_V
#undef PG8_WAIT_L
#undef PG8_BAR
#undef PG8_SCHED
}
}
using pg8::Unit;

struct Args { const float* in[15]; float* out; unsigned char* ws; int ph_lo, ph_hi; };
enum { I_XP = 0, I_XS, I_RELB, I_N1G, I_WIN, I_SGUG, I_WS, I_BS, I_QG, I_KG, I_SINK, I_WO, I_N2G, I_W1, I_W2 };

struct P1Ptrs { const bf16_t* H; const bf16_t* Wt;
    __device__ __forceinline__ void get(const Unit& u, const char*& a, const char*& b) const {
        const char* hp = (const char*)H + (size_t)u.pm * 512 * DM; const char* wp = (const char*)Wt + (size_t)u.pn * 512 * DM;
        if (u.pn < 17) { a = hp; b = wp; } else { a = wp; b = hp; } } };
struct EpiP1 {
    unsigned char* ws; unsigned char* dout;
    __device__ __forceinline__ void operator()(const f32x4 (&acc)[2][2][4][2], const Unit& u, int ui, int wr, int wc, int fr, int fq) const {
        bf16_t* base; size_t ld; int row0, col0, act;
        const int pn = u.pn;
        if (pn < 4)       { base = (bf16_t*)(ws + WS_U);  ld = DM;  row0 = u.pm * 256; col0 = pn * 256;        act = 1; }
        else if (pn < 8)  { base = (bf16_t*)(ws + WS_Q);  ld = DM;  row0 = u.pm * 256; col0 = (pn - 4) * 256;  act = 0; }
        else if (pn < 9)  { base = (bf16_t*)(ws + WS_K);  ld = 256; row0 = u.pm * 256; col0 = 0;               act = 0; }
        else if (pn < 13) { base = (bf16_t*)(ws + WS_SA); ld = DM;  row0 = u.pm * 256; col0 = (pn - 9) * 256;  act = 2; }
        else if (pn < 17) { base = (bf16_t*)(ws + WS_SB); ld = DM;  row0 = u.pm * 256; col0 = (pn - 13) * 256; act = 2; }
        else if (pn < 21) { base = (bf16_t*)(dout + DO_GVT); ld = MTOK; row0 = (pn - 17) * 256; col0 = u.pm * 256; act = 1; }
        else              { base = (bf16_t*)(ws + WS_VT); ld = MTOK; row0 = 0; col0 = u.pm * 256; act = 0; }
        const int r0 = row0 + wr * 64 + fr, c0 = col0 + wc * 32 + 8 * fq;
#pragma unroll
        for (int ai = 0; ai < 2; ++ai)
#pragma unroll
            for (int m = 0; m < 4; ++m) { bf16_t* rowp = base + (size_t)(r0 + ai * 128 + m * 16) * ld + c0;
#pragma unroll
                for (int bj = 0; bj < 2; ++bj) { f32x4 v0 = acc[ai][bj][m][0], v1 = acc[ai][bj][m][1];
                    if (act == 1) {
#pragma unroll
                        for (int j = 0; j < 4; ++j) { v0[j] = gelu_tanh(v0[j]); v1[j] = gelu_tanh(v1[j]); } }
                    else if (act == 2) {
#pragma unroll
                        for (int j = 0; j < 4; ++j) { v0[j] = sigmoidf(v0[j]); v1[j] = sigmoidf(v1[j]); } }
                    u32x4 w; w.x = cvt_pk_bf16(v0[0], v0[1]); w.y = cvt_pk_bf16(v0[2], v0[3]); w.z = cvt_pk_bf16(v1[0], v1[1]); w.w = cvt_pk_bf16(v1[2], v1[3]);
                    *(u32x4*)(rowp + bj * 128) = w; } }
    }
};
struct EpiWo {
    const float* xp; const float* xs; bf16_t* xb; float* part;
    __device__ __forceinline__ void operator()(const f32x4 (&acc)[2][2][4][2], const Unit& u, int ui, int wr, int wc, int fr, int fq) const {
        const int row0 = u.pm * 256 + wr * 64 + fr, col0 = u.pn * 256 + wc * 32 + 8 * fq;
        const float* xb0 = (u.pm * 256 < MP) ? xp : xs - (size_t)MP * DM;
#pragma unroll
        for (int ai = 0; ai < 2; ++ai) {
            f32x4 xv[4][2][2];
#pragma unroll
            for (int m = 0; m < 4; ++m)
#pragma unroll
                for (int bj = 0; bj < 2; ++bj) { const float* p = xb0 + (size_t)(row0 + ai * 128 + m * 16) * DM + col0 + bj * 128; xv[m][bj][0] = *(const f32x4*)p; xv[m][bj][1] = *(const f32x4*)(p + 4); }
#pragma unroll
            for (int m = 0; m < 4; ++m) { const int row = row0 + ai * 128 + m * 16; const size_t off = (size_t)row * DM + col0; float ss = 0.f;
#pragma unroll
                for (int bj = 0; bj < 2; ++bj) {
                    const f32x4 v0 = acc[ai][bj][m][0] + xv[m][bj][0], v1 = acc[ai][bj][m][1] + xv[m][bj][1];
                    u32x4 w; w.x = cvt_pk_bf16(v0[0], v0[1]); w.y = cvt_pk_bf16(v0[2], v0[3]); w.z = cvt_pk_bf16(v1[0], v1[1]); w.w = cvt_pk_bf16(v1[2], v1[3]);
                    *(u32x4*)(xb + off + bj * 128) = w;
                    ss += (v0[0] * v0[0] + v0[1] * v0[1]) + (v0[2] * v0[2] + v0[3] * v0[3]) + (v1[0] * v1[0] + v1[1] * v1[1]) + (v1[2] * v1[2] + v1[3] * v1[3]); }
                ss += __shfl_xor(ss, 16); ss += __shfl_xor(ss, 32);
                if (fq == 0) part[(size_t)row * 16 + u.pn * 4 + wc] = ss; }
        }
    }
};
struct EpiFF1 {
    bf16_t* hid;
    __device__ __forceinline__ void operator()(const f32x4 (&acc)[2][2][4][2], const Unit& u, int ui, int wr, int wc, int fr, int fq) const {
        const int row0 = u.pm * 256 + wr * 64 + fr, col0 = u.pn * 256 + wc * 32 + 8 * fq;
#pragma unroll
        for (int ai = 0; ai < 2; ++ai)
#pragma unroll
            for (int m = 0; m < 4; ++m) { bf16_t* rowp = hid + (size_t)(row0 + ai * 128 + m * 16) * DFF + col0;
#pragma unroll
                for (int bj = 0; bj < 2; ++bj) { f32x4 v0 = acc[ai][bj][m][0], v1 = acc[ai][bj][m][1];
#pragma unroll
                    for (int j = 0; j < 4; ++j) { const float a = fmaxf(v0[j], 0.f), b = fmaxf(v1[j], 0.f); v0[j] = a * a; v1[j] = b * b; }
                    u32x4 w; w.x = cvt_pk_bf16(v0[0], v0[1]); w.y = cvt_pk_bf16(v0[2], v0[3]); w.z = cvt_pk_bf16(v1[0], v1[1]); w.w = cvt_pk_bf16(v1[2], v1[3]);
                    *(u32x4*)(rowp + bj * 128) = w; } }
    }
};
constexpr int R_FF2TAB = 131072;
struct EpiFF2 {
    float* out; const bf16_t* xb; const LAS float* tab;
    __device__ __forceinline__ void operator()(const f32x4 (&acc)[2][2][4][2], const Unit& u, int ui, int wr, int wc, int fr, int fq) const {
        const int rl0 = wr * 64 + fr, col0 = u.pn * 256 + wc * 32 + 8 * fq;
        u32x4 xv[2][4][2];
#pragma unroll
        for (int ai = 0; ai < 2; ++ai)
#pragma unroll
            for (int m = 0; m < 4; ++m)
#pragma unroll
                for (int bj = 0; bj < 2; ++bj) xv[ai][m][bj] = *(const u32x4*)(xb + (size_t)(u.pm * 256 + rl0 + ai * 128 + m * 16) * DM + col0 + bj * 128);
#pragma unroll
        for (int ai = 0; ai < 2; ++ai)
#pragma unroll
            for (int m = 0; m < 4; ++m) { const int rl = rl0 + ai * 128 + m * 16; float* rowp = out + (size_t)(u.pm * 256 + rl) * DM + col0;
                const float r2 = tab[ui * 256 + rl];
#pragma unroll
                for (int bj = 0; bj < 2; ++bj) { const u32x4 x = xv[ai][m][bj];
                    const f32x4 x0 = {bf_lo(x.x), bf_hi(x.x), bf_lo(x.y), bf_hi(x.y)}, x1 = {bf_lo(x.z), bf_hi(x.z), bf_lo(x.w), bf_hi(x.w)};
                    *(f32x4*)(rowp + bj * 128) = acc[ai][bj][m][0] * r2 + x0; *(f32x4*)(rowp + bj * 128 + 4) = acc[ai][bj][m][1] * r2 + x1; } }
    }
};

__device__ __forceinline__ void p0_transpose_item(const float* W, int ldw, int ncols, const float* kscale, bf16_t* WT, int K, int row_off, LAS float* scr, int item, int lane) {
    const int nblk = ncols / 32, kb = item / nblk, nb = item % nblk, k0 = 64 * kb, n0 = 32 * nb;
#pragma unroll 8
    for (int i = 0; i < 32; ++i) { const int kk = 2 * i + (lane >> 5); float v = W[(size_t)(k0 + kk) * ldw + n0 + (lane & 31)]; if (kscale) v *= kscale[k0 + kk]; scr[kk * 33 + (lane & 31)] = v; }
    asm volatile("s_waitcnt lgkmcnt(0)" ::: "memory");
    const int c = lane & 7;
#pragma unroll
    for (int j = 0; j < 4; ++j) { const int n = (lane >> 3) + 8 * j; const LAS float* s = scr + (8 * c) * 33 + n;
        u32x4 o; o.x = cvt_pk_bf16(s[0 * 33], s[1 * 33]); o.y = cvt_pk_bf16(s[2 * 33], s[3 * 33]); o.z = cvt_pk_bf16(s[4 * 33], s[5 * 33]); o.w = cvt_pk_bf16(s[6 * 33], s[7 * 33]);
        *(u32x4*)(WT + (size_t)(row_off + n0 + n) * K + k0 + 8 * c) = o; }
    asm volatile("s_waitcnt lgkmcnt(0)" ::: "memory");
}
__device__ __forceinline__ float wave_sum(float v) {
#pragma unroll
    for (int o = 1; o < 64; o <<= 1) v += __shfl_xor(v, o);
    return v;
}
__device__ __forceinline__ void p0_phase(LAS unsigned char* lds, const Args& a, int vcu, int G, int wave, int lane) {
    LAS float* scr = (LAS float*)(lds + wave * 16384);
    const int gw = vcu * 8 + wave, NGW = G * 8;
    bf16_t* Wt = (bf16_t*)(a.ws + WS_WT);
    const float* win = a.in[I_WIN];
    constexpr int SEG_SRC[7] = {0, 2048, 3072, 3584, 4608, 1024, 3328};
    constexpr int SEG_N[7]   = {1024, 1024, 256, 1024, 1024, 1024, 256};
    constexpr int SEG_DST[7] = {0, 1024, 2048, 2304, 3328, 4352, 5376};
    constexpr int I_IN = 16 * (NIN / 32), I_O = 16 * 32, I_1 = 16 * (DFF / 32), I_2 = 64 * 32;
    for (int it = gw; it < I_IN + I_O + I_1 + I_2; it += NGW) {
        int r = it;
        if (r < I_IN) {
            int src = 0, n = 1024, dst = 0, base = 0, rb = 0; bool found = false;
#pragma unroll
            for (int s = 0; s < 7; ++s) { const int cnt = 16 * (SEG_N[s] / 32); if (!found && r < base + cnt) { found = true; src = SEG_SRC[s]; n = SEG_N[s]; dst = SEG_DST[s]; rb = r - base; } base += cnt; }
            p0_transpose_item(win + src, NIN, n, nullptr, Wt, DM, dst, scr, rb, lane); continue; }
        r -= I_IN;
        if (r < I_O) { p0_transpose_item(a.in[I_WO], DM, DM, nullptr, (bf16_t*)(a.ws + WS_WOT), DM, 0, scr, r, lane); continue; } r -= I_O;
        if (r < I_1) { p0_transpose_item(a.in[I_W1], DFF, DFF, a.in[I_N2G], (bf16_t*)(a.ws + WS_W1T), DM, 0, scr, r, lane); continue; } r -= I_1;
        p0_transpose_item(a.in[I_W2], DM, DM, nullptr, (bf16_t*)(a.ws + WS_W2T), DFF, 0, scr, r, lane);
    }
    bf16_t* H = (bf16_t*)((unsigned char*)a.out + DO_H);
    const f32x4* g4 = (const f32x4*)a.in[I_N1G] + lane;
    f32x4 g[4];
#pragma unroll
    for (int j = 0; j < 4; ++j) g[j] = g4[64 * j];
    for (int m = gw; m < MTOK; m += NGW) {
        const float* xrow = (m < MP) ? a.in[I_XP] + (size_t)m * DM : a.in[I_XS] + (size_t)(m - MP) * DM;
        const f32x4* xr = (const f32x4*)xrow + lane;
        f32x4 v[4]; float s = 0.f;
#pragma unroll
        for (int j = 0; j < 4; ++j) { v[j] = xr[64 * j]; s += (v[j].x * v[j].x + v[j].y * v[j].y) + (v[j].z * v[j].z + v[j].w * v[j].w); }
        const float rstd = __builtin_amdgcn_rsqf(wave_sum(s) * (1.f / DM) + EPS);
        u32x2* o8 = (u32x2*)(H + (size_t)m * DM) + lane;
#pragma unroll
        for (int j = 0; j < 4; ++j) { const f32x4 y = v[j] * rstd * g[j]; u32x2 w; w.x = cvt_pk_bf16(y.x, y.y); w.y = cvt_pk_bf16(y.z, y.w); o8[64 * j] = w; }
    }
}

__device__ __forceinline__ int t5_bucket(int rel) {
    const int n = rel < 0 ? -rel : rel; int b = rel > 0 ? 16 : 0;
    if (n < 8) return b + n;
    int k = (n >= 12) + (n >= 16) + (n >= 23) + (n >= 32) + (n >= 46) + (n >= 64) + (n >= 91);
    return b + 8 + k;
}
__device__ __forceinline__ u32x4 ldg16(const void* ubase, unsigned voff) { return *(const u32x4*)((const char*)ubase + voff); }
__device__ __forceinline__ void p2_unit_info(int unit, int& tok0, int& kb_lo, int& kb_hi) {
    tok0 = unit * 128; int n, nblk; if (unit < MP / 128) { n = unit & 31; nblk = 32; } else { n = (unit - MP / 128) & 63; nblk = 64; }
    kb_lo = (n > 0) ? -1 : 0; kb_hi = (n < nblk - 1) ? 1 : 0;
}
__device__ __forceinline__ void p2_phase(LAS unsigned char* lds, const Args& a, int vcu, int G, bf16_t* Mout) {
    const int tid = threadIdx.x, wave = __builtin_amdgcn_readfirstlane(tid >> 6), lane = tid & 63, c = lane & 31, h = lane >> 5;
    const int qt = wave & 3, hsel = wave >> 2;
    const bf16_t* Qg = (const bf16_t*)(a.ws + WS_Q); const bf16_t* Kg = (const bf16_t*)(a.ws + WS_K); const bf16_t* VTg = (const bf16_t*)(a.ws + WS_VT);
    const bf16_t* GVTg = (const bf16_t*)((unsigned char*)a.out + DO_GVT);
    const bf16_t* Ug = (const bf16_t*)(a.ws + WS_U); const bf16_t* SAg = (const bf16_t*)(a.ws + WS_SA); const bf16_t* SBg = (const bf16_t*)(a.ws + WS_SB);
    LAS float* tb = (LAS float*)(lds + R_TB); LAS float* rstd_l = (LAS float*)(lds + R_RSTD); LAS float* red = (LAS float*)(lds + R_RED);
    constexpr int NU = MTOK / 128;
    for (int i = tid; i < 8 * TB_N; i += 512) { const int hd = i / TB_N, rel = (i % TB_N) - 160; const int ar = rel < 0 ? -rel : rel;
        tb[i] = (ar <= 128) ? a.in[I_RELB][t5_bucket(rel) * 8 + hd] * LOG2E : -1e30f; }
    if (vcu >= NU) { __syncthreads(); return; }
    const int srow = tid >> 4, sch = tid & 15;
    const f32x4 kg0 = *(const f32x4*)(a.in[I_KG] + sch * 8), kg1 = *(const f32x4*)(a.in[I_KG] + sch * 8 + 4);
    u32x4 Kraw[4], Vraw[4];
    const unsigned offK = (unsigned)(srow * 256 + sch * 8) * 2u, offV = (unsigned)(srow * MTOK + sch * 8) * 2u;
    const unsigned offGV = (unsigned)((lane >> 4) * MTOK + (((lane & 15) ^ ((4 * wave + (lane >> 4)) & 15)) * 8)) * 2u;
    const unsigned offQ = (unsigned)(c * DM + 8 * h) * 2u, offP0 = (unsigned)((tid >> 4) * MTOK + 8 * (tid & 15)) * 2u, offC = (unsigned)((lane >> 4) * DM + (lane & 15) * 8) * 2u;
#define P2_PREFETCH(u_tok0, u_pr, u_kb) do { const int _kt0 = (u_tok0) + (u_kb) * 128, _kvh = (u_pr) >> 1; \
        const char* _kb0 = (const char*)(Kg + (size_t)_kt0 * 256 + _kvh * 128); const char* _vb0 = (const char*)(VTg + (size_t)(_kvh * 128) * MTOK + _kt0); \
        _Pragma("unroll") for (int i = 0; i < 4; ++i) Kraw[i] = ldg16(_kb0 + (size_t)i * (32 * 256 * 2), offK); \
        _Pragma("unroll") for (int i = 0; i < 4; ++i) Vraw[i] = ldg16(_vb0 + (size_t)i * ((size_t)32 * MTOK * 2), offV); } while (0)
    { int t0_, lo_, hi_; p2_unit_info(vcu, t0_, lo_, hi_); P2_PREFETCH(t0_, 0, lo_); }
    for (int unit = vcu; unit < NU; unit += G) {
        int tok0, kb_lo, kb_hi; p2_unit_info(unit, tok0, kb_lo, kb_hi);
        {
            float ss[8];
#pragma unroll
            for (int e = 0; e < 8; ++e) ss[e] = 0.f;
#pragma unroll 8
            for (int i = 0; i < 32; ++i) { const u32x4 w = ldg16((const char*)(GVTg + tok0) + (size_t)i * ((size_t)32 * MTOK * 2), offP0);
#pragma unroll
                for (int e = 0; e < 4; ++e) { const float lo = bf_lo(w[e]), hi = bf_hi(w[e]); ss[2 * e] += lo * lo; ss[2 * e + 1] += hi * hi; } }
#pragma unroll
            for (int e = 0; e < 8; ++e) { ss[e] += __shfl_xor(ss[e], 16); ss[e] += __shfl_xor(ss[e], 32); }
            __syncthreads();
            if (lane < 16) {
#pragma unroll
                for (int e = 0; e < 8; ++e) red[wave * 128 + lane * 8 + e] = ss[e]; }
            __syncthreads();
            if (tid < 128) { float s = 0.f;
#pragma unroll
                for (int w = 0; w < 8; ++w) s += red[w * 128 + tid];
                rstd_l[tid] = __builtin_amdgcn_rsqf(s * (1.0f / 1024.0f) + EPS); }
        }
        for (int pr = 0; pr < 4; ++pr) {
        const int hd = 2 * pr + hsel;
        bf16x8 Qf[8]; f32x16 O[4]; float m_run, l_run;
        {
            const char* qb = (const char*)(Qg + (size_t)(tok0 + 32 * qt) * DM + hd * 128); u32x4 raw[8]; float ss = 0.f;
#pragma unroll
            for (int s = 0; s < 8; ++s) raw[s] = ldg16(qb + 32 * s, offQ);
#pragma unroll
            for (int s = 0; s < 8; ++s)
#pragma unroll
                for (int e = 0; e < 4; ++e) { const float lo = bf_lo(raw[s][e]), hi = bf_hi(raw[s][e]); ss += lo * lo + hi * hi; }
            ss += __shfl_xor(ss, 32);
            const float sc = __builtin_amdgcn_rsqf(ss * (1.0f / 128.0f) + EPS) * (0.08838834764831845f * LOG2E);
            const float* qg = a.in[I_QG] + 8 * h;
#pragma unroll
            for (int s = 0; s < 8; ++s) { const f32x4 g0 = *(const f32x4*)(qg + 16 * s), g1 = *(const f32x4*)(qg + 16 * s + 4); u32x4 w;
                w.x = cvt_pk_bf16(bf_lo(raw[s][0]) * sc * g0[0], bf_hi(raw[s][0]) * sc * g0[1]); w.y = cvt_pk_bf16(bf_lo(raw[s][1]) * sc * g0[2], bf_hi(raw[s][1]) * sc * g0[3]);
                w.z = cvt_pk_bf16(bf_lo(raw[s][2]) * sc * g1[0], bf_hi(raw[s][2]) * sc * g1[1]); w.w = cvt_pk_bf16(bf_lo(raw[s][3]) * sc * g1[2], bf_hi(raw[s][3]) * sc * g1[3]);
                Qf[s] = __builtin_bit_cast(bf16x8, w); }
            m_run = a.in[I_SINK][hd] * LOG2E; l_run = (h == 0) ? 1.0f : 0.0f;
#pragma unroll
            for (int dt = 0; dt < 4; ++dt)
#pragma unroll
                for (int i = 0; i < 16; ++i) O[dt][i] = 0.f;
        }
        for (int kb = kb_lo; kb <= kb_hi; ++kb) {
        asm volatile("s_waitcnt vmcnt(0)" ::: "memory");
        __syncthreads();
#pragma unroll
        for (int i = 0; i < 4; ++i) { const u32x4 w = Kraw[i]; float v[8]; float ss = 0.f;
#pragma unroll
            for (int e = 0; e < 4; ++e) { v[2 * e] = bf_lo(w[e]); v[2 * e + 1] = bf_hi(w[e]); ss += v[2 * e] * v[2 * e] + v[2 * e + 1] * v[2 * e + 1]; }
            ss += __shfl_xor(ss, 1); ss += __shfl_xor(ss, 2); ss += __shfl_xor(ss, 4); ss += __shfl_xor(ss, 8);
            const float sc = __builtin_amdgcn_rsqf(ss * (1.0f / 128.0f) + EPS);
            u32x4 o; o.x = cvt_pk_bf16(v[0] * sc * kg0[0], v[1] * sc * kg0[1]); o.y = cvt_pk_bf16(v[2] * sc * kg0[2], v[3] * sc * kg0[3]);
            o.z = cvt_pk_bf16(v[4] * sc * kg1[0], v[5] * sc * kg1[1]); o.w = cvt_pk_bf16(v[6] * sc * kg1[2], v[7] * sc * kg1[3]);
            *(LAS u32x4*)(lds + R_KT + (srow + 32 * i) * KT_PITCH + sch * 16) = o; }
#pragma unroll
        for (int i = 0; i < 4; ++i) { const u32x4 w = Vraw[i]; LAS u32x2* p = (LAS u32x2*)(lds + R_VT + (srow + 32 * i) * VT_PITCH + sch * 16); p[0] = (u32x2){w.x, w.y}; p[1] = (u32x2){w.z, w.w}; }
        if (kb == kb_lo) {
#pragma unroll
            for (int i = 0; i < 8; ++i) {
                __builtin_amdgcn_global_load_lds((const unsigned*)((const char*)(GVTg + (size_t)(pr * 256 + 32 * i + 4 * wave) * MTOK + tok0) + offGV), (LAS unsigned*)(lds + R_GV + (32 * i + 4 * wave) * 256), 16, 0, 0); } }
        int nunit = unit, npr = pr, nkb = kb + 1, ntok0 = tok0, nkb_lo = kb_lo, nkb_hi = kb_hi;
        if (nkb > kb_hi) { npr = pr + 1; if (npr == 4) { npr = 0; nunit = unit + G; if (nunit < NU) p2_unit_info(nunit, ntok0, nkb_lo, nkb_hi); } nkb = nkb_lo; }
        const bool has_next = nunit < NU;
        if (has_next) P2_PREFETCH(ntok0, npr, nkb);
        __syncthreads();
        {
            const int kt_lo = (kb < 0) ? qt : 0, kt_hi = (kb > 0) ? qt : 3;
            for (int kt = kt_lo; kt <= kt_hi; ++kt) {
                f32x16 s;
#pragma unroll
                for (int i = 0; i < 16; ++i) s[i] = 0.f;
#pragma unroll
                for (int s8 = 0; s8 < 8; ++s8) { const bf16x8 kf = *(const LAS bf16x8*)(lds + R_KT + (32 * kt + c) * KT_PITCH + (16 * s8 + 8 * h) * 2);
                    s = __builtin_amdgcn_mfma_f32_32x32x16_bf16(kf, Qf[s8], s, 0, 0, 0); }
                __builtin_amdgcn_sched_barrier(0);
                const LAS float* tbp = tb + hd * TB_N + (kb * 128 + 32 * kt + 4 * h - 32 * qt - c + 160);
                float mx = -3.0e38f;
#pragma unroll
                for (int i = 0; i < 16; ++i) { s[i] += tbp[8 * (i >> 2) + (i & 3)]; mx = fmaxf(mx, s[i]); }
                mx = fmaxf(mx, __shfl_xor(mx, 32));
                const float m_new = fmaxf(m_run, mx), alpha = __builtin_amdgcn_exp2f(m_run - m_new); m_run = m_new;
                float ls = 0.f;
#pragma unroll
                for (int i = 0; i < 16; ++i) { s[i] = __builtin_amdgcn_exp2f(s[i] - m_new); ls += s[i]; }
                l_run = l_run * alpha + ls;
                if (__builtin_amdgcn_ballot_w64(alpha != 1.0f) != 0ull) {
#pragma unroll
                    for (int dt = 0; dt < 4; ++dt)
#pragma unroll
                        for (int i = 0; i < 16; ++i) O[dt][i] *= alpha; }
                bf16x8 Pf[2];
#pragma unroll
                for (int s2 = 0; s2 < 2; ++s2) { u32x4 w; w.x = cvt_pk_bf16(s[8 * s2 + 0], s[8 * s2 + 1]); w.y = cvt_pk_bf16(s[8 * s2 + 2], s[8 * s2 + 3]);
                    w.z = cvt_pk_bf16(s[8 * s2 + 4], s[8 * s2 + 5]); w.w = cvt_pk_bf16(s[8 * s2 + 6], s[8 * s2 + 7]); Pf[s2] = __builtin_bit_cast(bf16x8, w); }
                __builtin_amdgcn_sched_barrier(0);
#pragma unroll
                for (int dt = 0; dt < 4; ++dt) {
                    if (dt == 2) __builtin_amdgcn_sched_barrier(0);
#pragma unroll
                    for (int s2 = 0; s2 < 2; ++s2) { const LAS unsigned char* vp = lds + R_VT + (32 * dt + c) * VT_PITCH + (32 * kt + 16 * s2 + 4 * h) * 2;
                        const u32x2 lo = *(const LAS u32x2*)vp, hi = *(const LAS u32x2*)(vp + 16);
                        const u32x4 w = {lo.x, lo.y, hi.x, hi.y};
                        O[dt] = __builtin_amdgcn_mfma_f32_32x32x16_bf16(__builtin_bit_cast(bf16x8, w), Pf[s2], O[dt], 0, 0, 0); } }
                __builtin_amdgcn_sched_barrier(0);
            }
        }
        }
        {
            const float inv = __builtin_amdgcn_rcpf(l_run + __shfl_xor(l_run, 32));
            u32x2 t2[4][4];
#pragma unroll
            for (int dt = 0; dt < 4; ++dt)
#pragma unroll
                for (int g4 = 0; g4 < 4; ++g4) { t2[dt][g4].x = cvt_pk_bf16(O[dt][4 * g4] * inv, O[dt][4 * g4 + 1] * inv); t2[dt][g4].y = cvt_pk_bf16(O[dt][4 * g4 + 2] * inv, O[dt][4 * g4 + 3] * inv); }
            bf16x8 Wf[8];
            { const float* wrow = a.in[I_WS] + (size_t)(hd * 128 + 32 * qt + c) * 128 + 8 * h;
#pragma unroll
              for (int s8 = 0; s8 < 8; ++s8) { const f32x4 w0 = *(const f32x4*)(wrow + 16 * s8), w1 = *(const f32x4*)(wrow + 16 * s8 + 4);
                  const f32x4 r0 = *(const LAS f32x4*)(rstd_l + 16 * s8 + 8 * h), r1 = *(const LAS f32x4*)(rstd_l + 16 * s8 + 8 * h + 4);
                  u32x4 w; w.x = cvt_pk_bf16(w0[0] * r0[0], w0[1] * r0[1]); w.y = cvt_pk_bf16(w0[2] * r0[2], w0[3] * r0[3]);
                  w.z = cvt_pk_bf16(w1[0] * r1[0], w1[1] * r1[1]); w.w = cvt_pk_bf16(w1[2] * r1[2], w1[3] * r1[3]); Wf[s8] = __builtin_bit_cast(bf16x8, w); } }
            const float bsp = a.in[I_BS][hd * 128 + 32 * qt + c];
            u32x2 t1[4][4];
#pragma unroll
            for (int ct = 0; ct < 4; ++ct) { f32x16 acc;
#pragma unroll
                for (int i = 0; i < 16; ++i) acc[i] = 0.f;
#pragma unroll
                for (int s8 = 0; s8 < 8; ++s8) { const int grow = hsel * 128 + 32 * ct + c; const bf16x8 gf = *(const LAS bf16x8*)(lds + R_GV + grow * 256 + (((2 * s8 + h) ^ (grow & 15)) * 16));
                    acc = __builtin_amdgcn_mfma_f32_32x32x16_bf16(gf, Wf[s8], acc, 0, 0, 0); }
#pragma unroll
                for (int g4 = 0; g4 < 4; ++g4) { const f32x4 gn = *(const f32x4*)(a.in[I_SGUG] + hd * 128 + 32 * ct + 8 * g4 + 4 * h);
                    t1[ct][g4].x = cvt_pk_bf16(acc[4 * g4] * gn[0] + bsp, acc[4 * g4 + 1] * gn[1] + bsp); t1[ct][g4].y = cvt_pk_bf16(acc[4 * g4 + 2] * gn[2] + bsp, acc[4 * g4 + 3] * gn[3] + bsp); } }
            const int tl0 = lane >> 4, ch8 = lane & 15;
            const size_t gu0 = ((size_t)(tok0 + 32 * qt) * DM + hd * 128) * 2;
            __syncthreads();
            LAS unsigned char* ex = lds + wave * EX_WAVE;
#pragma unroll
            for (int ct = 0; ct < 4; ++ct)
#pragma unroll
                for (int g4 = 0; g4 < 4; ++g4) { const int off = c * KT_PITCH + (32 * ct + 8 * g4 + 4 * h) * 2;
                    *(LAS u32x2*)(ex + off) = t1[ct][g4]; *(LAS u32x2*)(ex + EX_T2 + off) = t2[ct][g4]; }
            asm volatile("s_waitcnt lgkmcnt(0)" ::: "memory");
#pragma unroll 1
            for (int bt = 0; bt < 2; ++bt) {
                u32x4 cu[4], ca[4], cb[4];
#pragma unroll
                for (int k = 0; k < 4; ++k) { const size_t go = gu0 + (size_t)(16 * bt + 4 * k) * DM * 2; cu[k] = ldg16((const char*)Ug + go, offC); ca[k] = ldg16((const char*)SAg + go, offC); cb[k] = ldg16((const char*)SBg + go, offC); }
#pragma unroll
                for (int k = 0; k < 4; ++k) { const int tl = tl0 + 4 * k + 16 * bt;
                    const u32x4 a1 = *(const LAS u32x4*)(ex + tl * KT_PITCH + ch8 * 16), a2 = *(const LAS u32x4*)(ex + EX_T2 + tl * KT_PITCH + ch8 * 16);
                    u32x4 o;
#pragma unroll
                    for (int e = 0; e < 4; ++e) {
                        const float lo = bf_lo(ca[k][e]) * (bf_lo(cu[k][e]) * bf_lo(a1[e])) + bf_lo(cb[k][e]) * bf_lo(a2[e]);
                        const float hi = bf_hi(ca[k][e]) * (bf_hi(cu[k][e]) * bf_hi(a1[e])) + bf_hi(cb[k][e]) * bf_hi(a2[e]);
                        o[e] = cvt_pk_bf16(lo, hi); }
                    *(u32x4*)((char*)Mout + gu0 + (size_t)(4 * k + 16 * bt) * DM * 2 + offC) = o; }
            }
        }
        }
    }
#undef P2_PREFETCH
    __syncthreads();
}


__global__ void __launch_bounds__(512, 2) fwd_megakernel(Args a) {
    extern __shared__ __attribute__((aligned(16))) unsigned char shm[];
    LAS unsigned char* lds = (LAS unsigned char*)shm;
    const int tid = threadIdx.x, lane = tid & 63, wave = __builtin_amdgcn_readfirstlane(tid >> 6);
    const int G = gridDim.x, bx = blockIdx.x;
    const int vcu = (G % 8 == 0) ? (bx % 8) * (G / 8) + bx / 8 : bx;
    const int lo = a.ph_lo, hi = a.ph_hi;
#define IN(k) (lo <= (k) && (k) < hi)
#define SEAM(k) do { if (IN(k) && IN((k) + 1)) { cg::this_grid().sync(); } } while (0)
    if (IN(0)) for (int rep = (PROBE_DUP == 0 ? 0 : 1); rep < 2; ++rep) { p0_phase(lds, a, vcu, G, wave, lane); __syncthreads(); }
    SEAM(0);
    if (IN(1)) for (int rep = (PROBE_DUP == 1 ? 0 : 1); rep < 2; ++rep) {
        pg8::StaticOrder S; S.init(MTOK, NIN, G, bx);
        P1Ptrs P{(const bf16_t*)((unsigned char*)a.out + DO_H), (const bf16_t*)(a.ws + WS_WT)};
        EpiP1 E{a.ws, (unsigned char*)a.out};
        pg8::gemm_phase(lds, DM, S, P, E);
    }
    SEAM(1);
    if (IN(2)) for (int rep = (PROBE_DUP == 2 ? 0 : 1); rep < 2; ++rep) p2_phase(lds, a, vcu, G, rep == 0 ? (bf16_t*)((unsigned char*)a.out + DO_H) : (bf16_t*)(a.ws + WS_U));
    SEAM(2);
    if (IN(3)) for (int rep = (PROBE_DUP == 3 ? 0 : 1); rep < 2; ++rep) {
        pg8::StaticOrder S; S.init(MTOK, DM, G, bx);
        pg8::PlainPtrs P{(const bf16_t*)(a.ws + WS_U), (const bf16_t*)(a.ws + WS_WOT), DM};
        EpiWo E{a.in[I_XP], a.in[I_XS], (bf16_t*)(a.ws + WS_Q), (float*)(a.ws + WS_PART)};
        pg8::gemm_phase(lds, DM, S, P, E);
    }
    SEAM(3);
    if (IN(4)) for (int rep = (PROBE_DUP == 4 ? 0 : 1); rep < 2; ++rep) {
        pg8::StaticOrder S; S.init(MTOK, DFF, G, bx);
        pg8::PlainPtrs P{(const bf16_t*)(a.ws + WS_Q), (const bf16_t*)(a.ws + WS_W1T), DM};
        EpiFF1 E{(bf16_t*)(a.ws + WS_HID)};
        pg8::gemm_phase(lds, DM, S, P, E);
    }
    SEAM(4);
    if (IN(5)) for (int rep = (PROBE_DUP == 5 ? 0 : 1); rep < 2; ++rep) {
        pg8::StaticOrder S; S.init(MTOK, DM, G, bx);
        pg8::PlainPtrs P{(const bf16_t*)(a.ws + WS_HID), (const bf16_t*)(a.ws + WS_W2T), DFF};
        LAS float* tab = (LAS float*)(lds + R_FF2TAB);
        for (int i = 0; i < 8; ++i) { Unit u; if (!S.next(i, u)) break;
            if (tid < 256) { const f32x4* pp = (const f32x4*)((const float*)(a.ws + WS_PART) + (size_t)(u.pm * 256 + tid) * 16); const f32x4 p0 = pp[0], p1 = pp[1], p2 = pp[2], p3 = pp[3];
                const float ss = ((p0[0] + p0[1]) + (p0[2] + p0[3])) + ((p1[0] + p1[1]) + (p1[2] + p1[3])) + ((p2[0] + p2[1]) + (p2[2] + p2[3])) + ((p3[0] + p3[1]) + (p3[2] + p3[3]));
                tab[i * 256 + tid] = __builtin_amdgcn_rcpf(ss * (1.0f / DM) + EPS); } }
        __syncthreads();
        EpiFF2 E{a.out, (const bf16_t*)(a.ws + WS_Q), tab};
        pg8::gemm_phase(lds, DFF, S, P, E);
    }
#undef IN
#undef SEAM
}

extern "C" void kernel_launch(void* const* d_in, const int* in_sizes, int n_in, void* d_out, int out_size, void* d_ws, size_t ws_size, hipStream_t stream) {
    static int grid = 0;
    if (grid == 0) {
        if (n_in != 15 || out_size != MTOK * DM || ws_size < WS_END) { fprintf(stderr, "kernel_launch: unexpected shapes (n_in %d out %d ws %zu)\n", n_in, out_size, ws_size); grid = -1; return; }
        int dev = 0, cus = 0, per_cu = 0;
        hipGetDevice(&dev); hipDeviceGetAttribute(&cus, hipDeviceAttributeMultiprocessorCount, dev);
        if (hipFuncSetAttribute((const void*)fwd_megakernel, hipFuncAttributeMaxDynamicSharedMemorySize, LDS_BYTES) != hipSuccess) { fprintf(stderr, "kernel_launch: hipFuncSetAttribute failed\n"); grid = -1; return; }
        hipOccupancyMaxActiveBlocksPerMultiprocessor(&per_cu, (const void*)fwd_megakernel, 512, LDS_BYTES);
        if (per_cu < 1) { fprintf(stderr, "kernel_launch: occupancy query says %d blocks/CU\n", per_cu); per_cu = 1; }
        (void)hipGetLastError();
        grid = cus * per_cu;
    }
    if (grid < 0) return;
    Args a{};
    for (int i = 0; i < 15; ++i) a.in[i] = (const float*)d_in[i];
    a.out = (float*)d_out; a.ws = (unsigned char*)d_ws;
    if (N_LAUNCHES == 1) {
        a.ph_lo = 0; a.ph_hi = 6;
        void* args[] = {&a};
        hipError_t e = hipLaunchCooperativeKernel((const void*)fwd_megakernel, dim3(grid), dim3(512), args, LDS_BYTES, stream);
        if (e != hipSuccess) fprintf(stderr, "cooperative launch failed: %s (grid %d)\n", hipGetErrorString(e), grid);
    } else {
        for (int p = 0; p < 6; ++p) { a.ph_lo = p; a.ph_hi = p + 1; hipLaunchKernelGGL(fwd_megakernel, dim3(grid), dim3(512), LDS_BYTES, stream, a); }
    }
}
```

```cpp
#include <hip/hip_runtime.h>
#include <hip/hip_cooperative_groups.h>
#include <cstdio>
namespace cg = cooperative_groups;

#define LAS __attribute__((address_space(3)))
typedef unsigned short bf16_t;
typedef short bf16x8 __attribute__((ext_vector_type(8)));
typedef float f32x4 __attribute__((ext_vector_type(4)));
typedef float f32x16 __attribute__((ext_vector_type(16)));
typedef unsigned u32x4 __attribute__((ext_vector_type(4)));
typedef unsigned u32x2 __attribute__((ext_vector_type(2)));

#ifndef PROBE_DUP
#define PROBE_DUP -1
#endif
#ifndef N_LAUNCHES
#define N_LAUNCHES 1
#endif

constexpr int MP = 8 * 4096, MS = 8 * 8192, MTOK = MP + MS;
constexpr int DM = 1024, NIN = 5632, DFF = 4096;
constexpr float EPS = 1e-6f;
constexpr float LOG2E = 1.4426950408889634f;
constexpr size_t MiB = 1u << 20;
constexpr size_t WS_WT = 0, WS_WOT = 12 * MiB, WS_W1T = 14 * MiB, WS_W2T = 22 * MiB;
constexpr size_t WS_Q = 32 * MiB;
constexpr size_t WS_U = 224 * MiB;
constexpr size_t WS_SA = 416 * MiB, WS_SB = 608 * MiB;
constexpr size_t WS_K = 800 * MiB;
constexpr size_t WS_VT = 848 * MiB;
constexpr size_t WS_HID = 224 * MiB;
constexpr size_t WS_PART = 992 * MiB;
constexpr size_t WS_END = 1000 * MiB;
constexpr size_t DO_H = 0, DO_GVT = 192 * MiB;

constexpr int KT_PITCH = 272, VT_PITCH = 264;
constexpr int R_KT = 0, R_VT = 34816, R_GV = 68608;
constexpr int EX_WAVE = 17408, EX_T2 = 8704;
constexpr int R_TB = 139264, TB_N = 320, R_RSTD = R_TB + 8 * TB_N * 4, R_RED = R_RSTD + 512;
constexpr int LDS_BYTES = 155648;
static_assert(R_RED + 4096 <= LDS_BYTES, "lds map");

__device__ __forceinline__ unsigned cvt_pk_bf16(float lo, float hi) { unsigned r; asm volatile("v_cvt_pk_bf16_f32 %0, %1, %2" : "=v"(r) : "v"(lo), "v"(hi)); return r; }
__device__ __forceinline__ float bf_lo(unsigned w) { return __uint_as_float(w << 16); }
__device__ __forceinline__ float bf_hi(unsigned w) { return __uint_as_float(w & 0xffff0000u); }
typedef float f32x2 __attribute__((ext_vector_type(2)));
template <int CTRL> __device__ __forceinline__ float dpp(float x) { return __builtin_bit_cast(float, __builtin_amdgcn_mov_dpp(__builtin_bit_cast(int, x), CTRL, 0xf, 0xf, true)); }
__device__ __forceinline__ float row16_sum(float x) { x += dpp<0xB1>(x); x += dpp<0x4E>(x); x += dpp<0x141>(x); x += dpp<0x128>(x); return x; }
__device__ __forceinline__ float x16_sum(float x) { auto s = __builtin_amdgcn_permlane16_swap(__float_as_uint(x), __float_as_uint(x), false, false); return __uint_as_float(s[0]) + __uint_as_float(s[1]); }
__device__ __forceinline__ float x32_sum(float x) { auto s = __builtin_amdgcn_permlane32_swap(__float_as_uint(x), __float_as_uint(x), false, false); return __uint_as_float(s[0]) + __uint_as_float(s[1]); }
__device__ __forceinline__ float x32_max(float x) { auto s = __builtin_amdgcn_permlane32_swap(__float_as_uint(x), __float_as_uint(x), false, false); return fmaxf(__uint_as_float(s[0]), __uint_as_float(s[1])); }
__device__ __forceinline__ f32x2 gelu2(f32x2 x) { const f32x2 u = x * x, p = u * (0.044715f * -2.302208198f) + (-2.302208198f), t = x * p; f32x2 e; e.x = __builtin_amdgcn_exp2f(t.x); e.y = __builtin_amdgcn_exp2f(t.y);
    const f32x2 d = e + 1.0f; f32x2 r; r.x = __builtin_amdgcn_rcpf(d.x); r.y = __builtin_amdgcn_rcpf(d.y); return x * r; }
__device__ __forceinline__ f32x2 sigmoid2(f32x2 x) { const f32x2 t = x * (-LOG2E); f32x2 e; e.x = __builtin_amdgcn_exp2f(t.x); e.y = __builtin_amdgcn_exp2f(t.y);
    const f32x2 d = e + 1.0f; f32x2 r; r.x = __builtin_amdgcn_rcpf(d.x); r.y = __builtin_amdgcn_rcpf(d.y); return r; }
__device__ __forceinline__ float gelu_tanh(float x) { const float t = x * (1.0f + 0.044715f * x * x) * (-2.302208198f); return x * __builtin_amdgcn_rcpf(1.0f + __builtin_amdgcn_exp2f(t)); }
__device__ __forceinline__ float sigmoidf(float x) { return __builtin_amdgcn_rcpf(1.0f + __builtin_amdgcn_exp2f(-LOG2E * x)); }

namespace pg8 {
constexpr int BM = 256, BK = 64, HALF = 128, HTB = HALF * BK * 2, STAGE_BYTES = 8 * HTB, NXCD = 8, WGM = 8;
__host__ __device__ __forceinline__ int lds_byte(int r, int c) { const int st = (r >> 4) * 2 + (c >> 5), rr = r & 15, cc = c & 31, ob = rr * 64 + cc * 2; return st * 1024 + (ob ^ (((ob >> 9) & 1) << 5)); }
__host__ __device__ __forceinline__ void stage_rc(int b, int& R, int& C) { const int st = b / 1024, sb = b % 1024, swz = sb ^ (((sb >> 9) & 1) << 5); R = (st >> 1) * 16 + swz / 64; C = (st & 1) * 32 + (swz % 64) / 2; }
__host__ __device__ __forceinline__ int perm32(int rho) { const int n = rho >> 4, i = rho & 15; return 8 * (i >> 2) + 4 * n + (i & 3); }
struct Unit { int pm, pn; };
struct StaticOrder {
    int nM, nN, nwg, G, c;
    __device__ void init(int M, int N, int G_, int c_) { nM = M / BM; nN = N / BM; nwg = nM * nN; G = G_; c = c_; }
    __device__ bool next(int i, Unit& u) const {
        const long L = (long)i * G + c; if (L >= nwg) return false;
        int wgid = (int)L; { const int q = nwg / NXCD, r = nwg % NXCD, xcd = wgid % NXCD, off = wgid / NXCD; wgid = (xcd < r ? xcd * (q + 1) : r * (q + 1) + (xcd - r) * q) + off; }
        const int nig = WGM * nN, gid = wgid / nig, fm = gid * WGM, gsz = (nM - fm) < WGM ? (nM - fm) : WGM;
        u.pm = fm + ((wgid % nig) % gsz); u.pn = (wgid % nig) / gsz; return true;
    }
};
struct PlainPtrs { const bf16_t* A; const bf16_t* Bt; int K;
    __device__ __forceinline__ void get(const Unit& u, const char*& a, const char*& b) const { a = (const char*)A + (size_t)u.pm * 512 * K; b = (const char*)Bt + (size_t)u.pn * 512 * K; } };

template <class Epi, class Ptrs>
__device__ __forceinline__ void gemm_phase(LAS unsigned char* lds, const int K, const StaticOrder& S, const Ptrs& P, const Epi& E) {
    const int tid = threadIdx.x, wid = __builtin_amdgcn_readfirstlane(tid >> 6), lane = tid & 63, wr = wid >> 2, wc = wid & 3, fr = lane & 15, fq = lane >> 4;
    const int nt = K / BK;
    unsigned voffA[2], voffB[2];
#pragma unroll
    for (int i = 0; i < 2; ++i) { int R, C; stage_rc(tid * 16 + i * 8192, R, C); const int Rb = (R & ~31) + perm32(R & 31);
        voffA[i] = (unsigned)(R * K + C) * 2u; voffB[i] = (unsigned)(Rb * K + C) * 2u; }
    const size_t kstep = (size_t)(BK * 2);
    const size_t hstep = (size_t)HALF * K * 2;
    const unsigned ldsw = (unsigned)wid * 1024u;
    const int aoff = lds_byte(wr * 64 + fr, fq * 8), boff = lds_byte(wc * 32 + fr, fq * 8);
#define PG8_SA(b, h) (((b) * 2 + (h)) * HTB)
#define PG8_SB(b, h) ((4 + (b) * 2 + (h)) * HTB)
#define PG8_STAGE(bufoff, gbase, voff) do { _Pragma("unroll") for (int _i = 0; _i < 2; ++_i) \
        __builtin_amdgcn_global_load_lds((const unsigned*)((const char*)(gbase) + (voff)[_i]), (LAS unsigned*)(lds + (bufoff) + ldsw + _i * 8192), 16, 0, 0); } while (0)
#define PG8_LDA(dst, b, h) do { _Pragma("unroll") for (int m = 0; m < 4; ++m) _Pragma("unroll") for (int k = 0; k < 2; ++k) dst[m][k] = *(const LAS bf16x8*)(lds + PG8_SA(b, h) + aoff + m * 2048 + k * 1024); } while (0)
#define PG8_LDB(dst, b, h) do { _Pragma("unroll") for (int n = 0; n < 2; ++n) _Pragma("unroll") for (int k = 0; k < 2; ++k) dst[n][k] = *(const LAS bf16x8*)(lds + PG8_SB(b, h) + boff + n * 2048 + k * 1024); } while (0)
#define PG8_MMA(ai, bj, At, Bt) do { __builtin_amdgcn_s_setprio(1); _Pragma("unroll") for (int m = 0; m < 4; ++m) _Pragma("unroll") for (int n = 0; n < 2; ++n) _Pragma("unroll") for (int k = 0; k < 2; ++k) \
        acc[ai][bj][m][n] = __builtin_amdgcn_mfma_f32_16x16x32_bf16(Bt[n][k], At[m][k], acc[ai][bj][m][n], 0, 0, 0); __builtin_amdgcn_s_setprio(0); } while (0)
#define PG8_WAIT_V(n) asm volatile("s_waitcnt vmcnt(" #n ")" ::: "memory")
#define PG8_WAIT_L(n) asm volatile("s_waitcnt lgkmcnt(" #n ")" ::: "memory")
#define PG8_BAR __builtin_amdgcn_s_barrier()
#define PG8_SCHED __builtin_amdgcn_sched_barrier(0)
    Unit cur, nxt; int ui = 0;
    if (!S.next(0, cur)) return;
    f32x4 acc[2][2][4][2];
#pragma unroll
    for (int a = 0; a < 2; ++a)
#pragma unroll
        for (int b = 0; b < 2; ++b)
#pragma unroll
            for (int m = 0; m < 4; ++m)
#pragma unroll
                for (int n = 0; n < 2; ++n) acc[a][b][m][n] = (f32x4){0.f, 0.f, 0.f, 0.f};
    bf16x8 At[4][2], B0[2][2], B1[2][2];
    const char* cA; const char* cB; P.get(cur, cA, cB);
    PG8_STAGE(PG8_SB(0, 0), cB, voffB); PG8_STAGE(PG8_SA(0, 0), cA, voffA); PG8_STAGE(PG8_SB(0, 1), cB + hstep, voffB); PG8_STAGE(PG8_SA(0, 1), cA + hstep, voffA);
    if (wr == 1) PG8_BAR;
    PG8_WAIT_V(4); PG8_BAR;
    PG8_STAGE(PG8_SB(1, 0), cB + kstep, voffB); PG8_STAGE(PG8_SA(1, 0), cA + kstep, voffA); PG8_STAGE(PG8_SB(1, 1), cB + hstep + kstep, voffB);
    PG8_WAIT_V(6); PG8_BAR;
    for (;;) {
        const bool has_next = S.next(ui + 1, nxt);
        const char* nA = cA; const char* nB = cB; if (has_next) P.get(nxt, nA, nB);
        for (int t = 0; t < nt; t += 2) {
            const bool last = (t == nt - 2);
            const char* a1 = cA + (size_t)(t + 1) * kstep;
            const char* a2 = last ? nA : cA + (size_t)(t + 2) * kstep; const char* b2 = last ? nB : cB + (size_t)(t + 2) * kstep;
            const char* a3 = a2 + kstep; const char* b3 = b2 + kstep;
            PG8_LDB(B0, 0, 0); PG8_SCHED; PG8_LDA(At, 0, 0); PG8_STAGE(PG8_SA(1, 1), a1 + hstep, voffA);
            PG8_WAIT_L(8); PG8_BAR; PG8_WAIT_L(0); PG8_MMA(0, 0, At, B0); PG8_BAR; PG8_SCHED;
            PG8_LDB(B1, 0, 1); PG8_STAGE(PG8_SB(0, 0), b2, voffB);
            PG8_BAR; PG8_WAIT_L(0); PG8_MMA(0, 1, At, B1); PG8_BAR;
            PG8_LDA(At, 0, 1); PG8_STAGE(PG8_SA(0, 0), a2, voffA);
            PG8_BAR; PG8_WAIT_L(0); PG8_MMA(1, 0, At, B0); PG8_BAR; PG8_SCHED;
            PG8_STAGE(PG8_SB(0, 1), b2 + hstep, voffB);
            PG8_WAIT_V(6); PG8_BAR; PG8_MMA(1, 1, At, B1); PG8_BAR;
            PG8_LDB(B0, 1, 0); PG8_SCHED; PG8_LDA(At, 1, 0); PG8_STAGE(PG8_SA(0, 1), a2 + hstep, voffA);
            PG8_WAIT_L(8); PG8_BAR; PG8_WAIT_L(0); PG8_MMA(0, 0, At, B0); PG8_BAR; PG8_SCHED;
            PG8_LDB(B1, 1, 1); PG8_STAGE(PG8_SB(1, 0), b3, voffB);
            PG8_BAR; PG8_WAIT_L(0); PG8_MMA(0, 1, At, B1); PG8_BAR;
            PG8_LDA(At, 1, 1); PG8_STAGE(PG8_SA(1, 0), a3, voffA);
            PG8_BAR; PG8_WAIT_L(0); PG8_MMA(1, 0, At, B0); PG8_BAR; PG8_SCHED;
            PG8_STAGE(PG8_SB(1, 1), b3 + hstep, voffB);
            PG8_WAIT_V(6); PG8_BAR; PG8_MMA(1, 1, At, B1); PG8_BAR;
        }
        E(acc, cur, ui, wr, wc, fr, fq);
        if (!has_next) break;
#pragma unroll
        for (int a = 0; a < 2; ++a)
#pragma unroll
            for (int b = 0; b < 2; ++b)
#pragma unroll
                for (int m = 0; m < 4; ++m)
#pragma unroll
                    for (int n = 0; n < 2; ++n) acc[a][b][m][n] = (f32x4){0.f, 0.f, 0.f, 0.f};
        cur = nxt; cA = nA; cB = nB; ++ui;
    }
    PG8_WAIT_V(0);
    if (wr == 0) PG8_BAR;
    PG8_BAR;
#undef PG8_SA
#undef PG8_SB
#undef PG8_STAGE
#undef PG8_LDA
#undef PG8_LDB
#undef PG8_MMA
#undef PG8_WAIT_V
#undef PG8_WAIT_L
#undef PG8_BAR
#undef PG8_SCHED
}
}
using pg8::Unit;

struct Args { const float* in[15]; float* out; unsigned char* ws; int ph_lo, ph_hi; };
enum { I_XP = 0, I_XS, I_RELB, I_N1G, I_WIN, I_SGUG, I_WS, I_BS, I_QG, I_KG, I_SINK, I_WO, I_N2G, I_W1, I_W2 };

struct P1Ptrs { const bf16_t* H; const bf16_t* Wt;
    __device__ __forceinline__ void get(const Unit& u, const char*& a, const char*& b) const {
        const char* hp = (const char*)H + (size_t)u.pm * 512 * DM; const char* wp = (const char*)Wt + (size_t)u.pn * 512 * DM;
        if (u.pn < 17) { a = hp; b = wp; } else { a = wp; b = hp; } } };
__device__ __forceinline__ u32x4 pack8(f32x4 v0, f32x4 v1) { u32x4 w; w.x = cvt_pk_bf16(v0[0], v0[1]); w.y = cvt_pk_bf16(v0[2], v0[3]); w.z = cvt_pk_bf16(v1[0], v1[1]); w.w = cvt_pk_bf16(v1[2], v1[3]); return w; }
__device__ __forceinline__ f32x4 gelu4(f32x4 v) { const f32x2 a = gelu2((f32x2){v[0], v[1]}), b = gelu2((f32x2){v[2], v[3]}); return (f32x4){a.x, a.y, b.x, b.y}; }
__device__ __forceinline__ f32x4 sigmoid4(f32x4 v) { const f32x2 a = sigmoid2((f32x2){v[0], v[1]}), b = sigmoid2((f32x2){v[2], v[3]}); return (f32x4){a.x, a.y, b.x, b.y}; }
struct EpiP1 {
    unsigned char* ws; unsigned char* dout;
    __device__ __forceinline__ void operator()(const f32x4 (&acc)[2][2][4][2], const Unit& u, int ui, int wr, int wc, int fr, int fq) const {
        const int pn = u.pn;
        if (pn < 8) {
            bf16_t* base = (bf16_t*)(ws + WS_U) + (size_t)(u.pm * 256 + wr * 64 + fr) * DM + pn * 128 + wc * 32 + 8 * fq;
#pragma unroll
            for (int ai = 0; ai < 2; ++ai)
#pragma unroll
                for (int m = 0; m < 4; ++m) {
                    const f32x4 g0 = gelu4(acc[ai][0][m][0]) * sigmoid4(acc[ai][1][m][0]), g1 = gelu4(acc[ai][0][m][1]) * sigmoid4(acc[ai][1][m][1]);
                    *(u32x4*)(base + (size_t)(ai * 128 + m * 16) * DM) = pack8(g0, g1); }
            return; }
        if (pn >= 17 && pn < 21) {
            bf16_t* base = (bf16_t*)(dout + DO_GVT) + (size_t)((pn - 17) * 256 + wr * 64 + fr) * MTOK + u.pm * 256 + wc * 32 + 8 * fq;
            float* pp = (float*)(ws + WS_PART) + (size_t)(u.pm * 256 + wc * 32 + 8 * fq) * 8 + (pn - 17) * 2 + wr;
#pragma unroll
            for (int bj = 0; bj < 2; ++bj) { f32x4 sq0 = {0.f, 0.f, 0.f, 0.f}, sq1 = {0.f, 0.f, 0.f, 0.f};
#pragma unroll
                for (int ai = 0; ai < 2; ++ai)
#pragma unroll
                    for (int m = 0; m < 4; ++m) { const f32x4 g0 = gelu4(acc[ai][bj][m][0]), g1 = gelu4(acc[ai][bj][m][1]);
                        sq0 += g0 * g0; sq1 += g1 * g1;
                        *(u32x4*)(base + (size_t)(ai * 128 + m * 16) * MTOK + bj * 128) = pack8(g0, g1); }
#pragma unroll
                for (int j = 0; j < 4; ++j) { const float t0 = row16_sum(sq0[j]), t1 = row16_sum(sq1[j]); if (fr == 0) { pp[(size_t)(bj * 128 + j) * 8] = t0; pp[(size_t)(bj * 128 + 4 + j) * 8] = t1; } } }
            return; }
        bf16_t* base; size_t ld; int row0, col0, act;
        if (pn < 12)      { base = (bf16_t*)(ws + WS_Q);  ld = DM;  row0 = u.pm * 256; col0 = (pn - 8) * 256;  act = 0; }
        else if (pn < 13) { base = (bf16_t*)(ws + WS_K);  ld = 256; row0 = u.pm * 256; col0 = 0;               act = 0; }
        else if (pn < 17) { base = (bf16_t*)(ws + WS_SB); ld = DM;  row0 = u.pm * 256; col0 = (pn - 13) * 256; act = 2; }
        else              { base = (bf16_t*)(ws + WS_VT); ld = MTOK; row0 = 0; col0 = u.pm * 256; act = 0; }
        const int r0 = row0 + wr * 64 + fr, c0 = col0 + wc * 32 + 8 * fq;
#pragma unroll
        for (int ai = 0; ai < 2; ++ai)
#pragma unroll
            for (int m = 0; m < 4; ++m) { bf16_t* rowp = base + (size_t)(r0 + ai * 128 + m * 16) * ld + c0;
#pragma unroll
                for (int bj = 0; bj < 2; ++bj) { f32x4 v0 = acc[ai][bj][m][0], v1 = acc[ai][bj][m][1];
                    if (act == 2) { v0 = sigmoid4(v0); v1 = sigmoid4(v1); }
                    *(u32x4*)(rowp + bj * 128) = pack8(v0, v1); } }
    }
};
struct EpiWo {
    const float* xp; const float* xs; bf16_t* xb; float* part;
    __device__ __forceinline__ void operator()(const f32x4 (&acc)[2][2][4][2], const Unit& u, int ui, int wr, int wc, int fr, int fq) const {
        const int row0 = u.pm * 256 + wr * 64 + fr, col0 = u.pn * 256 + wc * 32 + 8 * fq;
        const float* xb0 = (u.pm * 256 < MP) ? xp : xs - (size_t)MP * DM;
#pragma unroll
        for (int ai = 0; ai < 2; ++ai) {
            f32x4 xv[4][2][2];
#pragma unroll
            for (int m = 0; m < 4; ++m)
#pragma unroll
                for (int bj = 0; bj < 2; ++bj) { const float* p = xb0 + (size_t)(row0 + ai * 128 + m * 16) * DM + col0 + bj * 128; xv[m][bj][0] = *(const f32x4*)p; xv[m][bj][1] = *(const f32x4*)(p + 4); }
#pragma unroll
            for (int m = 0; m < 4; ++m) { const int row = row0 + ai * 128 + m * 16; const size_t off = (size_t)row * DM + col0; float ss = 0.f;
#pragma unroll
                for (int bj = 0; bj < 2; ++bj) {
                    const f32x4 v0 = acc[ai][bj][m][0] + xv[m][bj][0], v1 = acc[ai][bj][m][1] + xv[m][bj][1];
                    u32x4 w; w.x = cvt_pk_bf16(v0[0], v0[1]); w.y = cvt_pk_bf16(v0[2], v0[3]); w.z = cvt_pk_bf16(v1[0], v1[1]); w.w = cvt_pk_bf16(v1[2], v1[3]);
                    *(u32x4*)(xb + off + bj * 128) = w;
                    ss += (v0[0] * v0[0] + v0[1] * v0[1]) + (v0[2] * v0[2] + v0[3] * v0[3]) + (v1[0] * v1[0] + v1[1] * v1[1]) + (v1[2] * v1[2] + v1[3] * v1[3]); }
                ss = x32_sum(x16_sum(ss));
                if (fq == 0) part[(size_t)row * 16 + u.pn * 4 + wc] = ss; }
        }
    }
};
struct EpiFF1 {
    bf16_t* hid;
    __device__ __forceinline__ void operator()(const f32x4 (&acc)[2][2][4][2], const Unit& u, int ui, int wr, int wc, int fr, int fq) const {
        const int row0 = u.pm * 256 + wr * 64 + fr, col0 = u.pn * 256 + wc * 32 + 8 * fq;
#pragma unroll
        for (int ai = 0; ai < 2; ++ai)
#pragma unroll
            for (int m = 0; m < 4; ++m) { bf16_t* rowp = hid + (size_t)(row0 + ai * 128 + m * 16) * DFF + col0;
#pragma unroll
                for (int bj = 0; bj < 2; ++bj) { f32x4 v0 = acc[ai][bj][m][0], v1 = acc[ai][bj][m][1];
#pragma unroll
                    for (int j = 0; j < 4; ++j) { const float a = fmaxf(v0[j], 0.f), b = fmaxf(v1[j], 0.f); v0[j] = a * a; v1[j] = b * b; }
                    u32x4 w; w.x = cvt_pk_bf16(v0[0], v0[1]); w.y = cvt_pk_bf16(v0[2], v0[3]); w.z = cvt_pk_bf16(v1[0], v1[1]); w.w = cvt_pk_bf16(v1[2], v1[3]);
                    *(u32x4*)(rowp + bj * 128) = w; } }
    }
};
constexpr int R_FF2TAB = 131072;
struct EpiFF2 {
    float* out; const bf16_t* xb; const LAS float* tab;
    __device__ __forceinline__ void operator()(const f32x4 (&acc)[2][2][4][2], const Unit& u, int ui, int wr, int wc, int fr, int fq) const {
        const int rl0 = wr * 64 + fr, col0 = u.pn * 256 + wc * 32 + 8 * fq;
        u32x4 xv[2][4][2];
#pragma unroll
        for (int ai = 0; ai < 2; ++ai)
#pragma unroll
            for (int m = 0; m < 4; ++m)
#pragma unroll
                for (int bj = 0; bj < 2; ++bj) xv[ai][m][bj] = *(const u32x4*)(xb + (size_t)(u.pm * 256 + rl0 + ai * 128 + m * 16) * DM + col0 + bj * 128);
#pragma unroll
        for (int ai = 0; ai < 2; ++ai)
#pragma unroll
            for (int m = 0; m < 4; ++m) { const int rl = rl0 + ai * 128 + m * 16; float* rowp = out + (size_t)(u.pm * 256 + rl) * DM + col0;
                const float r2 = tab[ui * 256 + rl];
#pragma unroll
                for (int bj = 0; bj < 2; ++bj) { const u32x4 x = xv[ai][m][bj];
                    const f32x4 x0 = {bf_lo(x.x), bf_hi(x.x), bf_lo(x.y), bf_hi(x.y)}, x1 = {bf_lo(x.z), bf_hi(x.z), bf_lo(x.w), bf_hi(x.w)};
                    *(f32x4*)(rowp + bj * 128) = acc[ai][bj][m][0] * r2 + x0; *(f32x4*)(rowp + bj * 128 + 4) = acc[ai][bj][m][1] * r2 + x1; } }
    }
};

__device__ __forceinline__ void p0_transpose_blk(const float* W, int ldw, const float* kscale, bf16_t* WT, int K, int k0, int n0src, int n0dst, LAS float* scr, int lane) {
#pragma unroll 8
    for (int i = 0; i < 32; ++i) { const int kk = 2 * i + (lane >> 5); float v = W[(size_t)(k0 + kk) * ldw + n0src + (lane & 31)]; if (kscale) v *= kscale[k0 + kk]; scr[kk * 33 + (lane & 31)] = v; }
    asm volatile("s_waitcnt lgkmcnt(0)" ::: "memory");
    const int c = lane & 7;
#pragma unroll
    for (int j = 0; j < 4; ++j) { const int n = (lane >> 3) + 8 * j; const LAS float* s = scr + (8 * c) * 33 + n;
        u32x4 o; o.x = cvt_pk_bf16(s[0 * 33], s[1 * 33]); o.y = cvt_pk_bf16(s[2 * 33], s[3 * 33]); o.z = cvt_pk_bf16(s[4 * 33], s[5 * 33]); o.w = cvt_pk_bf16(s[6 * 33], s[7 * 33]);
        *(u32x4*)(WT + (size_t)(n0dst + n) * K + k0 + 8 * c) = o; }
    asm volatile("s_waitcnt lgkmcnt(0)" ::: "memory");
}
__device__ __forceinline__ int win_src_col(int d) {
    if (d < 2048) { const int j = d >> 8, w = d & 255; return w < 128 ? 128 * j + w : 3584 + 128 * j + (w - 128); }
    if (d < 3072) return 2048 + (d - 2048);
    if (d < 3328) return 3072 + (d - 3072);
    if (d < 4352) return 4608 + (d - 3328);
    if (d < 5376) return 1024 + (d - 4352);
    return 3328 + (d - 5376);
}
__device__ __forceinline__ float wave_sum(float v) { return x32_sum(x16_sum(row16_sum(v))); }
__device__ __forceinline__ void p0_phase(LAS unsigned char* lds, const Args& a, int vcu, int G, int wave, int lane) {
    LAS float* scr = (LAS float*)(lds + wave * 16384);
    const int gw = vcu * 8 + wave, NGW = G * 8;
    bf16_t* Wt = (bf16_t*)(a.ws + WS_WT);
    const float* win = a.in[I_WIN];
    constexpr int I_IN = 16 * (NIN / 32), I_O = 16 * 32, I_1 = 16 * (DFF / 32), I_2 = 64 * 32;
    for (int it = gw; it < I_IN + I_O + I_1 + I_2; it += NGW) {
        int r = it;
        if (r < I_IN) { const int kb = r / (NIN / 32), nb = r % (NIN / 32); p0_transpose_blk(win, NIN, nullptr, Wt, DM, 64 * kb, win_src_col(32 * nb), 32 * nb, scr, lane); continue; }
        r -= I_IN;
        if (r < I_O) { const int kb = r / 32, nb = r % 32; p0_transpose_blk(a.in[I_WO], DM, nullptr, (bf16_t*)(a.ws + WS_WOT), DM, 64 * kb, 32 * nb, 32 * nb, scr, lane); continue; } r -= I_O;
        if (r < I_1) { const int kb = r / 128, nb = r % 128; p0_transpose_blk(a.in[I_W1], DFF, a.in[I_N2G], (bf16_t*)(a.ws + WS_W1T), DM, 64 * kb, 32 * nb, 32 * nb, scr, lane); continue; } r -= I_1;
        { const int kb = r / 32, nb = r % 32; p0_transpose_blk(a.in[I_W2], DM, nullptr, (bf16_t*)(a.ws + WS_W2T), DFF, 64 * kb, 32 * nb, 32 * nb, scr, lane); }
    }
    bf16_t* H = (bf16_t*)((unsigned char*)a.out + DO_H);
    const f32x4* g4 = (const f32x4*)a.in[I_N1G] + lane;
    f32x4 g[4];
#pragma unroll
    for (int j = 0; j < 4; ++j) g[j] = g4[64 * j];
    for (int m = gw; m < MTOK; m += NGW) {
        const float* xrow = (m < MP) ? a.in[I_XP] + (size_t)m * DM : a.in[I_XS] + (size_t)(m - MP) * DM;
        const f32x4* xr = (const f32x4*)xrow + lane;
        f32x4 v[4]; float s = 0.f;
#pragma unroll
        for (int j = 0; j < 4; ++j) { v[j] = xr[64 * j]; s += (v[j].x * v[j].x + v[j].y * v[j].y) + (v[j].z * v[j].z + v[j].w * v[j].w); }
        const float rstd = __builtin_amdgcn_rsqf(wave_sum(s) * (1.f / DM) + EPS);
        u32x2* o8 = (u32x2*)(H + (size_t)m * DM) + lane;
#pragma unroll
        for (int j = 0; j < 4; ++j) { const f32x4 y = v[j] * rstd * g[j]; u32x2 w; w.x = cvt_pk_bf16(y.x, y.y); w.y = cvt_pk_bf16(y.z, y.w); o8[64 * j] = w; }
    }
}

__device__ __forceinline__ int t5_bucket(int rel) {
    const int n = rel < 0 ? -rel : rel; int b = rel > 0 ? 16 : 0;
    if (n < 8) return b + n;
    int k = (n >= 12) + (n >= 16) + (n >= 23) + (n >= 32) + (n >= 46) + (n >= 64) + (n >= 91);
    return b + 8 + k;
}
__device__ __forceinline__ u32x4 ldg16(const void* ubase, unsigned voff) { return *(const u32x4*)((const char*)ubase + voff); }
__device__ __forceinline__ void p2_unit_info(int unit, int& tok0, int& kb_lo, int& kb_hi) {
    tok0 = unit * 128; int n, nblk; if (unit < MP / 128) { n = unit & 31; nblk = 32; } else { n = (unit - MP / 128) & 63; nblk = 64; }
    kb_lo = (n > 0) ? -1 : 0; kb_hi = (n < nblk - 1) ? 1 : 0;
}
__device__ __forceinline__ void p2_phase(LAS unsigned char* lds, const Args& a, int vcu, int G, bf16_t* Mout) {
    const int tid = threadIdx.x, wave = __builtin_amdgcn_readfirstlane(tid >> 6), lane = tid & 63, c = lane & 31, h = lane >> 5;
    const int qt = wave & 3, hsel = wave >> 2;
    const bf16_t* Qg = (const bf16_t*)(a.ws + WS_Q); const bf16_t* Kg = (const bf16_t*)(a.ws + WS_K); const bf16_t* VTg = (const bf16_t*)(a.ws + WS_VT);
    const bf16_t* GVTg = (const bf16_t*)((unsigned char*)a.out + DO_GVT);
    const bf16_t* Ug = (const bf16_t*)(a.ws + WS_U); const bf16_t* SBg = (const bf16_t*)(a.ws + WS_SB);
    LAS float* tb = (LAS float*)(lds + R_TB); LAS float* rstd_l = (LAS float*)(lds + R_RSTD); LAS float* red = (LAS float*)(lds + R_RED);
    constexpr int NU = MTOK / 128;
    for (int i = tid; i < 8 * TB_N; i += 512) { const int hd = i / TB_N, rel = (i % TB_N) - 160; const int ar = rel < 0 ? -rel : rel;
        tb[i] = (ar <= 128) ? a.in[I_RELB][t5_bucket(rel) * 8 + hd] * LOG2E : -1e30f; }
    if (vcu >= NU) { __syncthreads(); return; }
    const int srow = tid >> 4, sch = tid & 15;
    const f32x4 kg0 = *(const f32x4*)(a.in[I_KG] + sch * 8), kg1 = *(const f32x4*)(a.in[I_KG] + sch * 8 + 4);
    u32x4 Kraw[4], Vraw[4];
    const unsigned offK = (unsigned)(srow * 256 + sch * 8) * 2u, offV = (unsigned)(srow * MTOK + sch * 8) * 2u;
    const unsigned offGV = (unsigned)((lane >> 4) * MTOK + (((lane & 15) ^ ((4 * wave + (lane >> 4)) & 15)) * 8)) * 2u;
    const unsigned offQ = (unsigned)(c * DM + 8 * h) * 2u, offP0 = (unsigned)((tid >> 4) * MTOK + 8 * (tid & 15)) * 2u, offC = (unsigned)((lane >> 4) * DM + (lane & 15) * 8) * 2u;
#define P2_PREFETCH(u_tok0, u_pr, u_kb) do { const int _kt0 = (u_tok0) + (u_kb) * 128, _kvh = (u_pr) >> 1; \
        const char* _kb0 = (const char*)(Kg + (size_t)_kt0 * 256 + _kvh * 128); const char* _vb0 = (const char*)(VTg + (size_t)(_kvh * 128) * MTOK + _kt0); \
        _Pragma("unroll") for (int i = 0; i < 4; ++i) Kraw[i] = ldg16(_kb0 + (size_t)i * (32 * 256 * 2), offK); \
        _Pragma("unroll") for (int i = 0; i < 4; ++i) Vraw[i] = ldg16(_vb0 + (size_t)i * ((size_t)32 * MTOK * 2), offV); } while (0)
    { int t0_, lo_, hi_; p2_unit_info(vcu, t0_, lo_, hi_); P2_PREFETCH(t0_, 0, lo_); }
    for (int unit = vcu; unit < NU; unit += G) {
        int tok0, kb_lo, kb_hi; p2_unit_info(unit, tok0, kb_lo, kb_hi);
        {
            __syncthreads();
            if (tid < 128) { const f32x4* pp = (const f32x4*)((const float*)(a.ws + WS_PART) + (size_t)(tok0 + tid) * 8); const f32x4 p0 = pp[0], p1 = pp[1];
                rstd_l[tid] = __builtin_amdgcn_rsqf((((p0[0] + p0[1]) + (p0[2] + p0[3])) + ((p1[0] + p1[1]) + (p1[2] + p1[3]))) * (1.0f / 1024.0f) + EPS); }
        }
        for (int pr = 0; pr < 4; ++pr) {
        const int hd = 2 * pr + hsel;
        bf16x8 Qf[8]; f32x16 O[4]; float m_run, l_run;
        {
            const char* qb = (const char*)(Qg + (size_t)(tok0 + 32 * qt) * DM + hd * 128); u32x4 raw[8]; float ss = 0.f;
#pragma unroll
            for (int s = 0; s < 8; ++s) raw[s] = ldg16(qb + 32 * s, offQ);
#pragma unroll
            for (int s = 0; s < 8; ++s)
#pragma unroll
                for (int e = 0; e < 4; ++e) { const float lo = bf_lo(raw[s][e]), hi = bf_hi(raw[s][e]); ss += lo * lo + hi * hi; }
            ss = x32_sum(ss);
            const float sc = __builtin_amdgcn_rsqf(ss * (1.0f / 128.0f) + EPS) * (0.08838834764831845f * LOG2E);
            const float* qg = a.in[I_QG] + 8 * h;
#pragma unroll
            for (int s = 0; s < 8; ++s) { const f32x4 g0 = *(const f32x4*)(qg + 16 * s), g1 = *(const f32x4*)(qg + 16 * s + 4); u32x4 w;
                w.x = cvt_pk_bf16(bf_lo(raw[s][0]) * sc * g0[0], bf_hi(raw[s][0]) * sc * g0[1]); w.y = cvt_pk_bf16(bf_lo(raw[s][1]) * sc * g0[2], bf_hi(raw[s][1]) * sc * g0[3]);
                w.z = cvt_pk_bf16(bf_lo(raw[s][2]) * sc * g1[0], bf_hi(raw[s][2]) * sc * g1[1]); w.w = cvt_pk_bf16(bf_lo(raw[s][3]) * sc * g1[2], bf_hi(raw[s][3]) * sc * g1[3]);
                Qf[s] = __builtin_bit_cast(bf16x8, w); }
            m_run = a.in[I_SINK][hd] * LOG2E; l_run = (h == 0) ? 1.0f : 0.0f;
#pragma unroll
            for (int dt = 0; dt < 4; ++dt)
#pragma unroll
                for (int i = 0; i < 16; ++i) O[dt][i] = 0.f;
        }
        for (int kb = kb_lo; kb <= kb_hi; ++kb) {
        if (kb == kb_lo + 1) asm volatile("s_waitcnt vmcnt(0)" ::: "memory");
        __syncthreads();
#pragma unroll
        for (int i = 0; i < 4; ++i) { const u32x4 w = Kraw[i]; float v[8]; float ss = 0.f;
#pragma unroll
            for (int e = 0; e < 4; ++e) { v[2 * e] = bf_lo(w[e]); v[2 * e + 1] = bf_hi(w[e]); ss += v[2 * e] * v[2 * e] + v[2 * e + 1] * v[2 * e + 1]; }
            ss = row16_sum(ss);
            const float sc = __builtin_amdgcn_rsqf(ss * (1.0f / 128.0f) + EPS);
            u32x4 o; o.x = cvt_pk_bf16(v[0] * sc * kg0[0], v[1] * sc * kg0[1]); o.y = cvt_pk_bf16(v[2] * sc * kg0[2], v[3] * sc * kg0[3]);
            o.z = cvt_pk_bf16(v[4] * sc * kg1[0], v[5] * sc * kg1[1]); o.w = cvt_pk_bf16(v[6] * sc * kg1[2], v[7] * sc * kg1[3]);
            *(LAS u32x4*)(lds + R_KT + (srow + 32 * i) * KT_PITCH + sch * 16) = o; }
#pragma unroll
        for (int i = 0; i < 4; ++i) { const u32x4 w = Vraw[i]; LAS u32x2* p = (LAS u32x2*)(lds + R_VT + (srow + 32 * i) * VT_PITCH + sch * 16); p[0] = (u32x2){w.x, w.y}; p[1] = (u32x2){w.z, w.w}; }
        if (kb == kb_lo) {
#pragma unroll
            for (int i = 0; i < 8; ++i) {
                __builtin_amdgcn_global_load_lds((const unsigned*)((const char*)(GVTg + (size_t)(pr * 256 + 32 * i + 4 * wave) * MTOK + tok0) + offGV), (LAS unsigned*)(lds + R_GV + (32 * i + 4 * wave) * 256), 16, 0, 0); } }
        int nunit = unit, npr = pr, nkb = kb + 1, ntok0 = tok0, nkb_lo = kb_lo, nkb_hi = kb_hi;
        if (nkb > kb_hi) { npr = pr + 1; if (npr == 4) { npr = 0; nunit = unit + G; if (nunit < NU) p2_unit_info(nunit, ntok0, nkb_lo, nkb_hi); } nkb = nkb_lo; }
        const bool has_next = nunit < NU;
        if (has_next) P2_PREFETCH(ntok0, npr, nkb);
        __syncthreads();
        {
            const int kt_lo = (kb < 0) ? qt : 0, kt_hi = (kb > 0) ? qt : 3;
            for (int kt = kt_lo; kt <= kt_hi; ++kt) {
                f32x16 s;
#pragma unroll
                for (int i = 0; i < 16; ++i) s[i] = 0.f;
#pragma unroll
                for (int s8 = 0; s8 < 8; ++s8) { const bf16x8 kf = *(const LAS bf16x8*)(lds + R_KT + (32 * kt + c) * KT_PITCH + (16 * s8 + 8 * h) * 2);
                    s = __builtin_amdgcn_mfma_f32_32x32x16_bf16(kf, Qf[s8], s, 0, 0, 0); }
                __builtin_amdgcn_sched_barrier(0);
                const LAS float* tbp = tb + hd * TB_N + (kb * 128 + 32 * kt + 4 * h - 32 * qt - c + 160);
                float mx = -3.0e38f;
#pragma unroll
                for (int i = 0; i < 16; ++i) { s[i] += tbp[8 * (i >> 2) + (i & 3)]; mx = fmaxf(mx, s[i]); }
                mx = x32_max(mx);
                const float m_new = fmaxf(m_run, mx), alpha = __builtin_amdgcn_exp2f(m_run - m_new); m_run = m_new;
                float ls = 0.f;
#pragma unroll
                for (int i = 0; i < 16; ++i) { s[i] = __builtin_amdgcn_exp2f(s[i] - m_new); ls += s[i]; }
                l_run = l_run * alpha + ls;
                if (__builtin_amdgcn_ballot_w64(alpha != 1.0f) != 0ull) {
#pragma unroll
                    for (int dt = 0; dt < 4; ++dt)
#pragma unroll
                        for (int i = 0; i < 16; ++i) O[dt][i] *= alpha; }
                bf16x8 Pf[2];
#pragma unroll
                for (int s2 = 0; s2 < 2; ++s2) { u32x4 w; w.x = cvt_pk_bf16(s[8 * s2 + 0], s[8 * s2 + 1]); w.y = cvt_pk_bf16(s[8 * s2 + 2], s[8 * s2 + 3]);
                    w.z = cvt_pk_bf16(s[8 * s2 + 4], s[8 * s2 + 5]); w.w = cvt_pk_bf16(s[8 * s2 + 6], s[8 * s2 + 7]); Pf[s2] = __builtin_bit_cast(bf16x8, w); }
                __builtin_amdgcn_sched_barrier(0);
#pragma unroll
                for (int dt = 0; dt < 4; ++dt) {
                    if (dt == 2) __builtin_amdgcn_sched_barrier(0);
#pragma unroll
                    for (int s2 = 0; s2 < 2; ++s2) { const LAS unsigned char* vp = lds + R_VT + (32 * dt + c) * VT_PITCH + (32 * kt + 16 * s2 + 4 * h) * 2;
                        const u32x2 lo = *(const LAS u32x2*)vp, hi = *(const LAS u32x2*)(vp + 16);
                        const u32x4 w = {lo.x, lo.y, hi.x, hi.y};
                        O[dt] = __builtin_amdgcn_mfma_f32_32x32x16_bf16(__builtin_bit_cast(bf16x8, w), Pf[s2], O[dt], 0, 0, 0); } }
                __builtin_amdgcn_sched_barrier(0);
            }
        }
        }
        {
            const float inv = __builtin_amdgcn_rcpf(x32_sum(l_run));
            u32x2 t2[4][4];
#pragma unroll
            for (int dt = 0; dt < 4; ++dt)
#pragma unroll
                for (int g4 = 0; g4 < 4; ++g4) { t2[dt][g4].x = cvt_pk_bf16(O[dt][4 * g4] * inv, O[dt][4 * g4 + 1] * inv); t2[dt][g4].y = cvt_pk_bf16(O[dt][4 * g4 + 2] * inv, O[dt][4 * g4 + 3] * inv); }
            bf16x8 Wf[8];
            { const float* wrow = a.in[I_WS] + (size_t)(hd * 128 + 32 * qt + c) * 128 + 8 * h;
#pragma unroll
              for (int s8 = 0; s8 < 8; ++s8) { const f32x4 w0 = *(const f32x4*)(wrow + 16 * s8), w1 = *(const f32x4*)(wrow + 16 * s8 + 4);
                  const f32x4 r0 = *(const LAS f32x4*)(rstd_l + 16 * s8 + 8 * h), r1 = *(const LAS f32x4*)(rstd_l + 16 * s8 + 8 * h + 4);
                  u32x4 w; w.x = cvt_pk_bf16(w0[0] * r0[0], w0[1] * r0[1]); w.y = cvt_pk_bf16(w0[2] * r0[2], w0[3] * r0[3]);
                  w.z = cvt_pk_bf16(w1[0] * r1[0], w1[1] * r1[1]); w.w = cvt_pk_bf16(w1[2] * r1[2], w1[3] * r1[3]); Wf[s8] = __builtin_bit_cast(bf16x8, w); } }
            const float bsp = a.in[I_BS][hd * 128 + 32 * qt + c];
            u32x2 t1[4][4];
#pragma unroll
            for (int ct = 0; ct < 4; ++ct) { f32x16 acc;
#pragma unroll
                for (int i = 0; i < 16; ++i) acc[i] = 0.f;
#pragma unroll
                for (int s8 = 0; s8 < 8; ++s8) { const int grow = hsel * 128 + 32 * ct + c; const bf16x8 gf = *(const LAS bf16x8*)(lds + R_GV + grow * 256 + (((2 * s8 + h) ^ (grow & 15)) * 16));
                    acc = __builtin_amdgcn_mfma_f32_32x32x16_bf16(gf, Wf[s8], acc, 0, 0, 0); }
#pragma unroll
                for (int g4 = 0; g4 < 4; ++g4) { const f32x4 gn = *(const f32x4*)(a.in[I_SGUG] + hd * 128 + 32 * ct + 8 * g4 + 4 * h);
                    t1[ct][g4].x = cvt_pk_bf16(acc[4 * g4] * gn[0] + bsp, acc[4 * g4 + 1] * gn[1] + bsp); t1[ct][g4].y = cvt_pk_bf16(acc[4 * g4 + 2] * gn[2] + bsp, acc[4 * g4 + 3] * gn[3] + bsp); } }
            const int tl0 = lane >> 4, ch8 = lane & 15;
            const size_t gu0 = ((size_t)(tok0 + 32 * qt) * DM + hd * 128) * 2;
            __builtin_amdgcn_sched_barrier(0);
            u32x4 cu[4], cb[4];
#pragma unroll
            for (int k = 0; k < 4; ++k) { const size_t go = gu0 + (size_t)(4 * k) * DM * 2; cu[k] = ldg16((const char*)Ug + go, offC); cb[k] = ldg16((const char*)SBg + go, offC); }
            __syncthreads();
            LAS unsigned char* ex = lds + wave * EX_WAVE;
#pragma unroll
            for (int ct = 0; ct < 4; ++ct)
#pragma unroll
                for (int g4 = 0; g4 < 4; ++g4) { const int off = c * KT_PITCH + (32 * ct + 8 * g4 + 4 * h) * 2;
                    *(LAS u32x2*)(ex + off) = t1[ct][g4]; *(LAS u32x2*)(ex + EX_T2 + off) = t2[ct][g4]; }
            asm volatile("s_waitcnt lgkmcnt(0)" ::: "memory");
#pragma unroll
            for (int bt = 0; bt < 2; ++bt) {
                if (bt == 1) {
#pragma unroll
                    for (int k = 0; k < 4; ++k) { const size_t go = gu0 + (size_t)(16 + 4 * k) * DM * 2; cu[k] = ldg16((const char*)Ug + go, offC); cb[k] = ldg16((const char*)SBg + go, offC); } }
#pragma unroll
                for (int k = 0; k < 4; ++k) { const int tl = tl0 + 4 * k + 16 * bt;
                    const u32x4 xu = cu[k], xb = cb[k];
                    const u32x4 a1 = *(const LAS u32x4*)(ex + tl * KT_PITCH + ch8 * 16), a2 = *(const LAS u32x4*)(ex + EX_T2 + tl * KT_PITCH + ch8 * 16);
                    u32x4 o;
#pragma unroll
                    for (int e = 0; e < 4; ++e) {
                        const float lo = bf_lo(xu[e]) * bf_lo(a1[e]) + bf_lo(xb[e]) * bf_lo(a2[e]);
                        const float hi = bf_hi(xu[e]) * bf_hi(a1[e]) + bf_hi(xb[e]) * bf_hi(a2[e]);
                        o[e] = cvt_pk_bf16(lo, hi); }
                    *(u32x4*)((char*)Mout + gu0 + (size_t)(4 * k + 16 * bt) * DM * 2 + offC) = o; }
            }
        }
        }
    }
#undef P2_PREFETCH
    __syncthreads();
}


__global__ void __launch_bounds__(512, 2) fwd_megakernel(Args a) {
    extern __shared__ __attribute__((aligned(16))) unsigned char shm[];
    LAS unsigned char* lds = (LAS unsigned char*)shm;
    const int tid = threadIdx.x, lane = tid & 63, wave = __builtin_amdgcn_readfirstlane(tid >> 6);
    const int G = gridDim.x, bx = blockIdx.x;
    const int vcu = (G % 8 == 0) ? (bx % 8) * (G / 8) + bx / 8 : bx;
    const int lo = a.ph_lo, hi = a.ph_hi;
#define IN(k) (lo <= (k) && (k) < hi)
#define SEAM(k) do { if (IN(k) && IN((k) + 1)) { cg::this_grid().sync(); } } while (0)
    if (IN(0)) for (int rep = (PROBE_DUP == 0 ? 0 : 1); rep < 2; ++rep) { p0_phase(lds, a, vcu, G, wave, lane); __syncthreads(); }
    SEAM(0);
    if (IN(1)) for (int rep = (PROBE_DUP == 1 ? 0 : 1); rep < 2; ++rep) {
        pg8::StaticOrder S; S.init(MTOK, NIN, G, bx);
        P1Ptrs P{(const bf16_t*)((unsigned char*)a.out + DO_H), (const bf16_t*)(a.ws + WS_WT)};
        EpiP1 E{a.ws, (unsigned char*)a.out};
        pg8::gemm_phase(lds, DM, S, P, E);
    }
    SEAM(1);
    if (IN(2)) for (int rep = (PROBE_DUP == 2 ? 0 : 1); rep < 2; ++rep) p2_phase(lds, a, vcu, G, rep == 0 ? (bf16_t*)((unsigned char*)a.out + DO_H) : (bf16_t*)(a.ws + WS_U));
    SEAM(2);
    if (IN(3)) for (int rep = (PROBE_DUP == 3 ? 0 : 1); rep < 2; ++rep) {
        pg8::StaticOrder S; S.init(MTOK, DM, G, bx);
        pg8::PlainPtrs P{(const bf16_t*)(a.ws + WS_U), (const bf16_t*)(a.ws + WS_WOT), DM};
        EpiWo E{a.in[I_XP], a.in[I_XS], (bf16_t*)(a.ws + WS_Q), (float*)(a.ws + WS_PART)};
        pg8::gemm_phase(lds, DM, S, P, E);
    }
    SEAM(3);
    if (IN(4)) for (int rep = (PROBE_DUP == 4 ? 0 : 1); rep < 2; ++rep) {
        pg8::StaticOrder S; S.init(MTOK, DFF, G, bx);
        pg8::PlainPtrs P{(const bf16_t*)(a.ws + WS_Q), (const bf16_t*)(a.ws + WS_W1T), DM};
        EpiFF1 E{(bf16_t*)(a.ws + WS_HID)};
        pg8::gemm_phase(lds, DM, S, P, E);
    }
    SEAM(4);
    if (IN(5)) for (int rep = (PROBE_DUP == 5 ? 0 : 1); rep < 2; ++rep) {
        pg8::StaticOrder S; S.init(MTOK, DM, G, bx);
        pg8::PlainPtrs P{(const bf16_t*)(a.ws + WS_HID), (const bf16_t*)(a.ws + WS_W2T), DFF};
        LAS float* tab = (LAS float*)(lds + R_FF2TAB);
        for (int i = 0; i < 8; ++i) { Unit u; if (!S.next(i, u)) break;
            if (tid < 256) { const f32x4* pp = (const f32x4*)((const float*)(a.ws + WS_PART) + (size_t)(u.pm * 256 + tid) * 16); const f32x4 p0 = pp[0], p1 = pp[1], p2 = pp[2], p3 = pp[3];
                const float ss = ((p0[0] + p0[1]) + (p0[2] + p0[3])) + ((p1[0] + p1[1]) + (p1[2] + p1[3])) + ((p2[0] + p2[1]) + (p2[2] + p2[3])) + ((p3[0] + p3[1]) + (p3[2] + p3[3]));
                tab[i * 256 + tid] = __builtin_amdgcn_rcpf(ss * (1.0f / DM) + EPS); } }
        __syncthreads();
        EpiFF2 E{a.out, (const bf16_t*)(a.ws + WS_Q), tab};
        pg8::gemm_phase(lds, DFF, S, P, E);
    }
#undef IN
#undef SEAM
}

extern "C" void kernel_launch(void* const* d_in, const int* in_sizes, int n_in, void* d_out, int out_size, void* d_ws, size_t ws_size, hipStream_t stream) {
    static int grid = 0;
    if (grid == 0) {
        if (n_in != 15 || out_size != MTOK * DM || ws_size < WS_END) { fprintf(stderr, "kernel_launch: unexpected shapes (n_in %d out %d ws %zu)\n", n_in, out_size, ws_size); grid = -1; return; }
        int dev = 0, cus = 0, per_cu = 0;
        hipGetDevice(&dev); hipDeviceGetAttribute(&cus, hipDeviceAttributeMultiprocessorCount, dev);
        if (hipFuncSetAttribute((const void*)fwd_megakernel, hipFuncAttributeMaxDynamicSharedMemorySize, LDS_BYTES) != hipSuccess) { fprintf(stderr, "kernel_launch: hipFuncSetAttribute failed\n"); grid = -1; return; }
        hipOccupancyMaxActiveBlocksPerMultiprocessor(&per_cu, (const void*)fwd_megakernel, 512, LDS_BYTES);
        if (per_cu < 1) { fprintf(stderr, "kernel_launch: occupancy query says %d blocks/CU\n", per_cu); per_cu = 1; }
        (void)hipGetLastError();
        grid = cus * per_cu;
    }
    if (grid < 0) return;
    Args a{};
    for (int i = 0; i < 15; ++i) a.in[i] = (const float*)d_in[i];
    a.out = (float*)d_out; a.ws = (unsigned char*)d_ws;
    if (N_LAUNCHES == 1) {
        a.ph_lo = 0; a.ph_hi = 6;
        void* args[] = {&a};
        hipError_t e = hipLaunchCooperativeKernel((const void*)fwd_megakernel, dim3(grid), dim3(512), args, LDS_BYTES, stream);
        if (e != hipSuccess) fprintf(stderr, "cooperative launch failed: %s (grid %d)\n", hipGetErrorString(e), grid);
    } else {
        for (int p = 0; p < 6; ++p) { a.ph_lo = p; a.ph_hi = p + 1; hipLaunchKernelGGL(fwd_megakernel, dim3(grid), dim3(512), LDS_BYTES, stream, a); }
    }
}
```

```cpp
#include <hip/hip_runtime.h>
#include <hip/hip_cooperative_groups.h>
#include <cstdio>
namespace cg = cooperative_groups;

#define LAS __attribute__((address_space(3)))
typedef unsigned short bf16_t;
typedef short bf16x8 __attribute__((ext_vector_type(8)));
typedef float f32x4 __attribute__((ext_vector_type(4)));
typedef float f32x16 __attribute__((ext_vector_type(16)));
typedef unsigned u32x4 __attribute__((ext_vector_type(4)));
typedef unsigned u32x2 __attribute__((ext_vector_type(2)));

#ifndef PROBE_DUP
#define PROBE_DUP -1
#endif
#ifndef N_LAUNCHES
#define N_LAUNCHES 1
#endif

constexpr int MP = 8 * 4096, MS = 8 * 8192, MTOK = MP + MS;
constexpr int DM = 1024, NIN = 5632, DFF = 4096;
constexpr float EPS = 1e-6f;
constexpr float LOG2E = 1.4426950408889634f;
constexpr size_t MiB = 1u << 20;
constexpr size_t WS_WT = 0, WS_WOT = 12 * MiB, WS_W1T = 14 * MiB, WS_W2T = 22 * MiB;
constexpr size_t WS_Q = 32 * MiB;
constexpr size_t WS_U = 224 * MiB;
constexpr size_t WS_SA = 416 * MiB, WS_SB = 608 * MiB;
constexpr size_t WS_K = 800 * MiB;
constexpr size_t WS_VT = 848 * MiB;
constexpr size_t WS_HID = 224 * MiB;
constexpr size_t WS_PART = 992 * MiB;
constexpr size_t WS_WSB = 31 * MiB;
constexpr size_t WS_BAR = 1000 * MiB;
constexpr size_t WS_END = 1001 * MiB;
constexpr size_t DO_H = 0, DO_GVT = 192 * MiB;

constexpr int KT_PITCH = 272, VT_PITCH = 264;
constexpr int R_KT = 0, R_VT = 34816, R_GV = 68608;
constexpr int EX_WAVE = 17408, EX_T2 = 8704;
constexpr int R_TB = 139264, TB_N = 320, R_RSTD = R_TB + 8 * TB_N * 4, R_RED = R_RSTD + 512;
constexpr int LDS_BYTES = 155648;
static_assert(R_RED + 4096 <= LDS_BYTES, "lds map");

__device__ __forceinline__ unsigned cvt_pk_bf16(float lo, float hi) { unsigned r; asm volatile("v_cvt_pk_bf16_f32 %0, %1, %2" : "=v"(r) : "v"(lo), "v"(hi)); return r; }
__device__ __forceinline__ float bf_lo(unsigned w) { return __uint_as_float(w << 16); }
__device__ __forceinline__ float bf_hi(unsigned w) { return __uint_as_float(w & 0xffff0000u); }
typedef float f32x2 __attribute__((ext_vector_type(2)));
template <int CTRL> __device__ __forceinline__ float dpp(float x) { return __builtin_bit_cast(float, __builtin_amdgcn_mov_dpp(__builtin_bit_cast(int, x), CTRL, 0xf, 0xf, true)); }
__device__ __forceinline__ float row16_sum(float x) { x += dpp<0xB1>(x); x += dpp<0x4E>(x); x += dpp<0x141>(x); x += dpp<0x128>(x); return x; }
__device__ __forceinline__ float x16_sum(float x) { auto s = __builtin_amdgcn_permlane16_swap(__float_as_uint(x), __float_as_uint(x), false, false); return __uint_as_float(s[0]) + __uint_as_float(s[1]); }
__device__ __forceinline__ float x32_sum(float x) { auto s = __builtin_amdgcn_permlane32_swap(__float_as_uint(x), __float_as_uint(x), false, false); return __uint_as_float(s[0]) + __uint_as_float(s[1]); }
__device__ __forceinline__ float x32_max(float x) { auto s = __builtin_amdgcn_permlane32_swap(__float_as_uint(x), __float_as_uint(x), false, false); return fmaxf(__uint_as_float(s[0]), __uint_as_float(s[1])); }
__device__ __forceinline__ f32x2 gelu2(f32x2 x) { const f32x2 u = x * x, p = u * (0.044715f * -2.302208198f) + (-2.302208198f), t = x * p; f32x2 e; e.x = __builtin_amdgcn_exp2f(t.x); e.y = __builtin_amdgcn_exp2f(t.y);
    const f32x2 d = e + 1.0f; f32x2 r; r.x = __builtin_amdgcn_rcpf(d.x); r.y = __builtin_amdgcn_rcpf(d.y); return x * r; }
__device__ __forceinline__ f32x2 sigmoid2(f32x2 x) { const f32x2 t = x * (-LOG2E); f32x2 e; e.x = __builtin_amdgcn_exp2f(t.x); e.y = __builtin_amdgcn_exp2f(t.y);
    const f32x2 d = e + 1.0f; f32x2 r; r.x = __builtin_amdgcn_rcpf(d.x); r.y = __builtin_amdgcn_rcpf(d.y); return r; }
__device__ __forceinline__ float gelu_tanh(float x) { const float t = x * (1.0f + 0.044715f * x * x) * (-2.302208198f); return x * __builtin_amdgcn_rcpf(1.0f + __builtin_amdgcn_exp2f(t)); }
__device__ __forceinline__ float sigmoidf(float x) { return __builtin_amdgcn_rcpf(1.0f + __builtin_amdgcn_exp2f(-LOG2E * x)); }

namespace pg8 {
constexpr int BM = 256, BK = 64, HALF = 128, HTB = HALF * BK * 2, STAGE_BYTES = 8 * HTB, NXCD = 8, WGM = 8;
__host__ __device__ __forceinline__ int lds_byte(int r, int c) { const int st = (r >> 4) * 2 + (c >> 5), rr = r & 15, cc = c & 31, ob = rr * 64 + cc * 2; return st * 1024 + (ob ^ (((ob >> 9) & 1) << 5)); }
__host__ __device__ __forceinline__ void stage_rc(int b, int& R, int& C) { const int st = b / 1024, sb = b % 1024, swz = sb ^ (((sb >> 9) & 1) << 5); R = (st >> 1) * 16 + swz / 64; C = (st & 1) * 32 + (swz % 64) / 2; }
__host__ __device__ __forceinline__ int perm32(int rho) { const int n = rho >> 4, i = rho & 15; return 8 * (i >> 2) + 4 * n + (i & 3); }
struct Unit { int pm, pn; };
struct StaticOrder {
    int nM, nN, nwg, G, c;
    __device__ void init(int M, int N, int G_, int c_) { nM = M / BM; nN = N / BM; nwg = nM * nN; G = G_; c = c_; }
    __device__ bool next(int i, Unit& u) const {
        const long L = (long)i * G + c; if (L >= nwg) return false;
        int wgid = (int)L; { const int q = nwg / NXCD, r = nwg % NXCD, xcd = wgid % NXCD, off = wgid / NXCD; wgid = (xcd < r ? xcd * (q + 1) : r * (q + 1) + (xcd - r) * q) + off; }
        const int nig = WGM * nN, gid = wgid / nig, fm = gid * WGM, gsz = (nM - fm) < WGM ? (nM - fm) : WGM;
        u.pm = fm + ((wgid % nig) % gsz); u.pn = (wgid % nig) / gsz; return true;
    }
};
struct PlainPtrs { const bf16_t* A; const bf16_t* Bt; int K;
    __device__ __forceinline__ void get(const Unit& u, const char*& a, const char*& b) const { a = (const char*)A + (size_t)u.pm * 512 * K; b = (const char*)Bt + (size_t)u.pn * 512 * K; } };

template <class Epi, class Ptrs>
__device__ __forceinline__ void gemm_phase(LAS unsigned char* lds, const int K, const StaticOrder& S, const Ptrs& P, const Epi& E) {
    const int tid = threadIdx.x, wid = __builtin_amdgcn_readfirstlane(tid >> 6), lane = tid & 63, wr = wid >> 2, wc = wid & 3, fr = lane & 15, fq = lane >> 4;
    const int nt = K / BK;
    unsigned voffA[2], voffB[2];
#pragma unroll
    for (int i = 0; i < 2; ++i) { int R, C; stage_rc(tid * 16 + i * 8192, R, C); const int Rb = (R & ~31) + perm32(R & 31);
        voffA[i] = (unsigned)(R * K + C) * 2u; voffB[i] = (unsigned)(Rb * K + C) * 2u; }
    const size_t kstep = (size_t)(BK * 2);
    const size_t hstep = (size_t)HALF * K * 2;
    const unsigned ldsw = (unsigned)wid * 1024u;
    const int aoff = lds_byte(wr * 64 + fr, fq * 8), boff = lds_byte(wc * 32 + fr, fq * 8);
#define PG8_SA(b, h) (((b) * 2 + (h)) * HTB)
#define PG8_SB(b, h) ((4 + (b) * 2 + (h)) * HTB)
#define PG8_STAGE(bufoff, gbase, voff) do { _Pragma("unroll") for (int _i = 0; _i < 2; ++_i) \
        __builtin_amdgcn_global_load_lds((const unsigned*)((const char*)(gbase) + (voff)[_i]), (LAS unsigned*)(lds + (bufoff) + ldsw + _i * 8192), 16, 0, 0); } while (0)
#define PG8_LDA(dst, b, h) do { _Pragma("unroll") for (int m = 0; m < 4; ++m) _Pragma("unroll") for (int k = 0; k < 2; ++k) dst[m][k] = *(const LAS bf16x8*)(lds + PG8_SA(b, h) + aoff + m * 2048 + k * 1024); } while (0)
#define PG8_LDB(dst, b, h) do { _Pragma("unroll") for (int n = 0; n < 2; ++n) _Pragma("unroll") for (int k = 0; k < 2; ++k) dst[n][k] = *(const LAS bf16x8*)(lds + PG8_SB(b, h) + boff + n * 2048 + k * 1024); } while (0)
#define PG8_MMA(ai, bj, At, Bt) do { __builtin_amdgcn_s_setprio(1); _Pragma("unroll") for (int m = 0; m < 4; ++m) _Pragma("unroll") for (int n = 0; n < 2; ++n) _Pragma("unroll") for (int k = 0; k < 2; ++k) \
        acc[ai][bj][m][n] = __builtin_amdgcn_mfma_f32_16x16x32_bf16(Bt[n][k], At[m][k], acc[ai][bj][m][n], 0, 0, 0); __builtin_amdgcn_s_setprio(0); } while (0)
#define PG8_WAIT_V(n) asm volatile("s_waitcnt vmcnt(" #n ")" ::: "memory")
#define PG8_WAIT_L(n) asm volatile("s_waitcnt lgkmcnt(" #n ")" ::: "memory")
#define PG8_BAR __builtin_amdgcn_s_barrier()
#define PG8_SCHED __builtin_amdgcn_sched_barrier(0)
    Unit cur, nxt; int ui = 0;
    if (!S.next(0, cur)) return;
    f32x4 acc[2][2][4][2];
#pragma unroll
    for (int a = 0; a < 2; ++a)
#pragma unroll
        for (int b = 0; b < 2; ++b)
#pragma unroll
            for (int m = 0; m < 4; ++m)
#pragma unroll
                for (int n = 0; n < 2; ++n) acc[a][b][m][n] = (f32x4){0.f, 0.f, 0.f, 0.f};
    bf16x8 At[4][2], B0[2][2], B1[2][2];
    const char* cA; const char* cB; P.get(cur, cA, cB);
    PG8_STAGE(PG8_SB(0, 0), cB, voffB); PG8_STAGE(PG8_SA(0, 0), cA, voffA); PG8_STAGE(PG8_SB(0, 1), cB + hstep, voffB); PG8_STAGE(PG8_SA(0, 1), cA + hstep, voffA);
    if (wr == 1) PG8_BAR;
    PG8_WAIT_V(4); PG8_BAR;
    PG8_STAGE(PG8_SB(1, 0), cB + kstep, voffB); PG8_STAGE(PG8_SA(1, 0), cA + kstep, voffA); PG8_STAGE(PG8_SB(1, 1), cB + hstep + kstep, voffB);
    PG8_WAIT_V(6); PG8_BAR;
    for (;;) {
        const bool has_next = S.next(ui + 1, nxt);
        const char* nA = cA; const char* nB = cB; if (has_next) P.get(nxt, nA, nB);
        for (int t = 0; t < nt; t += 2) {
            const bool last = (t == nt - 2);
            const char* a1 = cA + (size_t)(t + 1) * kstep;
            const char* a2 = last ? nA : cA + (size_t)(t + 2) * kstep; const char* b2 = last ? nB : cB + (size_t)(t + 2) * kstep;
            const char* a3 = a2 + kstep; const char* b3 = b2 + kstep;
            PG8_LDB(B0, 0, 0); PG8_SCHED; PG8_LDA(At, 0, 0); PG8_STAGE(PG8_SA(1, 1), a1 + hstep, voffA);
            PG8_WAIT_L(8); PG8_BAR; PG8_WAIT_L(0); PG8_MMA(0, 0, At, B0); PG8_BAR; PG8_SCHED;
            PG8_LDB(B1, 0, 1); PG8_STAGE(PG8_SB(0, 0), b2, voffB);
            PG8_BAR; PG8_WAIT_L(0); PG8_MMA(0, 1, At, B1); PG8_BAR;
            PG8_LDA(At, 0, 1); PG8_STAGE(PG8_SA(0, 0), a2, voffA);
            PG8_BAR; PG8_WAIT_L(0); PG8_MMA(1, 0, At, B0); PG8_BAR; PG8_SCHED;
            PG8_STAGE(PG8_SB(0, 1), b2 + hstep, voffB);
            PG8_WAIT_V(6); PG8_BAR; PG8_MMA(1, 1, At, B1); PG8_BAR;
            PG8_LDB(B0, 1, 0); PG8_SCHED; PG8_LDA(At, 1, 0); PG8_STAGE(PG8_SA(0, 1), a2 + hstep, voffA);
            PG8_WAIT_L(8); PG8_BAR; PG8_WAIT_L(0); PG8_MMA(0, 0, At, B0); PG8_BAR; PG8_SCHED;
            PG8_LDB(B1, 1, 1); PG8_STAGE(PG8_SB(1, 0), b3, voffB);
            PG8_BAR; PG8_WAIT_L(0); PG8_MMA(0, 1, At, B1); PG8_BAR;
            PG8_LDA(At, 1, 1); PG8_STAGE(PG8_SA(1, 0), a3, voffA);
            PG8_BAR; PG8_WAIT_L(0); PG8_MMA(1, 0, At, B0); PG8_BAR; PG8_SCHED;
            PG8_STAGE(PG8_SB(1, 1), b3 + hstep, voffB);
            PG8_WAIT_V(6); PG8_BAR; PG8_MMA(1, 1, At, B1); PG8_BAR;
        }
        E(acc, cur, ui, wr, wc, fr, fq);
        if (!has_next) break;
#pragma unroll
        for (int a = 0; a < 2; ++a)
#pragma unroll
            for (int b = 0; b < 2; ++b)
#pragma unroll
                for (int m = 0; m < 4; ++m)
#pragma unroll
                    for (int n = 0; n < 2; ++n) acc[a][b][m][n] = (f32x4){0.f, 0.f, 0.f, 0.f};
        cur = nxt; cA = nA; cB = nB; ++ui;
    }
    PG8_WAIT_V(0);
    if (wr == 0) PG8_BAR;
    PG8_BAR;
#undef PG8_SA
#undef PG8_SB
#undef PG8_STAGE
#undef PG8_LDA
#undef PG8_LDB
#undef PG8_MMA
#undef PG8_WAIT_V
#undef PG8_WAIT_L
#undef PG8_BAR
#undef PG8_SCHED
}
}
using pg8::Unit;

struct Args { const float* in[15]; float* out; unsigned char* ws; int ph_lo, ph_hi; };
enum { I_XP = 0, I_XS, I_RELB, I_N1G, I_WIN, I_SGUG, I_WS, I_BS, I_QG, I_KG, I_SINK, I_WO, I_N2G, I_W1, I_W2 };

struct P1Ptrs { const bf16_t* H; const bf16_t* Wt;
    __device__ __forceinline__ void get(const Unit& u, const char*& a, const char*& b) const {
        const char* hp = (const char*)H + (size_t)u.pm * 512 * DM; const char* wp = (const char*)Wt + (size_t)u.pn * 512 * DM;
        if (u.pn < 17) { a = hp; b = wp; } else { a = wp; b = hp; } } };
__device__ __forceinline__ u32x4 pack8(f32x4 v0, f32x4 v1) { u32x4 w; w.x = cvt_pk_bf16(v0[0], v0[1]); w.y = cvt_pk_bf16(v0[2], v0[3]); w.z = cvt_pk_bf16(v1[0], v1[1]); w.w = cvt_pk_bf16(v1[2], v1[3]); return w; }
__device__ __forceinline__ f32x2 g1_2(f32x2 x, f32x2 g) { const f32x2 u = x * x, p = u * (0.044715f * -2.302208198f) + (-2.302208198f), t = x * p, tg = g * (-LOG2E);
    f32x2 e1, e2; e1.x = __builtin_amdgcn_exp2f(t.x); e1.y = __builtin_amdgcn_exp2f(t.y); e2.x = __builtin_amdgcn_exp2f(tg.x); e2.y = __builtin_amdgcn_exp2f(tg.y);
    const f32x2 d = (e1 + 1.0f) * (e2 + 1.0f); f32x2 r; r.x = __builtin_amdgcn_rcpf(d.x); r.y = __builtin_amdgcn_rcpf(d.y); return x * r; }
__device__ __forceinline__ f32x4 g1_4(f32x4 v, f32x4 g) { const f32x2 a = g1_2((f32x2){v[0], v[1]}, (f32x2){g[0], g[1]}), b = g1_2((f32x2){v[2], v[3]}, (f32x2){g[2], g[3]}); return (f32x4){a.x, a.y, b.x, b.y}; }
__device__ __forceinline__ f32x4 gelu4(f32x4 v) { const f32x2 a = gelu2((f32x2){v[0], v[1]}), b = gelu2((f32x2){v[2], v[3]}); return (f32x4){a.x, a.y, b.x, b.y}; }
__device__ __forceinline__ f32x4 sigmoid4(f32x4 v) { const f32x2 a = sigmoid2((f32x2){v[0], v[1]}), b = sigmoid2((f32x2){v[2], v[3]}); return (f32x4){a.x, a.y, b.x, b.y}; }
struct EpiP1 {
    unsigned char* ws; unsigned char* dout;
    __device__ __forceinline__ void operator()(const f32x4 (&acc)[2][2][4][2], const Unit& u, int ui, int wr, int wc, int fr, int fq) const {
        const int pn = u.pn;
        if (pn < 8) {
            bf16_t* base = (bf16_t*)(ws + WS_U) + (size_t)(u.pm * 256 + wr * 64 + fr) * DM + pn * 128 + wc * 32 + 8 * fq;
#pragma unroll
            for (int ai = 0; ai < 2; ++ai)
#pragma unroll
                for (int m = 0; m < 4; ++m) {
                    const f32x4 g0 = g1_4(acc[ai][0][m][0], acc[ai][1][m][0]), g1 = g1_4(acc[ai][0][m][1], acc[ai][1][m][1]);
                    *(u32x4*)(base + (size_t)(ai * 128 + m * 16) * DM) = pack8(g0, g1); }
            return; }
        if (pn >= 17 && pn < 21) {
            bf16_t* base = (bf16_t*)(dout + DO_GVT) + (size_t)((pn - 17) * 256 + wr * 64 + fr) * MTOK + u.pm * 256 + wc * 32 + 8 * fq;
            float* pp = (float*)(ws + WS_PART) + (size_t)(u.pm * 256 + wc * 32 + 8 * fq) * 8 + (pn - 17) * 2 + wr;
#pragma unroll
            for (int bj = 0; bj < 2; ++bj) { f32x4 sq0 = {0.f, 0.f, 0.f, 0.f}, sq1 = {0.f, 0.f, 0.f, 0.f};
#pragma unroll
                for (int ai = 0; ai < 2; ++ai)
#pragma unroll
                    for (int m = 0; m < 4; ++m) { const f32x4 g0 = gelu4(acc[ai][bj][m][0]), g1 = gelu4(acc[ai][bj][m][1]);
                        sq0 += g0 * g0; sq1 += g1 * g1;
                        *(u32x4*)(base + (size_t)(ai * 128 + m * 16) * MTOK + bj * 128) = pack8(g0, g1); }
#pragma unroll
                for (int j = 0; j < 4; ++j) { const float t0 = row16_sum(sq0[j]), t1 = row16_sum(sq1[j]); if (fr == 0) { pp[(size_t)(bj * 128 + j) * 8] = t0; pp[(size_t)(bj * 128 + 4 + j) * 8] = t1; } } }
            return; }
        bf16_t* base; size_t ld; int row0, col0, act;
        if (pn < 12)      { base = (bf16_t*)(ws + WS_Q);  ld = DM;  row0 = u.pm * 256; col0 = (pn - 8) * 256;  act = 0; }
        else if (pn < 13) { base = (bf16_t*)(ws + WS_K);  ld = 256; row0 = u.pm * 256; col0 = 0;               act = 0; }
        else if (pn < 17) { base = (bf16_t*)(ws + WS_SB); ld = DM;  row0 = u.pm * 256; col0 = (pn - 13) * 256; act = 2; }
        else              { base = (bf16_t*)(ws + WS_VT); ld = MTOK; row0 = 0; col0 = u.pm * 256; act = 0; }
        const int r0 = row0 + wr * 64 + fr, c0 = col0 + wc * 32 + 8 * fq;
#pragma unroll
        for (int ai = 0; ai < 2; ++ai)
#pragma unroll
            for (int m = 0; m < 4; ++m) { bf16_t* rowp = base + (size_t)(r0 + ai * 128 + m * 16) * ld + c0;
#pragma unroll
                for (int bj = 0; bj < 2; ++bj) { f32x4 v0 = acc[ai][bj][m][0], v1 = acc[ai][bj][m][1];
                    if (act == 2) { v0 = sigmoid4(v0); v1 = sigmoid4(v1); }
                    *(u32x4*)(rowp + bj * 128) = pack8(v0, v1); } }
    }
};
struct EpiWo {
    const float* xp; const float* xs; bf16_t* xb; float* part;
    __device__ __forceinline__ void operator()(const f32x4 (&acc)[2][2][4][2], const Unit& u, int ui, int wr, int wc, int fr, int fq) const {
        const int row0 = u.pm * 256 + wr * 64 + fr, col0 = u.pn * 256 + wc * 32 + 8 * fq;
        const float* xb0 = (u.pm * 256 < MP) ? xp : xs - (size_t)MP * DM;
#pragma unroll
        for (int ai = 0; ai < 2; ++ai) {
            f32x4 xv[4][2][2];
#pragma unroll
            for (int m = 0; m < 4; ++m)
#pragma unroll
                for (int bj = 0; bj < 2; ++bj) { const float* p = xb0 + (size_t)(row0 + ai * 128 + m * 16) * DM + col0 + bj * 128; xv[m][bj][0] = *(const f32x4*)p; xv[m][bj][1] = *(const f32x4*)(p + 4); }
#pragma unroll
            for (int m = 0; m < 4; ++m) { const int row = row0 + ai * 128 + m * 16; const size_t off = (size_t)row * DM + col0; float ss = 0.f;
#pragma unroll
                for (int bj = 0; bj < 2; ++bj) {
                    const f32x4 v0 = acc[ai][bj][m][0] + xv[m][bj][0], v1 = acc[ai][bj][m][1] + xv[m][bj][1];
                    u32x4 w; w.x = cvt_pk_bf16(v0[0], v0[1]); w.y = cvt_pk_bf16(v0[2], v0[3]); w.z = cvt_pk_bf16(v1[0], v1[1]); w.w = cvt_pk_bf16(v1[2], v1[3]);
                    *(u32x4*)(xb + off + bj * 128) = w;
                    ss += (v0[0] * v0[0] + v0[1] * v0[1]) + (v0[2] * v0[2] + v0[3] * v0[3]) + (v1[0] * v1[0] + v1[1] * v1[1]) + (v1[2] * v1[2] + v1[3] * v1[3]); }
                ss = x32_sum(x16_sum(ss));
                if (fq == 0) part[(size_t)row * 16 + u.pn * 4 + wc] = ss; }
        }
    }
};
struct EpiFF1 {
    bf16_t* hid;
    __device__ __forceinline__ void operator()(const f32x4 (&acc)[2][2][4][2], const Unit& u, int ui, int wr, int wc, int fr, int fq) const {
        const int row0 = u.pm * 256 + wr * 64 + fr, col0 = u.pn * 256 + wc * 32 + 8 * fq;
#pragma unroll
        for (int ai = 0; ai < 2; ++ai)
#pragma unroll
            for (int m = 0; m < 4; ++m) { bf16_t* rowp = hid + (size_t)(row0 + ai * 128 + m * 16) * DFF + col0;
#pragma unroll
                for (int bj = 0; bj < 2; ++bj) { f32x4 v0 = acc[ai][bj][m][0], v1 = acc[ai][bj][m][1];
#pragma unroll
                    for (int j = 0; j < 4; ++j) { const float a = fmaxf(v0[j], 0.f), b = fmaxf(v1[j], 0.f); v0[j] = a * a; v1[j] = b * b; }
                    u32x4 w; w.x = cvt_pk_bf16(v0[0], v0[1]); w.y = cvt_pk_bf16(v0[2], v0[3]); w.z = cvt_pk_bf16(v1[0], v1[1]); w.w = cvt_pk_bf16(v1[2], v1[3]);
                    *(u32x4*)(rowp + bj * 128) = w; } }
    }
};
constexpr int R_FF2TAB = 131072;
struct EpiFF2 {
    float* out; const bf16_t* xb; const LAS float* tab;
    __device__ __forceinline__ void operator()(const f32x4 (&acc)[2][2][4][2], const Unit& u, int ui, int wr, int wc, int fr, int fq) const {
        const int rl0 = wr * 64 + fr, col0 = u.pn * 256 + wc * 32 + 8 * fq;
        u32x4 xv[2][4][2];
#pragma unroll
        for (int ai = 0; ai < 2; ++ai)
#pragma unroll
            for (int m = 0; m < 4; ++m)
#pragma unroll
                for (int bj = 0; bj < 2; ++bj) xv[ai][m][bj] = *(const u32x4*)(xb + (size_t)(u.pm * 256 + rl0 + ai * 128 + m * 16) * DM + col0 + bj * 128);
#pragma unroll
        for (int ai = 0; ai < 2; ++ai)
#pragma unroll
            for (int m = 0; m < 4; ++m) { const int rl = rl0 + ai * 128 + m * 16; float* rowp = out + (size_t)(u.pm * 256 + rl) * DM + col0;
                const float r2 = tab[ui * 256 + rl];
#pragma unroll
                for (int bj = 0; bj < 2; ++bj) { const u32x4 x = xv[ai][m][bj];
                    const f32x4 x0 = {bf_lo(x.x), bf_hi(x.x), bf_lo(x.y), bf_hi(x.y)}, x1 = {bf_lo(x.z), bf_hi(x.z), bf_lo(x.w), bf_hi(x.w)};
                    *(f32x4*)(rowp + bj * 128) = acc[ai][bj][m][0] * r2 + x0; *(f32x4*)(rowp + bj * 128 + 4) = acc[ai][bj][m][1] * r2 + x1; } }
    }
};

__device__ __forceinline__ void p0_transpose_blk(const float* W, int ldw, const float* kscale, bf16_t* WT, int K, int k0, int n0src, int n0dst, LAS float* scr, int lane) {
#pragma unroll 8
    for (int i = 0; i < 32; ++i) { const int kk = 2 * i + (lane >> 5); float v = W[(size_t)(k0 + kk) * ldw + n0src + (lane & 31)]; if (kscale) v *= kscale[k0 + kk]; scr[kk * 33 + (lane & 31)] = v; }
    asm volatile("s_waitcnt lgkmcnt(0)" ::: "memory");
    const int c = lane & 7;
#pragma unroll
    for (int j = 0; j < 4; ++j) { const int n = (lane >> 3) + 8 * j; const LAS float* s = scr + (8 * c) * 33 + n;
        u32x4 o; o.x = cvt_pk_bf16(s[0 * 33], s[1 * 33]); o.y = cvt_pk_bf16(s[2 * 33], s[3 * 33]); o.z = cvt_pk_bf16(s[4 * 33], s[5 * 33]); o.w = cvt_pk_bf16(s[6 * 33], s[7 * 33]);
        *(u32x4*)(WT + (size_t)(n0dst + n) * K + k0 + 8 * c) = o; }
    asm volatile("s_waitcnt lgkmcnt(0)" ::: "memory");
}
__device__ __forceinline__ int win_src_col(int d) {
    if (d < 2048) { const int j = d >> 8, w = d & 255; return w < 128 ? 128 * j + w : 3584 + 128 * j + (w - 128); }
    if (d < 3072) return 2048 + (d - 2048);
    if (d < 3328) return 3072 + (d - 3072);
    if (d < 4352) return 4608 + (d - 3328);
    if (d < 5376) return 1024 + (d - 4352);
    return 3328 + (d - 5376);
}
__device__ __forceinline__ float wave_sum(float v) { return x32_sum(x16_sum(row16_sum(v))); }
__device__ __forceinline__ void p0_phase(LAS unsigned char* lds, const Args& a, int vcu, int G, int wave, int lane) {
    LAS float* scr = (LAS float*)(lds + wave * 16384);
    const int gw = vcu * 8 + wave, NGW = G * 8;
    bf16_t* Wt = (bf16_t*)(a.ws + WS_WT);
    const float* win = a.in[I_WIN];
    constexpr int I_IN = 16 * (NIN / 32), I_O = 16 * 32, I_1 = 16 * (DFF / 32), I_2 = 64 * 32;
    for (int it = gw; it < I_IN + I_O + I_1 + I_2; it += NGW) {
        int r = it;
        if (r < I_IN) { const int kb = r / (NIN / 32), nb = r % (NIN / 32); p0_transpose_blk(win, NIN, nullptr, Wt, DM, 64 * kb, win_src_col(32 * nb), 32 * nb, scr, lane); continue; }
        r -= I_IN;
        if (r < I_O) { const int kb = r / 32, nb = r % 32; p0_transpose_blk(a.in[I_WO], DM, nullptr, (bf16_t*)(a.ws + WS_WOT), DM, 64 * kb, 32 * nb, 32 * nb, scr, lane); continue; } r -= I_O;
        if (r < I_1) { const int kb = r / 128, nb = r % 128; p0_transpose_blk(a.in[I_W1], DFF, a.in[I_N2G], (bf16_t*)(a.ws + WS_W1T), DM, 64 * kb, 32 * nb, 32 * nb, scr, lane); continue; } r -= I_1;
        { const int kb = r / 32, nb = r % 32; p0_transpose_blk(a.in[I_W2], DM, nullptr, (bf16_t*)(a.ws + WS_W2T), DFF, 64 * kb, 32 * nb, 32 * nb, scr, lane); }
    }
    { const int gt = gw * 64 + lane; if (gt < 8 * 128 * 128 / 8) { const f32x4 w0 = ((const f32x4*)a.in[I_WS])[2 * gt], w1 = ((const f32x4*)a.in[I_WS])[2 * gt + 1]; ((u32x4*)(a.ws + WS_WSB))[gt] = pack8(w0, w1); } }
    bf16_t* H = (bf16_t*)((unsigned char*)a.out + DO_H);
    const f32x4* g4 = (const f32x4*)a.in[I_N1G] + lane;
    f32x4 g[4];
#pragma unroll
    for (int j = 0; j < 4; ++j) g[j] = g4[64 * j];
    for (int m = gw; m < MTOK; m += NGW) {
        const float* xrow = (m < MP) ? a.in[I_XP] + (size_t)m * DM : a.in[I_XS] + (size_t)(m - MP) * DM;
        const f32x4* xr = (const f32x4*)xrow + lane;
        f32x4 v[4]; float s = 0.f;
#pragma unroll
        for (int j = 0; j < 4; ++j) { v[j] = xr[64 * j]; s += (v[j].x * v[j].x + v[j].y * v[j].y) + (v[j].z * v[j].z + v[j].w * v[j].w); }
        const float rstd = __builtin_amdgcn_rsqf(wave_sum(s) * (1.f / DM) + EPS);
        u32x2* o8 = (u32x2*)(H + (size_t)m * DM) + lane;
#pragma unroll
        for (int j = 0; j < 4; ++j) { const f32x4 y = v[j] * rstd * g[j]; u32x2 w; w.x = cvt_pk_bf16(y.x, y.y); w.y = cvt_pk_bf16(y.z, y.w); o8[64 * j] = w; }
    }
}

__device__ __forceinline__ int t5_bucket(int rel) {
    const int n = rel < 0 ? -rel : rel; int b = rel > 0 ? 16 : 0;
    if (n < 8) return b + n;
    int k = (n >= 12) + (n >= 16) + (n >= 23) + (n >= 32) + (n >= 46) + (n >= 64) + (n >= 91);
    return b + 8 + k;
}
__device__ __forceinline__ u32x4 ldg16(const void* ubase, unsigned voff) { return *(const u32x4*)((const char*)ubase + voff); }
__device__ __forceinline__ void p2_unit_info(int unit, int& tok0, int& kb_lo, int& kb_hi) {
    tok0 = unit * 128; int n, nblk; if (unit < MP / 128) { n = unit & 31; nblk = 32; } else { n = (unit - MP / 128) & 63; nblk = 64; }
    kb_lo = (n > 0) ? -1 : 0; kb_hi = (n < nblk - 1) ? 1 : 0;
}
__device__ __forceinline__ void p2_phase(LAS unsigned char* lds, const Args& a, int vcu, int G, bf16_t* Mout) {
    const int tid = threadIdx.x, wave = __builtin_amdgcn_readfirstlane(tid >> 6), lane = tid & 63, c = lane & 31, h = lane >> 5;
    const int hsel = wave >> 2, qt = hsel ? 3 - (wave & 3) : (wave & 3);
    const bf16_t* Qg = (const bf16_t*)(a.ws + WS_Q); const bf16_t* Kg = (const bf16_t*)(a.ws + WS_K); const bf16_t* VTg = (const bf16_t*)(a.ws + WS_VT);
    const bf16_t* GVTg = (const bf16_t*)((unsigned char*)a.out + DO_GVT);
    const bf16_t* Ug = (const bf16_t*)(a.ws + WS_U); const bf16_t* SBg = (const bf16_t*)(a.ws + WS_SB);
    LAS float* tb = (LAS float*)(lds + R_TB); LAS float* rstd_l = (LAS float*)(lds + R_RSTD); LAS float* red = (LAS float*)(lds + R_RED);
    constexpr int NU = MTOK / 128;
    for (int i = tid; i < 8 * TB_N; i += 512) { const int hd = i / TB_N, rel = (i % TB_N) - 160; const int ar = rel < 0 ? -rel : rel;
        tb[i] = (ar <= 128) ? a.in[I_RELB][t5_bucket(rel) * 8 + hd] * LOG2E : -1e30f; }
    if (vcu >= NU) { __syncthreads(); return; }
    const int srow = tid >> 4, sch = tid & 15;
    const f32x4 kg0 = *(const f32x4*)(a.in[I_KG] + sch * 8), kg1 = *(const f32x4*)(a.in[I_KG] + sch * 8 + 4);
    u32x4 Kraw[4], Vraw[4];
    const unsigned offK = (unsigned)(srow * 256 + sch * 8) * 2u, offV = (unsigned)(srow * MTOK + sch * 8) * 2u;
    const unsigned offGV = (unsigned)((lane >> 4) * MTOK + (((lane & 15) ^ ((4 * wave + (lane >> 4)) & 15)) * 8)) * 2u;
    const unsigned offQ = (unsigned)(c * DM + 8 * h) * 2u, offP0 = (unsigned)((tid >> 4) * MTOK + 8 * (tid & 15)) * 2u, offC = (unsigned)((lane >> 4) * DM + (lane & 15) * 8) * 2u;
#define P2_PREFETCH(u_tok0, u_pr, u_kb) do { const int _kt0 = (u_tok0) + (u_kb) * 128, _kvh = (u_pr) >> 1; \
        const char* _kb0 = (const char*)(Kg + (size_t)_kt0 * 256 + _kvh * 128); const char* _vb0 = (const char*)(VTg + (size_t)(_kvh * 128) * MTOK + _kt0); \
        _Pragma("unroll") for (int i = 0; i < 4; ++i) Kraw[i] = ldg16(_kb0 + (size_t)i * (32 * 256 * 2), offK); \
        _Pragma("unroll") for (int i = 0; i < 4; ++i) Vraw[i] = ldg16(_vb0 + (size_t)i * ((size_t)32 * MTOK * 2), offV); } while (0)
    { int t0_, lo_, hi_; p2_unit_info(vcu, t0_, lo_, hi_); P2_PREFETCH(t0_, 0, lo_); }
    for (int unit = vcu; unit < NU; unit += G) {
        int tok0, kb_lo, kb_hi; p2_unit_info(unit, tok0, kb_lo, kb_hi);
        {
            __syncthreads();
            if (tid < 128) { const f32x4* pp = (const f32x4*)((const float*)(a.ws + WS_PART) + (size_t)(tok0 + tid) * 8); const f32x4 p0 = pp[0], p1 = pp[1];
                rstd_l[tid] = __builtin_amdgcn_rsqf((((p0[0] + p0[1]) + (p0[2] + p0[3])) + ((p1[0] + p1[1]) + (p1[2] + p1[3]))) * (1.0f / 1024.0f) + EPS); }
        }
        for (int pr = 0; pr < 4; ++pr) {
        const int hd = 2 * pr + hsel;
        bf16x8 Qf[8]; f32x16 O[4]; float m_run, l_run;
        {
            const char* qb = (const char*)(Qg + (size_t)(tok0 + 32 * qt) * DM + hd * 128); u32x4 raw[8]; float ss = 0.f;
#pragma unroll
            for (int s = 0; s < 8; ++s) raw[s] = ldg16(qb + 32 * s, offQ);
#pragma unroll
            for (int s = 0; s < 8; ++s)
#pragma unroll
                for (int e = 0; e < 4; ++e) { const float lo = bf_lo(raw[s][e]), hi = bf_hi(raw[s][e]); ss += lo * lo + hi * hi; }
            ss = x32_sum(ss);
            const float sc = __builtin_amdgcn_rsqf(ss * (1.0f / 128.0f) + EPS) * (0.08838834764831845f * LOG2E);
            const float* qg = a.in[I_QG] + 8 * h;
#pragma unroll
            for (int s = 0; s < 8; ++s) { const f32x4 g0 = *(const f32x4*)(qg + 16 * s), g1 = *(const f32x4*)(qg + 16 * s + 4); u32x4 w;
                w.x = cvt_pk_bf16(bf_lo(raw[s][0]) * sc * g0[0], bf_hi(raw[s][0]) * sc * g0[1]); w.y = cvt_pk_bf16(bf_lo(raw[s][1]) * sc * g0[2], bf_hi(raw[s][1]) * sc * g0[3]);
                w.z = cvt_pk_bf16(bf_lo(raw[s][2]) * sc * g1[0], bf_hi(raw[s][2]) * sc * g1[1]); w.w = cvt_pk_bf16(bf_lo(raw[s][3]) * sc * g1[2], bf_hi(raw[s][3]) * sc * g1[3]);
                Qf[s] = __builtin_bit_cast(bf16x8, w); }
            m_run = a.in[I_SINK][hd] * LOG2E; l_run = (h == 0) ? 1.0f : 0.0f;
#pragma unroll
            for (int dt = 0; dt < 4; ++dt)
#pragma unroll
                for (int i = 0; i < 16; ++i) O[dt][i] = 0.f;
        }
        for (int kb = kb_lo; kb <= kb_hi; ++kb) {
        if (kb == kb_lo + 1) asm volatile("s_waitcnt vmcnt(0)" ::: "memory");
        __syncthreads();
#pragma unroll
        for (int i = 0; i < 4; ++i) { const u32x4 w = Kraw[i]; float v[8]; float ss = 0.f;
#pragma unroll
            for (int e = 0; e < 4; ++e) { v[2 * e] = bf_lo(w[e]); v[2 * e + 1] = bf_hi(w[e]); ss += v[2 * e] * v[2 * e] + v[2 * e + 1] * v[2 * e + 1]; }
            ss = row16_sum(ss);
            const float sc = __builtin_amdgcn_rsqf(ss * (1.0f / 128.0f) + EPS);
            u32x4 o; o.x = cvt_pk_bf16(v[0] * sc * kg0[0], v[1] * sc * kg0[1]); o.y = cvt_pk_bf16(v[2] * sc * kg0[2], v[3] * sc * kg0[3]);
            o.z = cvt_pk_bf16(v[4] * sc * kg1[0], v[5] * sc * kg1[1]); o.w = cvt_pk_bf16(v[6] * sc * kg1[2], v[7] * sc * kg1[3]);
            *(LAS u32x4*)(lds + R_KT + (srow + 32 * i) * KT_PITCH + sch * 16) = o; }
#pragma unroll
        for (int i = 0; i < 4; ++i) { const u32x4 w = Vraw[i]; LAS u32x2* p = (LAS u32x2*)(lds + R_VT + (srow + 32 * i) * VT_PITCH + sch * 16); p[0] = (u32x2){w.x, w.y}; p[1] = (u32x2){w.z, w.w}; }
        if (kb == kb_lo) {
#pragma unroll
            for (int i = 0; i < 8; ++i) {
                __builtin_amdgcn_global_load_lds((const unsigned*)((const char*)(GVTg + (size_t)(pr * 256 + 32 * i + 4 * wave) * MTOK + tok0) + offGV), (LAS unsigned*)(lds + R_GV + (32 * i + 4 * wave) * 256), 16, 0, 0); } }
        int nunit = unit, npr = pr, nkb = kb + 1, ntok0 = tok0, nkb_lo = kb_lo, nkb_hi = kb_hi;
        if (nkb > kb_hi) { npr = pr + 1; if (npr == 4) { npr = 0; nunit = unit + G; if (nunit < NU) p2_unit_info(nunit, ntok0, nkb_lo, nkb_hi); } nkb = nkb_lo; }
        const bool has_next = nunit < NU;
        if (has_next) P2_PREFETCH(ntok0, npr, nkb);
        __syncthreads();
        {
            const int kt_lo = (kb < 0) ? qt : 0, kt_hi = (kb > 0) ? qt : 3;
            for (int kt = kt_lo; kt <= kt_hi; ++kt) {
                f32x16 s;
#pragma unroll
                for (int i = 0; i < 16; ++i) s[i] = 0.f;
#pragma unroll
                for (int s8 = 0; s8 < 8; ++s8) { const bf16x8 kf = *(const LAS bf16x8*)(lds + R_KT + (32 * kt + c) * KT_PITCH + (16 * s8 + 8 * h) * 2);
                    s = __builtin_amdgcn_mfma_f32_32x32x16_bf16(kf, Qf[s8], s, 0, 0, 0); }
                u32x2 vlo[4], vhi[4];
#pragma unroll
                for (int dt = 0; dt < 2; ++dt)
#pragma unroll
                    for (int s2 = 0; s2 < 2; ++s2) { const LAS unsigned char* vp = lds + R_VT + (32 * dt + c) * VT_PITCH + (32 * kt + 16 * s2 + 4 * h) * 2;
                        vlo[dt * 2 + s2] = *(const LAS u32x2*)vp; vhi[dt * 2 + s2] = *(const LAS u32x2*)(vp + 16); }
                __builtin_amdgcn_sched_barrier(0);
                const LAS float* tbp = tb + hd * TB_N + (kb * 128 + 32 * kt + 4 * h - 32 * qt - c + 160);
                float mx = -3.0e38f;
#pragma unroll
                for (int i = 0; i < 16; ++i) { s[i] += tbp[8 * (i >> 2) + (i & 3)]; mx = fmaxf(mx, s[i]); }
                mx = x32_max(mx);
                const float m_new = fmaxf(m_run, mx), alpha = __builtin_amdgcn_exp2f(m_run - m_new); m_run = m_new;
                float ls = 0.f;
#pragma unroll
                for (int i = 0; i < 16; ++i) { s[i] = __builtin_amdgcn_exp2f(s[i] - m_new); ls += s[i]; }
                l_run = l_run * alpha + ls;
                if (__builtin_amdgcn_ballot_w64(alpha != 1.0f) != 0ull) {
#pragma unroll
                    for (int dt = 0; dt < 4; ++dt)
#pragma unroll
                        for (int i = 0; i < 16; ++i) O[dt][i] *= alpha; }
                bf16x8 Pf[2];
#pragma unroll
                for (int s2 = 0; s2 < 2; ++s2) { u32x4 w; w.x = cvt_pk_bf16(s[8 * s2 + 0], s[8 * s2 + 1]); w.y = cvt_pk_bf16(s[8 * s2 + 2], s[8 * s2 + 3]);
                    w.z = cvt_pk_bf16(s[8 * s2 + 4], s[8 * s2 + 5]); w.w = cvt_pk_bf16(s[8 * s2 + 6], s[8 * s2 + 7]); Pf[s2] = __builtin_bit_cast(bf16x8, w); }
                __builtin_amdgcn_sched_barrier(0);
                u32x2 wlo[4], whi[4];
#pragma unroll
                for (int dt = 2; dt < 4; ++dt)
#pragma unroll
                    for (int s2 = 0; s2 < 2; ++s2) { const LAS unsigned char* vp = lds + R_VT + (32 * dt + c) * VT_PITCH + (32 * kt + 16 * s2 + 4 * h) * 2;
                        wlo[(dt - 2) * 2 + s2] = *(const LAS u32x2*)vp; whi[(dt - 2) * 2 + s2] = *(const LAS u32x2*)(vp + 16); }
#pragma unroll
                for (int dt = 0; dt < 2; ++dt)
#pragma unroll
                    for (int s2 = 0; s2 < 2; ++s2) { const u32x4 w = {vlo[dt * 2 + s2].x, vlo[dt * 2 + s2].y, vhi[dt * 2 + s2].x, vhi[dt * 2 + s2].y};
                        O[dt] = __builtin_amdgcn_mfma_f32_32x32x16_bf16(__builtin_bit_cast(bf16x8, w), Pf[s2], O[dt], 0, 0, 0); }
                __builtin_amdgcn_sched_barrier(0);
#pragma unroll
                for (int dt = 2; dt < 4; ++dt)
#pragma unroll
                    for (int s2 = 0; s2 < 2; ++s2) { const u32x4 w = {wlo[(dt - 2) * 2 + s2].x, wlo[(dt - 2) * 2 + s2].y, whi[(dt - 2) * 2 + s2].x, whi[(dt - 2) * 2 + s2].y};
                        O[dt] = __builtin_amdgcn_mfma_f32_32x32x16_bf16(__builtin_bit_cast(bf16x8, w), Pf[s2], O[dt], 0, 0, 0); }
                __builtin_amdgcn_sched_barrier(0);
            }
        }
        }
        {
            const float inv = __builtin_amdgcn_rcpf(x32_sum(l_run));
            u32x2 t2[4][4];
#pragma unroll
            for (int dt = 0; dt < 4; ++dt)
#pragma unroll
                for (int g4 = 0; g4 < 4; ++g4) { t2[dt][g4].x = cvt_pk_bf16(O[dt][4 * g4] * inv, O[dt][4 * g4 + 1] * inv); t2[dt][g4].y = cvt_pk_bf16(O[dt][4 * g4 + 2] * inv, O[dt][4 * g4 + 3] * inv); }
            bf16x8 Wf[8];
            { const bf16_t* wrow = (const bf16_t*)(a.ws + WS_WSB) + (size_t)(hd * 128 + 32 * qt + c) * 128 + 8 * h;
#pragma unroll
              for (int s8 = 0; s8 < 8; ++s8) { const u32x4 wv = *(const u32x4*)(wrow + 16 * s8);
                  const f32x4 r0 = *(const LAS f32x4*)(rstd_l + 16 * s8 + 8 * h), r1 = *(const LAS f32x4*)(rstd_l + 16 * s8 + 8 * h + 4);
                  u32x4 w; w.x = cvt_pk_bf16(bf_lo(wv.x) * r0[0], bf_hi(wv.x) * r0[1]); w.y = cvt_pk_bf16(bf_lo(wv.y) * r0[2], bf_hi(wv.y) * r0[3]);
                  w.z = cvt_pk_bf16(bf_lo(wv.z) * r1[0], bf_hi(wv.z) * r1[1]); w.w = cvt_pk_bf16(bf_lo(wv.w) * r1[2], bf_hi(wv.w) * r1[3]); Wf[s8] = __builtin_bit_cast(bf16x8, w); } }
            const float bsp = a.in[I_BS][hd * 128 + 32 * qt + c];
            u32x2 t1[4][4];
#pragma unroll
            for (int ct = 0; ct < 4; ++ct) { f32x16 acc;
#pragma unroll
                for (int i = 0; i < 16; ++i) acc[i] = 0.f;
#pragma unroll
                for (int s8 = 0; s8 < 8; ++s8) { const int grow = hsel * 128 + 32 * ct + c; const bf16x8 gf = *(const LAS bf16x8*)(lds + R_GV + grow * 256 + (((2 * s8 + h) ^ (grow & 15)) * 16));
                    acc = __builtin_amdgcn_mfma_f32_32x32x16_bf16(gf, Wf[s8], acc, 0, 0, 0); }
#pragma unroll
                for (int g4 = 0; g4 < 4; ++g4) { const f32x4 gn = *(const f32x4*)(a.in[I_SGUG] + hd * 128 + 32 * ct + 8 * g4 + 4 * h);
                    t1[ct][g4].x = cvt_pk_bf16(acc[4 * g4] * gn[0] + bsp, acc[4 * g4 + 1] * gn[1] + bsp); t1[ct][g4].y = cvt_pk_bf16(acc[4 * g4 + 2] * gn[2] + bsp, acc[4 * g4 + 3] * gn[3] + bsp); } }
            const int tl0 = lane >> 4, ch8 = lane & 15;
            const size_t gu0 = ((size_t)(tok0 + 32 * qt) * DM + hd * 128) * 2;
            __builtin_amdgcn_sched_barrier(0);
            u32x4 cu[4], cb[4];
#pragma unroll
            for (int k = 0; k < 4; ++k) { const size_t go = gu0 + (size_t)(4 * k) * DM * 2; cu[k] = ldg16((const char*)Ug + go, offC); cb[k] = ldg16((const char*)SBg + go, offC); }
            __syncthreads();
            LAS unsigned char* ex = lds + wave * EX_WAVE;
#pragma unroll
            for (int ct = 0; ct < 4; ++ct)
#pragma unroll
                for (int g4 = 0; g4 < 4; ++g4) { const int off = c * KT_PITCH + (32 * ct + 8 * g4 + 4 * h) * 2;
                    *(LAS u32x2*)(ex + off) = t1[ct][g4]; *(LAS u32x2*)(ex + EX_T2 + off) = t2[ct][g4]; }
            asm volatile("s_waitcnt lgkmcnt(0)" ::: "memory");
#pragma unroll
            for (int bt = 0; bt < 2; ++bt) {
                if (bt == 1) {
#pragma unroll
                    for (int k = 0; k < 4; ++k) { const size_t go = gu0 + (size_t)(16 + 4 * k) * DM * 2; cu[k] = ldg16((const char*)Ug + go, offC); cb[k] = ldg16((const char*)SBg + go, offC); } }
#pragma unroll
                for (int k = 0; k < 4; ++k) { const int tl = tl0 + 4 * k + 16 * bt;
                    const u32x4 xu = cu[k], xb = cb[k];
                    const u32x4 a1 = *(const LAS u32x4*)(ex + tl * KT_PITCH + ch8 * 16), a2 = *(const LAS u32x4*)(ex + EX_T2 + tl * KT_PITCH + ch8 * 16);
                    u32x4 o;
#pragma unroll
                    for (int e = 0; e < 4; ++e) {
                        const float lo = bf_lo(xu[e]) * bf_lo(a1[e]) + bf_lo(xb[e]) * bf_lo(a2[e]);
                        const float hi = bf_hi(xu[e]) * bf_hi(a1[e]) + bf_hi(xb[e]) * bf_hi(a2[e]);
                        o[e] = cvt_pk_bf16(lo, hi); }
                    *(u32x4*)((char*)Mout + gu0 + (size_t)(4 * k + 16 * bt) * DM * 2 + offC) = o; }
            }
        }
        }
    }
#undef P2_PREFETCH
    __syncthreads();
}


#define XB_TMO      128
#define XB_XCNT(j)  (256  + 64 * (j))
#define XB_XSUB(j)  (1280 + 64 * (j))
#define XB_XGEN(j)  (2304 + 64 * (j))
#define XB_TOP      3328
#define XB_TOPGEN   3392
#define XCD_BAR_WORDS 3456
#define XB_SPIN_CAP (1u << 22)
__device__ __forceinline__ unsigned xb_ld(unsigned* p)              { return __hip_atomic_load(p, __ATOMIC_RELAXED, __HIP_MEMORY_SCOPE_AGENT); }
__device__ __forceinline__ unsigned xb_add(unsigned* p, unsigned v) { return __hip_atomic_fetch_add(p, v, __ATOMIC_RELAXED, __HIP_MEMORY_SCOPE_AGENT); }
__device__ __forceinline__ unsigned xb_xcc_id() { return (unsigned)__builtin_amdgcn_s_getreg((3 << 11) | 20) & 0xFu; }
#define XB_SPIN(cond, bar) do { unsigned _sp = 0; while (cond) { __builtin_amdgcn_s_sleep(1); \
    if ((++_sp & 255u) == 0u) { if (xb_ld(&(bar)[XB_TMO])) break; if (_sp > XB_SPIN_CAP) { atomicAdd(&(bar)[XB_TMO], 1u); break; } } } } while (0)
struct XcdBarrier { unsigned* bar; unsigned x; volatile LAS unsigned* st; };
__device__ __forceinline__ XcdBarrier xcd_barrier_post(unsigned* bar, volatile LAS unsigned* st) {
    XcdBarrier b; b.bar = bar; b.x = xb_xcc_id(); b.st = st;
    if (threadIdx.x == 0) (void)xb_add(&bar[XB_XCNT(b.x)], 1u);
    return b;
}
__device__ __forceinline__ void xcd_barrier_complete(unsigned* bar, unsigned x, unsigned& nloc, unsigned& nx) {
    const unsigned G = gridDim.x * gridDim.y * gridDim.z;
    unsigned sum, cnt, mine, sp = 0u;
    for (;;) {
        sum = 0u; cnt = 0u; mine = 0u;
#pragma unroll
        for (unsigned j = 0; j < 16; ++j) { const unsigned c = xb_ld(&bar[XB_XCNT(j)]); sum += c; cnt += (c > 0u) ? 1u : 0u; mine = (j == x) ? c : mine; }
        if (sum == G) break;
        __builtin_amdgcn_s_sleep(1);
        if ((++sp & 255u) == 0u) { if (xb_ld(&bar[XB_TMO])) break; if (sp > XB_SPIN_CAP) { atomicAdd(&bar[XB_TMO], 1u); break; } }
    }
    nloc = mine > 0u ? mine : 1u; nx = cnt > 0u ? cnt : 1u;
}
__device__ __forceinline__ void xcd_barrier(const XcdBarrier& b) {
    asm volatile("s_waitcnt vmcnt(0)" ::: "memory");
    __syncthreads();
    if (threadIdx.x == 0) {
        unsigned* bar = b.bar;
        __builtin_amdgcn_s_waitcnt(0);
        unsigned nloc = b.st[0], nx = b.st[1];
        if (nloc == 0u) { xcd_barrier_complete(bar, b.x, nloc, nx); b.st[0] = nloc; b.st[1] = nx; }
        const unsigned old = xb_add(&bar[XB_XSUB(b.x)], 1u);
        const unsigned gen = old / nloc;
        if (old + 1u == (gen + 1u) * nloc) {
            __builtin_amdgcn_fence(__ATOMIC_RELEASE, "agent");
            asm volatile("s_waitcnt vmcnt(0)" ::: "memory");
            const unsigned og = xb_add(&bar[XB_TOP], 1u);
            const unsigned tg = og / nx;
            if (og + 1u == (tg + 1u) * nx) xb_add(&bar[XB_TOPGEN], 1u);
            else XB_SPIN(xb_ld(&bar[XB_TOPGEN]) == tg, bar);
            __builtin_amdgcn_fence(__ATOMIC_ACQUIRE, "agent");
            xb_add(&bar[XB_XGEN(b.x)], 1u);
            asm volatile("s_waitcnt vmcnt(0)" ::: "memory");
        } else {
            XB_SPIN(xb_ld(&bar[XB_XGEN(b.x)]) == gen, bar);
            __builtin_amdgcn_fence(__ATOMIC_ACQUIRE, "agent");
            asm volatile("s_waitcnt vmcnt(0)" ::: "memory");
        }
    }
    __syncthreads();
}
__global__ void __launch_bounds__(512, 2) fwd_megakernel(Args a) {
    extern __shared__ __attribute__((aligned(16))) unsigned char shm[];
    LAS unsigned char* lds = (LAS unsigned char*)shm;
    const int tid = threadIdx.x, lane = tid & 63, wave = __builtin_amdgcn_readfirstlane(tid >> 6);
    const int G = gridDim.x, bx = blockIdx.x;
    const int vcu = (G % 8 == 0) ? (bx % 8) * (G / 8) + bx / 8 : bx;
    const int lo = a.ph_lo, hi = a.ph_hi;
#define IN(k) (lo <= (k) && (k) < hi)
#define SEAM(k) do { if (IN(k) && IN((k) + 1)) { xcd_barrier(gbar); } } while (0)
    volatile LAS unsigned* bst = (volatile LAS unsigned*)(lds + LDS_BYTES - 16);
    if (tid == 0) { bst[0] = 0u; bst[1] = 0u; }
    __syncthreads();
    XcdBarrier gbar; gbar.bar = (unsigned*)(a.ws + WS_BAR); gbar.x = 0; gbar.st = bst;
    if (hi - lo > 1) gbar = xcd_barrier_post((unsigned*)(a.ws + WS_BAR), bst);
    if (hi > 100) cg::this_grid().sync();
    if (IN(0)) for (int rep = (PROBE_DUP == 0 ? 0 : 1); rep < 2; ++rep) { p0_phase(lds, a, vcu, G, wave, lane); __syncthreads(); }
    SEAM(0);
    if (IN(1)) for (int rep = (PROBE_DUP == 1 ? 0 : 1); rep < 2; ++rep) {
        pg8::StaticOrder S; S.init(MTOK, NIN, G, bx);
        P1Ptrs P{(const bf16_t*)((unsigned char*)a.out + DO_H), (const bf16_t*)(a.ws + WS_WT)};
        EpiP1 E{a.ws, (unsigned char*)a.out};
        pg8::gemm_phase(lds, DM, S, P, E);
    }
    SEAM(1);
    if (IN(2)) for (int rep = (PROBE_DUP == 2 ? 0 : 1); rep < 2; ++rep) p2_phase(lds, a, vcu, G, rep == 0 ? (bf16_t*)((unsigned char*)a.out + DO_H) : (bf16_t*)(a.ws + WS_U));
    SEAM(2);
    if (IN(3)) for (int rep = (PROBE_DUP == 3 ? 0 : 1); rep < 2; ++rep) {
        pg8::StaticOrder S; S.init(MTOK, DM, G, bx);
        pg8::PlainPtrs P{(const bf16_t*)(a.ws + WS_U), (const bf16_t*)(a.ws + WS_WOT), DM};
        EpiWo E{a.in[I_XP], a.in[I_XS], (bf16_t*)(a.ws + WS_Q), (float*)(a.ws + WS_PART)};
        pg8::gemm_phase(lds, DM, S, P, E);
    }
    SEAM(3);
    if (IN(4)) for (int rep = (PROBE_DUP == 4 ? 0 : 1); rep < 2; ++rep) {
        pg8::StaticOrder S; S.init(MTOK, DFF, G, bx);
        pg8::PlainPtrs P{(const bf16_t*)(a.ws + WS_Q), (const bf16_t*)(a.ws + WS_W1T), DM};
        EpiFF1 E{(bf16_t*)(a.ws + WS_HID)};
        pg8::gemm_phase(lds, DM, S, P, E);
    }
    SEAM(4);
    if (IN(5)) for (int rep = (PROBE_DUP == 5 ? 0 : 1); rep < 2; ++rep) {
        pg8::StaticOrder S; S.init(MTOK, DM, G, bx);
        pg8::PlainPtrs P{(const bf16_t*)(a.ws + WS_HID), (const bf16_t*)(a.ws + WS_W2T), DFF};
        LAS float* tab = (LAS float*)(lds + R_FF2TAB);
        for (int i = 0; i < 8; ++i) { Unit u; if (!S.next(i, u)) break;
            if (tid < 256) { const f32x4* pp = (const f32x4*)((const float*)(a.ws + WS_PART) + (size_t)(u.pm * 256 + tid) * 16); const f32x4 p0 = pp[0], p1 = pp[1], p2 = pp[2], p3 = pp[3];
                const float ss = ((p0[0] + p0[1]) + (p0[2] + p0[3])) + ((p1[0] + p1[1]) + (p1[2] + p1[3])) + ((p2[0] + p2[1]) + (p2[2] + p2[3])) + ((p3[0] + p3[1]) + (p3[2] + p3[3]));
                tab[i * 256 + tid] = __builtin_amdgcn_rcpf(ss * (1.0f / DM) + EPS); } }
        __syncthreads();
        EpiFF2 E{a.out, (const bf16_t*)(a.ws + WS_Q), tab};
        pg8::gemm_phase(lds, DFF, S, P, E);
    }
#undef IN
#undef SEAM
}

extern "C" void kernel_launch(void* const* d_in, const int* in_sizes, int n_in, void* d_out, int out_size, void* d_ws, size_t ws_size, hipStream_t stream) {
    static int grid = 0;
    if (grid == 0) {
        if (n_in != 15 || out_size != MTOK * DM || ws_size < WS_END) { fprintf(stderr, "kernel_launch: unexpected shapes (n_in %d out %d ws %zu)\n", n_in, out_size, ws_size); grid = -1; return; }
        int dev = 0, cus = 0, per_cu = 0;
        hipGetDevice(&dev); hipDeviceGetAttribute(&cus, hipDeviceAttributeMultiprocessorCount, dev);
        if (hipFuncSetAttribute((const void*)fwd_megakernel, hipFuncAttributeMaxDynamicSharedMemorySize, LDS_BYTES) != hipSuccess) { fprintf(stderr, "kernel_launch: hipFuncSetAttribute failed\n"); grid = -1; return; }
        hipOccupancyMaxActiveBlocksPerMultiprocessor(&per_cu, (const void*)fwd_megakernel, 512, LDS_BYTES);
        if (per_cu < 1) { fprintf(stderr, "kernel_launch: occupancy query says %d blocks/CU\n", per_cu); per_cu = 1; }
        (void)hipGetLastError();
        grid = cus * per_cu;
    }
    if (grid < 0) return;
    Args a{};
    for (int i = 0; i < 15; ++i) a.in[i] = (const float*)d_in[i];
    a.out = (float*)d_out; a.ws = (unsigned char*)d_ws;
    if (N_LAUNCHES == 1) {
        a.ph_lo = 0; a.ph_hi = 6;
        if (hipMemsetAsync((unsigned char*)d_ws + WS_BAR, 0, XCD_BAR_WORDS * 4, stream) != hipSuccess) fprintf(stderr, "kernel_launch: memset of the barrier words failed\n");
        void* args[] = {&a};
        hipError_t e = hipLaunchCooperativeKernel((const void*)fwd_megakernel, dim3(grid), dim3(512), args, LDS_BYTES, stream);
        if (e != hipSuccess) fprintf(stderr, "cooperative launch failed: %s (grid %d)\n", hipGetErrorString(e), grid);
    } else {
        for (int p = 0; p < 6; ++p) { a.ph_lo = p; a.ph_hi = p + 1; hipLaunchKernelGGL(fwd_megakernel, dim3(grid), dim3(512), LDS_BYTES, stream, a); }
    }
}
```

```cpp
#include <hip/hip_runtime.h>
#include <hip/hip_cooperative_groups.h>
#include <cstdio>
namespace cg = cooperative_groups;

#define LAS __attribute__((address_space(3)))
typedef unsigned short bf16_t;
typedef short bf16x8 __attribute__((ext_vector_type(8)));
typedef float f32x4 __attribute__((ext_vector_type(4)));
typedef float f32x16 __attribute__((ext_vector_type(16)));
typedef unsigned u32x4 __attribute__((ext_vector_type(4)));
typedef unsigned u32x2 __attribute__((ext_vector_type(2)));

#ifndef PROBE_DUP
#define PROBE_DUP -1
#endif
#ifndef N_LAUNCHES
#define N_LAUNCHES 1
#endif

constexpr int MP = 8 * 4096, MS = 8 * 8192, MTOK = MP + MS;
constexpr int DM = 1024, NIN = 5632, DFF = 4096;
constexpr float EPS = 1e-6f;
constexpr float LOG2E = 1.4426950408889634f;
constexpr size_t MiB = 1u << 20;
constexpr size_t WS_WT = 0, WS_WOT = 12 * MiB, WS_W1T = 14 * MiB, WS_W2T = 22 * MiB;
constexpr size_t WS_Q = 32 * MiB;
constexpr size_t WS_U = 224 * MiB;
constexpr size_t WS_SA = 416 * MiB, WS_SB = 608 * MiB;
constexpr size_t WS_K = 800 * MiB;
constexpr size_t WS_VT = 848 * MiB;
constexpr size_t WS_HID = 224 * MiB;
constexpr size_t WS_PART = 992 * MiB;
constexpr size_t WS_WSB = 31 * MiB;
constexpr size_t WS_BAR = 1000 * MiB;
constexpr size_t WS_END = 1001 * MiB;
constexpr size_t DO_H = 0, DO_GVT = 192 * MiB;

constexpr int KT_PITCH = 272, VT_PITCH = 264;
constexpr int R_KT = 0, R_VT = 34816, R_GV = 68608;
constexpr int EX_WAVE = 17408, EX_T2 = 8704;
constexpr int R_TB = 139264, TB_N = 320, R_RSTD = R_TB + 8 * TB_N * 4, R_RED = R_RSTD + 512;
constexpr int LDS_BYTES = 155648;
static_assert(R_RED + 4096 <= LDS_BYTES, "lds map");

__device__ __forceinline__ unsigned cvt_pk_bf16(float lo, float hi) { unsigned r; asm volatile("v_cvt_pk_bf16_f32 %0, %1, %2" : "=v"(r) : "v"(lo), "v"(hi)); return r; }
__device__ __forceinline__ float bf_lo(unsigned w) { return __uint_as_float(w << 16); }
__device__ __forceinline__ float bf_hi(unsigned w) { return __uint_as_float(w & 0xffff0000u); }
typedef float f32x2 __attribute__((ext_vector_type(2)));
template <int CTRL> __device__ __forceinline__ float dpp(float x) { return __builtin_bit_cast(float, __builtin_amdgcn_mov_dpp(__builtin_bit_cast(int, x), CTRL, 0xf, 0xf, true)); }
__device__ __forceinline__ float row16_sum(float x) { x += dpp<0xB1>(x); x += dpp<0x4E>(x); x += dpp<0x141>(x); x += dpp<0x128>(x); return x; }
__device__ __forceinline__ float x16_sum(float x) { auto s = __builtin_amdgcn_permlane16_swap(__float_as_uint(x), __float_as_uint(x), false, false); return __uint_as_float(s[0]) + __uint_as_float(s[1]); }
__device__ __forceinline__ float x32_sum(float x) { auto s = __builtin_amdgcn_permlane32_swap(__float_as_uint(x), __float_as_uint(x), false, false); return __uint_as_float(s[0]) + __uint_as_float(s[1]); }
__device__ __forceinline__ float x32_max(float x) { auto s = __builtin_amdgcn_permlane32_swap(__float_as_uint(x), __float_as_uint(x), false, false); return fmaxf(__uint_as_float(s[0]), __uint_as_float(s[1])); }
__device__ __forceinline__ f32x2 gelu2(f32x2 x) { const f32x2 u = x * x, p = u * (0.044715f * -2.302208198f) + (-2.302208198f), t = x * p; f32x2 e; e.x = __builtin_amdgcn_exp2f(t.x); e.y = __builtin_amdgcn_exp2f(t.y);
    const f32x2 d = e + 1.0f; f32x2 r; r.x = __builtin_amdgcn_rcpf(d.x); r.y = __builtin_amdgcn_rcpf(d.y); return x * r; }
__device__ __forceinline__ f32x2 sigmoid2(f32x2 x) { const f32x2 t = x * (-LOG2E); f32x2 e; e.x = __builtin_amdgcn_exp2f(t.x); e.y = __builtin_amdgcn_exp2f(t.y);
    const f32x2 d = e + 1.0f; f32x2 r; r.x = __builtin_amdgcn_rcpf(d.x); r.y = __builtin_amdgcn_rcpf(d.y); return r; }
__device__ __forceinline__ float gelu_tanh(float x) { const float t = x * (1.0f + 0.044715f * x * x) * (-2.302208198f); return x * __builtin_amdgcn_rcpf(1.0f + __builtin_amdgcn_exp2f(t)); }
__device__ __forceinline__ float sigmoidf(float x) { return __builtin_amdgcn_rcpf(1.0f + __builtin_amdgcn_exp2f(-LOG2E * x)); }

namespace pg8 {
constexpr int BM = 256, BK = 64, HALF = 128, HTB = HALF * BK * 2, STAGE_BYTES = 8 * HTB, NXCD = 8, WGM = 8;
__host__ __device__ __forceinline__ int lds_byte(int r, int c) { const int st = (r >> 4) * 2 + (c >> 5), rr = r & 15, cc = c & 31, ob = rr * 64 + cc * 2; return st * 1024 + (ob ^ (((ob >> 9) & 1) << 5)); }
__host__ __device__ __forceinline__ void stage_rc(int b, int& R, int& C) { const int st = b / 1024, sb = b % 1024, swz = sb ^ (((sb >> 9) & 1) << 5); R = (st >> 1) * 16 + swz / 64; C = (st & 1) * 32 + (swz % 64) / 2; }
__host__ __device__ __forceinline__ int perm32(int rho) { const int n = rho >> 4, i = rho & 15; return 8 * (i >> 2) + 4 * n + (i & 3); }
struct Unit { int pm, pn; };
struct StaticOrder {
    int nM, nN, nwg, G, c;
    __device__ void init(int M, int N, int G_, int c_) { nM = M / BM; nN = N / BM; nwg = nM * nN; G = G_; c = c_; }
    __device__ bool next(int i, Unit& u) const {
        const long L = (long)i * G + c; if (L >= nwg) return false;
        int wgid = (int)L; { const int q = nwg / NXCD, r = nwg % NXCD, xcd = wgid % NXCD, off = wgid / NXCD; wgid = (xcd < r ? xcd * (q + 1) : r * (q + 1) + (xcd - r) * q) + off; }
        const int nig = WGM * nN, gid = wgid / nig, fm = gid * WGM, gsz = (nM - fm) < WGM ? (nM - fm) : WGM;
        u.pm = fm + ((wgid % nig) % gsz); u.pn = (wgid % nig) / gsz; return true;
    }
};
struct PlainPtrs { const bf16_t* A; const bf16_t* Bt; int K;
    __device__ __forceinline__ void get(const Unit& u, const char*& a, const char*& b) const { a = (const char*)A + (size_t)u.pm * 512 * K; b = (const char*)Bt + (size_t)u.pn * 512 * K; } };

template <class Epi, class Ptrs>
__device__ __forceinline__ void gemm_phase(LAS unsigned char* lds, const int K, const StaticOrder& S, const Ptrs& P, const Epi& E) {
    const int tid = threadIdx.x, wid = __builtin_amdgcn_readfirstlane(tid >> 6), lane = tid & 63, wr = wid >> 2, wc = wid & 3, fr = lane & 15, fq = lane >> 4;
    const int nt = K / BK;
    unsigned voffA[2], voffB[2];
#pragma unroll
    for (int i = 0; i < 2; ++i) { int R, C; stage_rc(tid * 16 + i * 8192, R, C); const int Rb = (R & ~31) + perm32(R & 31);
        voffA[i] = (unsigned)(R * K + C) * 2u; voffB[i] = (unsigned)(Rb * K + C) * 2u; }
    const size_t kstep = (size_t)(BK * 2);
    const size_t hstep = (size_t)HALF * K * 2;
    const unsigned ldsw = (unsigned)wid * 1024u;
    const int aoff = lds_byte(wr * 64 + fr, fq * 8), boff = lds_byte(wc * 32 + fr, fq * 8);
#define PG8_SA(b, h) (((b) * 2 + (h)) * HTB)
#define PG8_SB(b, h) ((4 + (b) * 2 + (h)) * HTB)
#define PG8_STAGE(bufoff, gbase, voff) do { _Pragma("unroll") for (int _i = 0; _i < 2; ++_i) \
        __builtin_amdgcn_global_load_lds((const unsigned*)((const char*)(gbase) + (voff)[_i]), (LAS unsigned*)(lds + (bufoff) + ldsw + _i * 8192), 16, 0, 0); } while (0)
#define PG8_LDA(dst, b, h) do { _Pragma("unroll") for (int m = 0; m < 4; ++m) _Pragma("unroll") for (int k = 0; k < 2; ++k) dst[m][k] = *(const LAS bf16x8*)(lds + PG8_SA(b, h) + aoff + m * 2048 + k * 1024); } while (0)
#define PG8_LDB(dst, b, h) do { _Pragma("unroll") for (int n = 0; n < 2; ++n) _Pragma("unroll") for (int k = 0; k < 2; ++k) dst[n][k] = *(const LAS bf16x8*)(lds + PG8_SB(b, h) + boff + n * 2048 + k * 1024); } while (0)
#define PG8_MMA(ai, bj, At, Bt) do { __builtin_amdgcn_s_setprio(1); _Pragma("unroll") for (int m = 0; m < 4; ++m) _Pragma("unroll") for (int n = 0; n < 2; ++n) _Pragma("unroll") for (int k = 0; k < 2; ++k) \
        acc[ai][bj][m][n] = __builtin_amdgcn_mfma_f32_16x16x32_bf16(Bt[n][k], At[m][k], acc[ai][bj][m][n], 0, 0, 0); __builtin_amdgcn_s_setprio(0); } while (0)
#define PG8_WAIT_V(n) asm volatile("s_waitcnt vmcnt(" #n ")" ::: "memory")
#define PG8_WAIT_L(n) asm volatile("s_waitcnt lgkmcnt(" #n ")" ::: "memory")
#define PG8_BAR __builtin_amdgcn_s_barrier()
#define PG8_SCHED __builtin_amdgcn_sched_barrier(0)
    Unit cur, nxt; int ui = 0;
    if (!S.next(0, cur)) return;
    f32x4 acc[2][2][4][2];
#pragma unroll
    for (int a = 0; a < 2; ++a)
#pragma unroll
        for (int b = 0; b < 2; ++b)
#pragma unroll
            for (int m = 0; m < 4; ++m)
#pragma unroll
                for (int n = 0; n < 2; ++n) acc[a][b][m][n] = (f32x4){0.f, 0.f, 0.f, 0.f};
    bf16x8 At[4][2], B0[2][2], B1[2][2];
    const char* cA; const char* cB; P.get(cur, cA, cB);
    PG8_STAGE(PG8_SB(0, 0), cB, voffB); PG8_STAGE(PG8_SA(0, 0), cA, voffA); PG8_STAGE(PG8_SB(0, 1), cB + hstep, voffB); PG8_STAGE(PG8_SA(0, 1), cA + hstep, voffA);
    if (wr == 1) PG8_BAR;
    PG8_WAIT_V(4); PG8_BAR;
    PG8_STAGE(PG8_SB(1, 0), cB + kstep, voffB); PG8_STAGE(PG8_SA(1, 0), cA + kstep, voffA); PG8_STAGE(PG8_SB(1, 1), cB + hstep + kstep, voffB);
    PG8_WAIT_V(6); PG8_BAR;
    for (;;) {
        const bool has_next = S.next(ui + 1, nxt);
        const char* nA = cA; const char* nB = cB; if (has_next) P.get(nxt, nA, nB);
        for (int t = 0; t < nt; t += 2) {
            const bool last = (t == nt - 2);
            const char* a1 = cA + (size_t)(t + 1) * kstep;
            const char* a2 = last ? nA : cA + (size_t)(t + 2) * kstep; const char* b2 = last ? nB : cB + (size_t)(t + 2) * kstep;
            const char* a3 = a2 + kstep; const char* b3 = b2 + kstep;
            PG8_LDB(B0, 0, 0); PG8_SCHED; PG8_LDA(At, 0, 0); PG8_STAGE(PG8_SA(1, 1), a1 + hstep, voffA);
            PG8_WAIT_L(8); PG8_BAR; PG8_WAIT_L(0); PG8_MMA(0, 0, At, B0); PG8_BAR; PG8_SCHED;
            PG8_LDB(B1, 0, 1); PG8_STAGE(PG8_SB(0, 0), b2, voffB);
            PG8_BAR; PG8_WAIT_L(0); PG8_MMA(0, 1, At, B1); PG8_BAR;
            PG8_LDA(At, 0, 1); PG8_STAGE(PG8_SA(0, 0), a2, voffA);
            PG8_BAR; PG8_WAIT_L(0); PG8_MMA(1, 0, At, B0); PG8_BAR; PG8_SCHED;
            PG8_STAGE(PG8_SB(0, 1), b2 + hstep, voffB);
            PG8_WAIT_V(6); PG8_BAR; PG8_MMA(1, 1, At, B1); PG8_BAR;
            PG8_LDB(B0, 1, 0); PG8_SCHED; PG8_LDA(At, 1, 0); PG8_STAGE(PG8_SA(0, 1), a2 + hstep, voffA);
            PG8_WAIT_L(8); PG8_BAR; PG8_WAIT_L(0); PG8_MMA(0, 0, At, B0); PG8_BAR; PG8_SCHED;
            PG8_LDB(B1, 1, 1); PG8_STAGE(PG8_SB(1, 0), b3, voffB);
            PG8_BAR; PG8_WAIT_L(0); PG8_MMA(0, 1, At, B1); PG8_BAR;
            PG8_LDA(At, 1, 1); PG8_STAGE(PG8_SA(1, 0), a3, voffA);
            PG8_BAR; PG8_WAIT_L(0); PG8_MMA(1, 0, At, B0); PG8_BAR; PG8_SCHED;
            PG8_STAGE(PG8_SB(1, 1), b3 + hstep, voffB);
            PG8_WAIT_V(6); PG8_BAR; PG8_MMA(1, 1, At, B1); PG8_BAR;
        }
        E(acc, cur, ui, wr, wc, fr, fq);
        if (!has_next) break;
#pragma unroll
        for (int a = 0; a < 2; ++a)
#pragma unroll
            for (int b = 0; b < 2; ++b)
#pragma unroll
                for (int m = 0; m < 4; ++m)
#pragma unroll
                    for (int n = 0; n < 2; ++n) acc[a][b][m][n] = (f32x4){0.f, 0.f, 0.f, 0.f};
        cur = nxt; cA = nA; cB = nB; ++ui;
    }
    PG8_WAIT_V(0);
    if (wr == 0) PG8_BAR;
    PG8_BAR;
#undef PG8_SA
#undef PG8_SB
#undef PG8_STAGE
#undef PG8_LDA
#undef PG8_LDB
#undef PG8_MMA
#undef PG8_WAIT_V
#undef PG8_WAIT_L
#undef PG8_BAR
#undef PG8_SCHED
}
}
using pg8::Unit;

struct Args { const float* in[15]; float* out; unsigned char* ws; int ph_lo, ph_hi; };
enum { I_XP = 0, I_XS, I_RELB, I_N1G, I_WIN, I_SGUG, I_WS, I_BS, I_QG, I_KG, I_SINK, I_WO, I_N2G, I_W1, I_W2 };

struct P1Ptrs { const bf16_t* H; const bf16_t* Wt;
    __device__ __forceinline__ void get(const Unit& u, const char*& a, const char*& b) const {
        const char* hp = (const char*)H + (size_t)u.pm * 512 * DM; const char* wp = (const char*)Wt + (size_t)u.pn * 512 * DM;
        if (u.pn < 17) { a = hp; b = wp; } else { a = wp; b = hp; } } };
__device__ __forceinline__ u32x4 pack8(f32x4 v0, f32x4 v1) { u32x4 w; w.x = cvt_pk_bf16(v0[0], v0[1]); w.y = cvt_pk_bf16(v0[2], v0[3]); w.z = cvt_pk_bf16(v1[0], v1[1]); w.w = cvt_pk_bf16(v1[2], v1[3]); return w; }
__device__ __forceinline__ f32x2 g1_2(f32x2 x, f32x2 g) { const f32x2 u = x * x, p = u * (0.044715f * -2.302208198f) + (-2.302208198f), t = x * p, tg = g * (-LOG2E);
    f32x2 e1, e2; e1.x = __builtin_amdgcn_exp2f(t.x); e1.y = __builtin_amdgcn_exp2f(t.y); e2.x = __builtin_amdgcn_exp2f(tg.x); e2.y = __builtin_amdgcn_exp2f(tg.y);
    const f32x2 d = (e1 + 1.0f) * (e2 + 1.0f); f32x2 r; r.x = __builtin_amdgcn_rcpf(d.x); r.y = __builtin_amdgcn_rcpf(d.y); return x * r; }
__device__ __forceinline__ f32x4 g1_4(f32x4 v, f32x4 g) { const f32x2 a = g1_2((f32x2){v[0], v[1]}, (f32x2){g[0], g[1]}), b = g1_2((f32x2){v[2], v[3]}, (f32x2){g[2], g[3]}); return (f32x4){a.x, a.y, b.x, b.y}; }
__device__ __forceinline__ f32x4 gelu4(f32x4 v) { const f32x2 a = gelu2((f32x2){v[0], v[1]}), b = gelu2((f32x2){v[2], v[3]}); return (f32x4){a.x, a.y, b.x, b.y}; }
__device__ __forceinline__ f32x4 sigmoid4(f32x4 v) { const f32x2 a = sigmoid2((f32x2){v[0], v[1]}), b = sigmoid2((f32x2){v[2], v[3]}); return (f32x4){a.x, a.y, b.x, b.y}; }
struct EpiP1 {
    unsigned char* ws; unsigned char* dout;
    __device__ __forceinline__ void operator()(const f32x4 (&acc)[2][2][4][2], const Unit& u, int ui, int wr, int wc, int fr, int fq) const {
        const int pn = u.pn;
        if (pn < 8) {
            bf16_t* base = (bf16_t*)(ws + WS_U) + (size_t)(u.pm * 256 + wr * 64 + fr) * DM + pn * 128 + wc * 32 + 8 * fq;
#pragma unroll
            for (int ai = 0; ai < 2; ++ai)
#pragma unroll
                for (int m = 0; m < 4; ++m) {
                    const f32x4 g0 = g1_4(acc[ai][0][m][0], acc[ai][1][m][0]), g1 = g1_4(acc[ai][0][m][1], acc[ai][1][m][1]);
                    *(u32x4*)(base + (size_t)(ai * 128 + m * 16) * DM) = pack8(g0, g1); }
            return; }
        if (pn >= 17 && pn < 21) {
            bf16_t* base = (bf16_t*)(dout + DO_GVT) + (size_t)((pn - 17) * 256 + wr * 64 + fr) * MTOK + u.pm * 256 + wc * 32 + 8 * fq;
            float* pp = (float*)(ws + WS_PART) + (size_t)(u.pm * 256 + wc * 32 + 8 * fq) * 8 + (pn - 17) * 2 + wr;
#pragma unroll
            for (int bj = 0; bj < 2; ++bj) { f32x4 sq0 = {0.f, 0.f, 0.f, 0.f}, sq1 = {0.f, 0.f, 0.f, 0.f};
#pragma unroll
                for (int ai = 0; ai < 2; ++ai)
#pragma unroll
                    for (int m = 0; m < 4; ++m) { const f32x4 g0 = gelu4(acc[ai][bj][m][0]), g1 = gelu4(acc[ai][bj][m][1]);
                        sq0 += g0 * g0; sq1 += g1 * g1;
                        *(u32x4*)(base + (size_t)(ai * 128 + m * 16) * MTOK + bj * 128) = pack8(g0, g1); }
#pragma unroll
                for (int j = 0; j < 4; ++j) { const float t0 = row16_sum(sq0[j]), t1 = row16_sum(sq1[j]); if (fr == 0) { pp[(size_t)(bj * 128 + j) * 8] = t0; pp[(size_t)(bj * 128 + 4 + j) * 8] = t1; } } }
            return; }
        bf16_t* base; size_t ld; int row0, col0, act;
        if (pn < 12)      { base = (bf16_t*)(ws + WS_Q);  ld = DM;  row0 = u.pm * 256; col0 = (pn - 8) * 256;  act = 0; }
        else if (pn < 13) { base = (bf16_t*)(ws + WS_K);  ld = 256; row0 = u.pm * 256; col0 = 0;               act = 0; }
        else if (pn < 17) { base = (bf16_t*)(ws + WS_SB); ld = DM;  row0 = u.pm * 256; col0 = (pn - 13) * 256; act = 2; }
        else              { base = (bf16_t*)(ws + WS_VT); ld = MTOK; row0 = 0; col0 = u.pm * 256; act = 0; }
        const int r0 = row0 + wr * 64 + fr, c0 = col0 + wc * 32 + 8 * fq;
#pragma unroll
        for (int ai = 0; ai < 2; ++ai)
#pragma unroll
            for (int m = 0; m < 4; ++m) { bf16_t* rowp = base + (size_t)(r0 + ai * 128 + m * 16) * ld + c0;
#pragma unroll
                for (int bj = 0; bj < 2; ++bj) { f32x4 v0 = acc[ai][bj][m][0], v1 = acc[ai][bj][m][1];
                    if (act == 2) { v0 = sigmoid4(v0); v1 = sigmoid4(v1); }
                    *(u32x4*)(rowp + bj * 128) = pack8(v0, v1); } }
    }
};
struct EpiWo {
    const float* xp; const float* xs; bf16_t* xb; float* part;
    __device__ __forceinline__ void operator()(const f32x4 (&acc)[2][2][4][2], const Unit& u, int ui, int wr, int wc, int fr, int fq) const {
        const int row0 = u.pm * 256 + wr * 64 + fr, col0 = u.pn * 256 + wc * 32 + 8 * fq;
        const float* xb0 = (u.pm * 256 < MP) ? xp : xs - (size_t)MP * DM;
#pragma unroll
        for (int ai = 0; ai < 2; ++ai) {
            f32x4 xv[4][2][2];
#pragma unroll
            for (int m = 0; m < 4; ++m)
#pragma unroll
                for (int bj = 0; bj < 2; ++bj) { const float* p = xb0 + (size_t)(row0 + ai * 128 + m * 16) * DM + col0 + bj * 128; xv[m][bj][0] = *(const f32x4*)p; xv[m][bj][1] = *(const f32x4*)(p + 4); }
#pragma unroll
            for (int m = 0; m < 4; ++m) { const int row = row0 + ai * 128 + m * 16; const size_t off = (size_t)row * DM + col0; float ss = 0.f;
#pragma unroll
                for (int bj = 0; bj < 2; ++bj) {
                    const f32x4 v0 = acc[ai][bj][m][0] + xv[m][bj][0], v1 = acc[ai][bj][m][1] + xv[m][bj][1];
                    u32x4 w; w.x = cvt_pk_bf16(v0[0], v0[1]); w.y = cvt_pk_bf16(v0[2], v0[3]); w.z = cvt_pk_bf16(v1[0], v1[1]); w.w = cvt_pk_bf16(v1[2], v1[3]);
                    *(u32x4*)(xb + off + bj * 128) = w;
                    ss += (v0[0] * v0[0] + v0[1] * v0[1]) + (v0[2] * v0[2] + v0[3] * v0[3]) + (v1[0] * v1[0] + v1[1] * v1[1]) + (v1[2] * v1[2] + v1[3] * v1[3]); }
                ss = x32_sum(x16_sum(ss));
                if (fq == 0) part[(size_t)row * 16 + u.pn * 4 + wc] = ss; }
        }
    }
};
struct EpiFF1 {
    bf16_t* hid;
    __device__ __forceinline__ void operator()(const f32x4 (&acc)[2][2][4][2], const Unit& u, int ui, int wr, int wc, int fr, int fq) const {
        const int row0 = u.pm * 256 + wr * 64 + fr, col0 = u.pn * 256 + wc * 32 + 8 * fq;
#pragma unroll
        for (int ai = 0; ai < 2; ++ai)
#pragma unroll
            for (int m = 0; m < 4; ++m) { bf16_t* rowp = hid + (size_t)(row0 + ai * 128 + m * 16) * DFF + col0;
#pragma unroll
                for (int bj = 0; bj < 2; ++bj) { f32x4 v0 = acc[ai][bj][m][0], v1 = acc[ai][bj][m][1];
#pragma unroll
                    for (int j = 0; j < 4; ++j) { const float a = fmaxf(v0[j], 0.f), b = fmaxf(v1[j], 0.f); v0[j] = a * a; v1[j] = b * b; }
                    u32x4 w; w.x = cvt_pk_bf16(v0[0], v0[1]); w.y = cvt_pk_bf16(v0[2], v0[3]); w.z = cvt_pk_bf16(v1[0], v1[1]); w.w = cvt_pk_bf16(v1[2], v1[3]);
                    *(u32x4*)(rowp + bj * 128) = w; } }
    }
};
constexpr int R_FF2TAB = 131072;
struct EpiFF2 {
    float* out; const bf16_t* xb; const LAS float* tab;
    __device__ __forceinline__ void operator()(const f32x4 (&acc)[2][2][4][2], const Unit& u, int ui, int wr, int wc, int fr, int fq) const {
        const int rl0 = wr * 64 + fr, col0 = u.pn * 256 + wc * 32 + 8 * fq;
        u32x4 xv[2][4][2];
#pragma unroll
        for (int ai = 0; ai < 2; ++ai)
#pragma unroll
            for (int m = 0; m < 4; ++m)
#pragma unroll
                for (int bj = 0; bj < 2; ++bj) xv[ai][m][bj] = *(const u32x4*)(xb + (size_t)(u.pm * 256 + rl0 + ai * 128 + m * 16) * DM + col0 + bj * 128);
#pragma unroll
        for (int ai = 0; ai < 2; ++ai)
#pragma unroll
            for (int m = 0; m < 4; ++m) { const int rl = rl0 + ai * 128 + m * 16; float* rowp = out + (size_t)(u.pm * 256 + rl) * DM + col0;
                const float r2 = tab[ui * 256 + rl];
#pragma unroll
                for (int bj = 0; bj < 2; ++bj) { const u32x4 x = xv[ai][m][bj];
                    const f32x4 x0 = {bf_lo(x.x), bf_hi(x.x), bf_lo(x.y), bf_hi(x.y)}, x1 = {bf_lo(x.z), bf_hi(x.z), bf_lo(x.w), bf_hi(x.w)};
                    *(f32x4*)(rowp + bj * 128) = acc[ai][bj][m][0] * r2 + x0; *(f32x4*)(rowp + bj * 128 + 4) = acc[ai][bj][m][1] * r2 + x1; } }
    }
};

__device__ __forceinline__ void p0_transpose_blk(const float* W, int ldw, const float* kscale, bf16_t* WT, int K, int k0, int n0src, int n0dst, LAS float* scr, int lane) {
#pragma unroll 8
    for (int i = 0; i < 32; ++i) { const int kk = 2 * i + (lane >> 5); float v = W[(size_t)(k0 + kk) * ldw + n0src + (lane & 31)]; if (kscale) v *= kscale[k0 + kk]; scr[kk * 33 + (lane & 31)] = v; }
    asm volatile("s_waitcnt lgkmcnt(0)" ::: "memory");
    const int c = lane & 7;
#pragma unroll
    for (int j = 0; j < 4; ++j) { const int n = (lane >> 3) + 8 * j; const LAS float* s = scr + (8 * c) * 33 + n;
        u32x4 o; o.x = cvt_pk_bf16(s[0 * 33], s[1 * 33]); o.y = cvt_pk_bf16(s[2 * 33], s[3 * 33]); o.z = cvt_pk_bf16(s[4 * 33], s[5 * 33]); o.w = cvt_pk_bf16(s[6 * 33], s[7 * 33]);
        *(u32x4*)(WT + (size_t)(n0dst + n) * K + k0 + 8 * c) = o; }
    asm volatile("s_waitcnt lgkmcnt(0)" ::: "memory");
}
__device__ __forceinline__ int win_src_col(int d) {
    if (d < 2048) { const int j = d >> 8, w = d & 255; return w < 128 ? 128 * j + w : 3584 + 128 * j + (w - 128); }
    if (d < 3072) return 2048 + (d - 2048);
    if (d < 3328) return 3072 + (d - 3072);
    if (d < 4352) return 4608 + (d - 3328);
    if (d < 5376) return 1024 + (d - 4352);
    return 3328 + (d - 5376);
}
__device__ __forceinline__ float wave_sum(float v) { return x32_sum(x16_sum(row16_sum(v))); }
__device__ __forceinline__ void p0_phase(LAS unsigned char* lds, const Args& a, int vcu, int G, int wave, int lane) {
    LAS float* scr = (LAS float*)(lds + wave * 16384);
    const int gw = vcu * 8 + wave, NGW = G * 8;
    bf16_t* Wt = (bf16_t*)(a.ws + WS_WT);
    const float* win = a.in[I_WIN];
    constexpr int I_IN = 16 * (NIN / 32), I_O = 16 * 32, I_1 = 16 * (DFF / 32), I_2 = 64 * 32;
    for (int it = gw; it < I_IN + I_O + I_1 + I_2; it += NGW) {
        int r = it;
        if (r < I_IN) { const int kb = r / (NIN / 32), nb = r % (NIN / 32); p0_transpose_blk(win, NIN, nullptr, Wt, DM, 64 * kb, win_src_col(32 * nb), 32 * nb, scr, lane); continue; }
        r -= I_IN;
        if (r < I_O) { const int kb = r / 32, nb = r % 32; p0_transpose_blk(a.in[I_WO], DM, nullptr, (bf16_t*)(a.ws + WS_WOT), DM, 64 * kb, 32 * nb, 32 * nb, scr, lane); continue; } r -= I_O;
        if (r < I_1) { const int kb = r / 128, nb = r % 128; p0_transpose_blk(a.in[I_W1], DFF, a.in[I_N2G], (bf16_t*)(a.ws + WS_W1T), DM, 64 * kb, 32 * nb, 32 * nb, scr, lane); continue; } r -= I_1;
        { const int kb = r / 32, nb = r % 32; p0_transpose_blk(a.in[I_W2], DM, nullptr, (bf16_t*)(a.ws + WS_W2T), DFF, 64 * kb, 32 * nb, 32 * nb, scr, lane); }
    }
    { const int gt = gw * 64 + lane; if (gt < 8 * 128 * 128 / 8) { const f32x4 w0 = ((const f32x4*)a.in[I_WS])[2 * gt], w1 = ((const f32x4*)a.in[I_WS])[2 * gt + 1]; ((u32x4*)(a.ws + WS_WSB))[gt] = pack8(w0, w1); } }
    bf16_t* H = (bf16_t*)((unsigned char*)a.out + DO_H);
    const f32x4* g4 = (const f32x4*)a.in[I_N1G] + lane;
    f32x4 g[4];
#pragma unroll
    for (int j = 0; j < 4; ++j) g[j] = g4[64 * j];
    for (int m = gw; m < MTOK; m += NGW) {
        const float* xrow = (m < MP) ? a.in[I_XP] + (size_t)m * DM : a.in[I_XS] + (size_t)(m - MP) * DM;
        const f32x4* xr = (const f32x4*)xrow + lane;
        f32x4 v[4]; float s = 0.f;
#pragma unroll
        for (int j = 0; j < 4; ++j) { v[j] = xr[64 * j]; s += (v[j].x * v[j].x + v[j].y * v[j].y) + (v[j].z * v[j].z + v[j].w * v[j].w); }
        const float rstd = __builtin_amdgcn_rsqf(wave_sum(s) * (1.f / DM) + EPS);
        u32x2* o8 = (u32x2*)(H + (size_t)m * DM) + lane;
#pragma unroll
        for (int j = 0; j < 4; ++j) { const f32x4 y = v[j] * rstd * g[j]; u32x2 w; w.x = cvt_pk_bf16(y.x, y.y); w.y = cvt_pk_bf16(y.z, y.w); o8[64 * j] = w; }
    }
}

__device__ __forceinline__ int t5_bucket(int rel) {
    const int n = rel < 0 ? -rel : rel; int b = rel > 0 ? 16 : 0;
    if (n < 8) return b + n;
    int k = (n >= 12) + (n >= 16) + (n >= 23) + (n >= 32) + (n >= 46) + (n >= 64) + (n >= 91);
    return b + 8 + k;
}
__device__ __forceinline__ u32x4 ldg16(const void* ubase, unsigned voff) { return *(const u32x4*)((const char*)ubase + voff); }
__device__ __forceinline__ void p2_unit_info(int unit, int& tok0, int& kb_lo, int& kb_hi) {
    tok0 = unit * 128; int n, nblk; if (unit < MP / 128) { n = unit & 31; nblk = 32; } else { n = (unit - MP / 128) & 63; nblk = 64; }
    kb_lo = (n > 0) ? -1 : 0; kb_hi = (n < nblk - 1) ? 1 : 0;
}
#define P2_BAR() do { asm volatile("s_waitcnt lgkmcnt(0)" ::: "memory"); __builtin_amdgcn_s_barrier(); asm volatile("" ::: "memory"); } while (0)
__device__ __forceinline__ void p2_phase(LAS unsigned char* lds, const Args& a, int vcu, int G, bf16_t* Mout) {
    const int tid = threadIdx.x, wave = __builtin_amdgcn_readfirstlane(tid >> 6), lane = tid & 63, c = lane & 31, h = lane >> 5;
    const int hsel = wave >> 2, qt = hsel ? 3 - (wave & 3) : (wave & 3);
    const bf16_t* Qg = (const bf16_t*)(a.ws + WS_Q); const bf16_t* Kg = (const bf16_t*)(a.ws + WS_K); const bf16_t* VTg = (const bf16_t*)(a.ws + WS_VT);
    const bf16_t* GVTg = (const bf16_t*)((unsigned char*)a.out + DO_GVT);
    const bf16_t* Ug = (const bf16_t*)(a.ws + WS_U); const bf16_t* SBg = (const bf16_t*)(a.ws + WS_SB);
    LAS float* tb = (LAS float*)(lds + R_TB); LAS float* rstd_l = (LAS float*)(lds + R_RSTD); LAS float* red = (LAS float*)(lds + R_RED);
    constexpr int NU = MTOK / 128;
    for (int i = tid; i < 8 * TB_N; i += 512) { const int hd = i / TB_N, rel = (i % TB_N) - 160; const int ar = rel < 0 ? -rel : rel;
        tb[i] = (ar <= 128) ? a.in[I_RELB][t5_bucket(rel) * 8 + hd] * LOG2E : -1e30f; }
    if (vcu >= NU) { P2_BAR(); return; }
    const int srow = tid >> 4, sch = tid & 15;
    const f32x4 kg0 = *(const f32x4*)(a.in[I_KG] + sch * 8), kg1 = *(const f32x4*)(a.in[I_KG] + sch * 8 + 4);
    u32x4 Kraw[4], Vraw[4];
    const unsigned offK = (unsigned)(srow * 256 + sch * 8) * 2u, offV = (unsigned)(srow * MTOK + sch * 8) * 2u;
    const unsigned offGV = (unsigned)((lane >> 4) * MTOK + (((lane & 15) ^ ((4 * wave + (lane >> 4)) & 15)) * 8)) * 2u;
    const unsigned offQ = (unsigned)(c * DM + 8 * h) * 2u, offP0 = (unsigned)((tid >> 4) * MTOK + 8 * (tid & 15)) * 2u, offC = (unsigned)((lane >> 4) * DM + (lane & 15) * 8) * 2u;
#define P2_PREFETCH(u_tok0, u_pr, u_kb) do { const int _kt0 = (u_tok0) + (u_kb) * 128, _kvh = (u_pr) >> 1; \
        const char* _kb0 = (const char*)(Kg + (size_t)_kt0 * 256 + _kvh * 128); const char* _vb0 = (const char*)(VTg + (size_t)(_kvh * 128) * MTOK + _kt0); \
        _Pragma("unroll") for (int i = 0; i < 4; ++i) Kraw[i] = ldg16(_kb0 + (size_t)i * (32 * 256 * 2), offK); \
        _Pragma("unroll") for (int i = 0; i < 4; ++i) Vraw[i] = ldg16(_vb0 + (size_t)i * ((size_t)32 * MTOK * 2), offV); } while (0)
    { int t0_, lo_, hi_; p2_unit_info(vcu, t0_, lo_, hi_); P2_PREFETCH(t0_, 0, lo_); }
    for (int unit = vcu; unit < NU; unit += G) {
        int tok0, kb_lo, kb_hi; p2_unit_info(unit, tok0, kb_lo, kb_hi);
        {
            P2_BAR();
            if (tid < 128) { const f32x4* pp = (const f32x4*)((const float*)(a.ws + WS_PART) + (size_t)(tok0 + tid) * 8); const f32x4 p0 = pp[0], p1 = pp[1];
                rstd_l[tid] = __builtin_amdgcn_rsqf((((p0[0] + p0[1]) + (p0[2] + p0[3])) + ((p1[0] + p1[1]) + (p1[2] + p1[3]))) * (1.0f / 1024.0f) + EPS); }
        }
        for (int pr = 0; pr < 4; ++pr) {
        const int hd = 2 * pr + hsel;
        bf16x8 Qf[8]; f32x16 O[4]; float m_run, l_run;
        {
            const char* qb = (const char*)(Qg + (size_t)(tok0 + 32 * qt) * DM + hd * 128); u32x4 raw[8]; float ss = 0.f;
#pragma unroll
            for (int s = 0; s < 8; ++s) raw[s] = ldg16(qb + 32 * s, offQ);
#pragma unroll
            for (int s = 0; s < 8; ++s)
#pragma unroll
                for (int e = 0; e < 4; ++e) { const float lo = bf_lo(raw[s][e]), hi = bf_hi(raw[s][e]); ss += lo * lo + hi * hi; }
            ss = x32_sum(ss);
            const float sc = __builtin_amdgcn_rsqf(ss * (1.0f / 128.0f) + EPS) * (0.08838834764831845f * LOG2E);
            const float* qg = a.in[I_QG] + 8 * h;
#pragma unroll
            for (int s = 0; s < 8; ++s) { const f32x4 g0 = *(const f32x4*)(qg + 16 * s), g1 = *(const f32x4*)(qg + 16 * s + 4); u32x4 w;
                w.x = cvt_pk_bf16(bf_lo(raw[s][0]) * sc * g0[0], bf_hi(raw[s][0]) * sc * g0[1]); w.y = cvt_pk_bf16(bf_lo(raw[s][1]) * sc * g0[2], bf_hi(raw[s][1]) * sc * g0[3]);
                w.z = cvt_pk_bf16(bf_lo(raw[s][2]) * sc * g1[0], bf_hi(raw[s][2]) * sc * g1[1]); w.w = cvt_pk_bf16(bf_lo(raw[s][3]) * sc * g1[2], bf_hi(raw[s][3]) * sc * g1[3]);
                Qf[s] = __builtin_bit_cast(bf16x8, w); }
            m_run = a.in[I_SINK][hd] * LOG2E; l_run = (h == 0) ? 1.0f : 0.0f;
#pragma unroll
            for (int dt = 0; dt < 4; ++dt)
#pragma unroll
                for (int i = 0; i < 16; ++i) O[dt][i] = 0.f;
        }
        for (int kb = kb_lo; kb <= kb_hi; ++kb) {
        if (kb == kb_lo + 1) asm volatile("s_waitcnt vmcnt(0)" ::: "memory");
        P2_BAR();
#pragma unroll
        for (int i = 0; i < 4; ++i) { const u32x4 w = Kraw[i]; float v[8]; float ss = 0.f;
#pragma unroll
            for (int e = 0; e < 4; ++e) { v[2 * e] = bf_lo(w[e]); v[2 * e + 1] = bf_hi(w[e]); ss += v[2 * e] * v[2 * e] + v[2 * e + 1] * v[2 * e + 1]; }
            ss = row16_sum(ss);
            const float sc = __builtin_amdgcn_rsqf(ss * (1.0f / 128.0f) + EPS);
            u32x4 o; o.x = cvt_pk_bf16(v[0] * sc * kg0[0], v[1] * sc * kg0[1]); o.y = cvt_pk_bf16(v[2] * sc * kg0[2], v[3] * sc * kg0[3]);
            o.z = cvt_pk_bf16(v[4] * sc * kg1[0], v[5] * sc * kg1[1]); o.w = cvt_pk_bf16(v[6] * sc * kg1[2], v[7] * sc * kg1[3]);
            *(LAS u32x4*)(lds + R_KT + (srow + 32 * i) * KT_PITCH + sch * 16) = o; }
#pragma unroll
        for (int i = 0; i < 4; ++i) { const u32x4 w = Vraw[i]; LAS u32x2* p = (LAS u32x2*)(lds + R_VT + (srow + 32 * i) * VT_PITCH + sch * 16); p[0] = (u32x2){w.x, w.y}; p[1] = (u32x2){w.z, w.w}; }
        if (kb == kb_lo) {
#pragma unroll
            for (int i = 0; i < 8; ++i) {
                __builtin_amdgcn_global_load_lds((const unsigned*)((const char*)(GVTg + (size_t)(pr * 256 + 32 * i + 4 * wave) * MTOK + tok0) + offGV), (LAS unsigned*)(lds + R_GV + (32 * i + 4 * wave) * 256), 16, 0, 0); } }
        int nunit = unit, npr = pr, nkb = kb + 1, ntok0 = tok0, nkb_lo = kb_lo, nkb_hi = kb_hi;
        if (nkb > kb_hi) { npr = pr + 1; if (npr == 4) { npr = 0; nunit = unit + G; if (nunit < NU) p2_unit_info(nunit, ntok0, nkb_lo, nkb_hi); } nkb = nkb_lo; }
        const bool has_next = nunit < NU;
        if (has_next) P2_PREFETCH(ntok0, npr, nkb);
        P2_BAR();
        {
            const int kt_lo = (kb < 0) ? qt : 0, kt_hi = (kb > 0) ? qt : 3;
            for (int kt = kt_lo; kt <= kt_hi; ++kt) {
                f32x16 s;
#pragma unroll
                for (int i = 0; i < 16; ++i) s[i] = 0.f;
#pragma unroll
                for (int s8 = 0; s8 < 8; ++s8) { const bf16x8 kf = *(const LAS bf16x8*)(lds + R_KT + (32 * kt + c) * KT_PITCH + (16 * s8 + 8 * h) * 2);
                    s = __builtin_amdgcn_mfma_f32_32x32x16_bf16(kf, Qf[s8], s, 0, 0, 0); }
                u32x2 vlo[4], vhi[4];
#pragma unroll
                for (int dt = 0; dt < 2; ++dt)
#pragma unroll
                    for (int s2 = 0; s2 < 2; ++s2) { const LAS unsigned char* vp = lds + R_VT + (32 * dt + c) * VT_PITCH + (32 * kt + 16 * s2 + 4 * h) * 2;
                        vlo[dt * 2 + s2] = *(const LAS u32x2*)vp; vhi[dt * 2 + s2] = *(const LAS u32x2*)(vp + 16); }
                __builtin_amdgcn_sched_barrier(0);
                const LAS float* tbp = tb + hd * TB_N + (kb * 128 + 32 * kt + 4 * h - 32 * qt - c + 160);
                float mx = -3.0e38f;
#pragma unroll
                for (int i = 0; i < 16; ++i) { s[i] += tbp[8 * (i >> 2) + (i & 3)]; mx = fmaxf(mx, s[i]); }
                mx = x32_max(mx);
                const float m_new = fmaxf(m_run, mx), alpha = __builtin_amdgcn_exp2f(m_run - m_new); m_run = m_new;
                float ls = 0.f;
#pragma unroll
                for (int i = 0; i < 16; ++i) { s[i] = __builtin_amdgcn_exp2f(s[i] - m_new); ls += s[i]; }
                l_run = l_run * alpha + ls;
                if (__builtin_amdgcn_ballot_w64(alpha != 1.0f) != 0ull) {
#pragma unroll
                    for (int dt = 0; dt < 4; ++dt)
#pragma unroll
                        for (int i = 0; i < 16; ++i) O[dt][i] *= alpha; }
                bf16x8 Pf[2];
#pragma unroll
                for (int s2 = 0; s2 < 2; ++s2) { u32x4 w; w.x = cvt_pk_bf16(s[8 * s2 + 0], s[8 * s2 + 1]); w.y = cvt_pk_bf16(s[8 * s2 + 2], s[8 * s2 + 3]);
                    w.z = cvt_pk_bf16(s[8 * s2 + 4], s[8 * s2 + 5]); w.w = cvt_pk_bf16(s[8 * s2 + 6], s[8 * s2 + 7]); Pf[s2] = __builtin_bit_cast(bf16x8, w); }
                __builtin_amdgcn_sched_barrier(0);
                u32x2 wlo[4], whi[4];
#pragma unroll
                for (int dt = 2; dt < 4; ++dt)
#pragma unroll
                    for (int s2 = 0; s2 < 2; ++s2) { const LAS unsigned char* vp = lds + R_VT + (32 * dt + c) * VT_PITCH + (32 * kt + 16 * s2 + 4 * h) * 2;
                        wlo[(dt - 2) * 2 + s2] = *(const LAS u32x2*)vp; whi[(dt - 2) * 2 + s2] = *(const LAS u32x2*)(vp + 16); }
#pragma unroll
                for (int dt = 0; dt < 2; ++dt)
#pragma unroll
                    for (int s2 = 0; s2 < 2; ++s2) { const u32x4 w = {vlo[dt * 2 + s2].x, vlo[dt * 2 + s2].y, vhi[dt * 2 + s2].x, vhi[dt * 2 + s2].y};
                        O[dt] = __builtin_amdgcn_mfma_f32_32x32x16_bf16(__builtin_bit_cast(bf16x8, w), Pf[s2], O[dt], 0, 0, 0); }
                __builtin_amdgcn_sched_barrier(0);
#pragma unroll
                for (int dt = 2; dt < 4; ++dt)
#pragma unroll
                    for (int s2 = 0; s2 < 2; ++s2) { const u32x4 w = {wlo[(dt - 2) * 2 + s2].x, wlo[(dt - 2) * 2 + s2].y, whi[(dt - 2) * 2 + s2].x, whi[(dt - 2) * 2 + s2].y};
                        O[dt] = __builtin_amdgcn_mfma_f32_32x32x16_bf16(__builtin_bit_cast(bf16x8, w), Pf[s2], O[dt], 0, 0, 0); }
                __builtin_amdgcn_sched_barrier(0);
            }
        }
        }
        {
            const float inv = __builtin_amdgcn_rcpf(x32_sum(l_run));
            u32x2 t2[4][4];
#pragma unroll
            for (int dt = 0; dt < 4; ++dt)
#pragma unroll
                for (int g4 = 0; g4 < 4; ++g4) { t2[dt][g4].x = cvt_pk_bf16(O[dt][4 * g4] * inv, O[dt][4 * g4 + 1] * inv); t2[dt][g4].y = cvt_pk_bf16(O[dt][4 * g4 + 2] * inv, O[dt][4 * g4 + 3] * inv); }
            bf16x8 Wf[8];
            { const bf16_t* wrow = (const bf16_t*)(a.ws + WS_WSB) + (size_t)(hd * 128 + 32 * qt + c) * 128 + 8 * h;
#pragma unroll
              for (int s8 = 0; s8 < 8; ++s8) { const u32x4 wv = *(const u32x4*)(wrow + 16 * s8);
                  const f32x4 r0 = *(const LAS f32x4*)(rstd_l + 16 * s8 + 8 * h), r1 = *(const LAS f32x4*)(rstd_l + 16 * s8 + 8 * h + 4);
                  u32x4 w; w.x = cvt_pk_bf16(bf_lo(wv.x) * r0[0], bf_hi(wv.x) * r0[1]); w.y = cvt_pk_bf16(bf_lo(wv.y) * r0[2], bf_hi(wv.y) * r0[3]);
                  w.z = cvt_pk_bf16(bf_lo(wv.z) * r1[0], bf_hi(wv.z) * r1[1]); w.w = cvt_pk_bf16(bf_lo(wv.w) * r1[2], bf_hi(wv.w) * r1[3]); Wf[s8] = __builtin_bit_cast(bf16x8, w); } }
            const float bsp = a.in[I_BS][hd * 128 + 32 * qt + c];
            u32x2 t1[4][4];
#pragma unroll
            for (int ct = 0; ct < 4; ++ct) { f32x16 acc;
#pragma unroll
                for (int i = 0; i < 16; ++i) acc[i] = 0.f;
#pragma unroll
                for (int s8 = 0; s8 < 8; ++s8) { const int grow = hsel * 128 + 32 * ct + c; const bf16x8 gf = *(const LAS bf16x8*)(lds + R_GV + grow * 256 + (((2 * s8 + h) ^ (grow & 15)) * 16));
                    acc = __builtin_amdgcn_mfma_f32_32x32x16_bf16(gf, Wf[s8], acc, 0, 0, 0); }
#pragma unroll
                for (int g4 = 0; g4 < 4; ++g4) { const f32x4 gn = *(const f32x4*)(a.in[I_SGUG] + hd * 128 + 32 * ct + 8 * g4 + 4 * h);
                    t1[ct][g4].x = cvt_pk_bf16(acc[4 * g4] * gn[0] + bsp, acc[4 * g4 + 1] * gn[1] + bsp); t1[ct][g4].y = cvt_pk_bf16(acc[4 * g4 + 2] * gn[2] + bsp, acc[4 * g4 + 3] * gn[3] + bsp); } }
            const int tl0 = lane >> 4, ch8 = lane & 15;
            const size_t gu0 = ((size_t)(tok0 + 32 * qt) * DM + hd * 128) * 2;
            __builtin_amdgcn_sched_barrier(0);
            u32x4 cu[4], cb[4];
#pragma unroll
            for (int k = 0; k < 4; ++k) { const size_t go = gu0 + (size_t)(4 * k) * DM * 2; cu[k] = ldg16((const char*)Ug + go, offC); cb[k] = ldg16((const char*)SBg + go, offC); }
            P2_BAR();
            LAS unsigned char* ex = lds + wave * EX_WAVE;
#pragma unroll
            for (int ct = 0; ct < 4; ++ct)
#pragma unroll
                for (int g4 = 0; g4 < 4; ++g4) { const int off = c * KT_PITCH + (32 * ct + 8 * g4 + 4 * h) * 2;
                    *(LAS u32x2*)(ex + off) = t1[ct][g4]; *(LAS u32x2*)(ex + EX_T2 + off) = t2[ct][g4]; }
            asm volatile("s_waitcnt lgkmcnt(0)" ::: "memory");
#pragma unroll
            for (int bt = 0; bt < 2; ++bt) {
                if (bt == 1) {
#pragma unroll
                    for (int k = 0; k < 4; ++k) { const size_t go = gu0 + (size_t)(16 + 4 * k) * DM * 2; cu[k] = ldg16((const char*)Ug + go, offC); cb[k] = ldg16((const char*)SBg + go, offC); } }
#pragma unroll
                for (int k = 0; k < 4; ++k) { const int tl = tl0 + 4 * k + 16 * bt;
                    const u32x4 xu = cu[k], xb = cb[k];
                    const u32x4 a1 = *(const LAS u32x4*)(ex + tl * KT_PITCH + ch8 * 16), a2 = *(const LAS u32x4*)(ex + EX_T2 + tl * KT_PITCH + ch8 * 16);
                    u32x4 o;
#pragma unroll
                    for (int e = 0; e < 4; ++e) {
                        const float lo = bf_lo(xu[e]) * bf_lo(a1[e]) + bf_lo(xb[e]) * bf_lo(a2[e]);
                        const float hi = bf_hi(xu[e]) * bf_hi(a1[e]) + bf_hi(xb[e]) * bf_hi(a2[e]);
                        o[e] = cvt_pk_bf16(lo, hi); }
                    *(u32x4*)((char*)Mout + gu0 + (size_t)(4 * k + 16 * bt) * DM * 2 + offC) = o; }
            }
        }
        }
    }
#undef P2_PREFETCH
    __syncthreads();
}


#define XB_TMO      128
#define XB_XCNT(j)  (256  + 64 * (j))
#define XB_XSUB(j)  (1280 + 64 * (j))
#define XB_XGEN(j)  (2304 + 64 * (j))
#define XB_TOP      3328
#define XB_TOPGEN   3392
#define XCD_BAR_WORDS 3456
#define XB_SPIN_CAP (1u << 22)
__device__ __forceinline__ unsigned xb_ld(unsigned* p)              { return __hip_atomic_load(p, __ATOMIC_RELAXED, __HIP_MEMORY_SCOPE_AGENT); }
__device__ __forceinline__ unsigned xb_add(unsigned* p, unsigned v) { return __hip_atomic_fetch_add(p, v, __ATOMIC_RELAXED, __HIP_MEMORY_SCOPE_AGENT); }
__device__ __forceinline__ unsigned xb_xcc_id() { return (unsigned)__builtin_amdgcn_s_getreg((3 << 11) | 20) & 0xFu; }
#define XB_SPIN(cond, bar) do { unsigned _sp = 0; while (cond) { __builtin_amdgcn_s_sleep(1); \
    if ((++_sp & 255u) == 0u) { if (xb_ld(&(bar)[XB_TMO])) break; if (_sp > XB_SPIN_CAP) { atomicAdd(&(bar)[XB_TMO], 1u); break; } } } } while (0)
struct XcdBarrier { unsigned* bar; unsigned x; volatile LAS unsigned* st; };
__device__ __forceinline__ XcdBarrier xcd_barrier_post(unsigned* bar, volatile LAS unsigned* st) {
    XcdBarrier b; b.bar = bar; b.x = xb_xcc_id(); b.st = st;
    if (threadIdx.x == 0) (void)xb_add(&bar[XB_XCNT(b.x)], 1u);
    return b;
}
__device__ __forceinline__ void xcd_barrier_complete(unsigned* bar, unsigned x, unsigned& nloc, unsigned& nx) {
    const unsigned G = gridDim.x * gridDim.y * gridDim.z;
    unsigned sum, cnt, mine, sp = 0u;
    for (;;) {
        sum = 0u; cnt = 0u; mine = 0u;
#pragma unroll
        for (unsigned j = 0; j < 16; ++j) { const unsigned c = xb_ld(&bar[XB_XCNT(j)]); sum += c; cnt += (c > 0u) ? 1u : 0u; mine = (j == x) ? c : mine; }
        if (sum == G) break;
        __builtin_amdgcn_s_sleep(1);
        if ((++sp & 255u) == 0u) { if (xb_ld(&bar[XB_TMO])) break; if (sp > XB_SPIN_CAP) { atomicAdd(&bar[XB_TMO], 1u); break; } }
    }
    nloc = mine > 0u ? mine : 1u; nx = cnt > 0u ? cnt : 1u;
}
__device__ __forceinline__ void xcd_barrier(const XcdBarrier& b) {
    asm volatile("s_waitcnt vmcnt(0)" ::: "memory");
    __syncthreads();
    if (threadIdx.x == 0) {
        unsigned* bar = b.bar;
        __builtin_amdgcn_s_waitcnt(0);
        unsigned nloc = b.st[0], nx = b.st[1];
        if (nloc == 0u) { xcd_barrier_complete(bar, b.x, nloc, nx); b.st[0] = nloc; b.st[1] = nx; }
        const unsigned old = xb_add(&bar[XB_XSUB(b.x)], 1u);
        const unsigned gen = old / nloc;
        if (old + 1u == (gen + 1u) * nloc) {
            __builtin_amdgcn_fence(__ATOMIC_RELEASE, "agent");
            asm volatile("s_waitcnt vmcnt(0)" ::: "memory");
            const unsigned og = xb_add(&bar[XB_TOP], 1u);
            const unsigned tg = og / nx;
            if (og + 1u == (tg + 1u) * nx) xb_add(&bar[XB_TOPGEN], 1u);
            else XB_SPIN(xb_ld(&bar[XB_TOPGEN]) == tg, bar);
            __builtin_amdgcn_fence(__ATOMIC_ACQUIRE, "agent");
            xb_add(&bar[XB_XGEN(b.x)], 1u);
            asm volatile("s_waitcnt vmcnt(0)" ::: "memory");
        } else {
            XB_SPIN(xb_ld(&bar[XB_XGEN(b.x)]) == gen, bar);
            __builtin_amdgcn_fence(__ATOMIC_ACQUIRE, "agent");
            asm volatile("s_waitcnt vmcnt(0)" ::: "memory");
        }
    }
    __syncthreads();
}
__global__ void __launch_bounds__(512, 2) fwd_megakernel(Args a) {
    extern __shared__ __attribute__((aligned(16))) unsigned char shm[];
    LAS unsigned char* lds = (LAS unsigned char*)shm;
    const int tid = threadIdx.x, lane = tid & 63, wave = __builtin_amdgcn_readfirstlane(tid >> 6);
    const int G = gridDim.x, bx = blockIdx.x;
    const int vcu = (G % 8 == 0) ? (bx % 8) * (G / 8) + bx / 8 : bx;
    const int lo = a.ph_lo, hi = a.ph_hi;
#define IN(k) (lo <= (k) && (k) < hi)
#define SEAM(k) do { if (IN(k) && IN((k) + 1)) { xcd_barrier(gbar); } } while (0)
    volatile LAS unsigned* bst = (volatile LAS unsigned*)(lds + LDS_BYTES - 16);
    if (tid == 0) { bst[0] = 0u; bst[1] = 0u; }
    __syncthreads();
    XcdBarrier gbar; gbar.bar = (unsigned*)(a.ws + WS_BAR); gbar.x = 0; gbar.st = bst;
    if (hi - lo > 1) gbar = xcd_barrier_post((unsigned*)(a.ws + WS_BAR), bst);
    if (hi > 100) cg::this_grid().sync();
    if (IN(0)) for (int rep = (PROBE_DUP == 0 ? 0 : 1); rep < 2; ++rep) { p0_phase(lds, a, vcu, G, wave, lane); __syncthreads(); }
    SEAM(0);
    if (IN(1)) for (int rep = (PROBE_DUP == 1 ? 0 : 1); rep < 2; ++rep) {
        pg8::StaticOrder S; S.init(MTOK, NIN, G, bx);
        P1Ptrs P{(const bf16_t*)((unsigned char*)a.out + DO_H), (const bf16_t*)(a.ws + WS_WT)};
        EpiP1 E{a.ws, (unsigned char*)a.out};
        pg8::gemm_phase(lds, DM, S, P, E);
    }
    SEAM(1);
    if (IN(2)) for (int rep = (PROBE_DUP == 2 ? 0 : 1); rep < 2; ++rep) p2_phase(lds, a, vcu, G, rep == 0 ? (bf16_t*)((unsigned char*)a.out + DO_H) : (bf16_t*)(a.ws + WS_U));
    SEAM(2);
    if (IN(3)) for (int rep = (PROBE_DUP == 3 ? 0 : 1); rep < 2; ++rep) {
        pg8::StaticOrder S; S.init(MTOK, DM, G, bx);
        pg8::PlainPtrs P{(const bf16_t*)(a.ws + WS_U), (const bf16_t*)(a.ws + WS_WOT), DM};
        EpiWo E{a.in[I_XP], a.in[I_XS], (bf16_t*)(a.ws + WS_Q), (float*)(a.ws + WS_PART)};
        pg8::gemm_phase(lds, DM, S, P, E);
    }
    SEAM(3);
    if (IN(4)) for (int rep = (PROBE_DUP == 4 ? 0 : 1); rep < 2; ++rep) {
        pg8::StaticOrder S; S.init(MTOK, DFF, G, bx);
        pg8::PlainPtrs P{(const bf16_t*)(a.ws + WS_Q), (const bf16_t*)(a.ws + WS_W1T), DM};
        EpiFF1 E{(bf16_t*)(a.ws + WS_HID)};
        pg8::gemm_phase(lds, DM, S, P, E);
    }
    SEAM(4);
    if (IN(5)) for (int rep = (PROBE_DUP == 5 ? 0 : 1); rep < 2; ++rep) {
        pg8::StaticOrder S; S.init(MTOK, DM, G, bx);
        pg8::PlainPtrs P{(const bf16_t*)(a.ws + WS_HID), (const bf16_t*)(a.ws + WS_W2T), DFF};
        LAS float* tab = (LAS float*)(lds + R_FF2TAB);
        for (int i = 0; i < 8; ++i) { Unit u; if (!S.next(i, u)) break;
            if (tid < 256) { const f32x4* pp = (const f32x4*)((const float*)(a.ws + WS_PART) + (size_t)(u.pm * 256 + tid) * 16); const f32x4 p0 = pp[0], p1 = pp[1], p2 = pp[2], p3 = pp[3];
                const float ss = ((p0[0] + p0[1]) + (p0[2] + p0[3])) + ((p1[0] + p1[1]) + (p1[2] + p1[3])) + ((p2[0] + p2[1]) + (p2[2] + p2[3])) + ((p3[0] + p3[1]) + (p3[2] + p3[3]));
                tab[i * 256 + tid] = __builtin_amdgcn_rcpf(ss * (1.0f / DM) + EPS); } }
        __syncthreads();
        EpiFF2 E{a.out, (const bf16_t*)(a.ws + WS_Q), tab};
        pg8::gemm_phase(lds, DFF, S, P, E);
    }
#undef IN
#undef SEAM
}

extern "C" void kernel_launch(void* const* d_in, const int* in_sizes, int n_in, void* d_out, int out_size, void* d_ws, size_t ws_size, hipStream_t stream) {
    static int grid = 0;
    if (grid == 0) {
        if (n_in != 15 || out_size != MTOK * DM || ws_size < WS_END) { fprintf(stderr, "kernel_launch: unexpected shapes (n_in %d out %d ws %zu)\n", n_in, out_size, ws_size); grid = -1; return; }
        int dev = 0, cus = 0, per_cu = 0;
        hipGetDevice(&dev); hipDeviceGetAttribute(&cus, hipDeviceAttributeMultiprocessorCount, dev);
        if (hipFuncSetAttribute((const void*)fwd_megakernel, hipFuncAttributeMaxDynamicSharedMemorySize, LDS_BYTES) != hipSuccess) { fprintf(stderr, "kernel_launch: hipFuncSetAttribute failed\n"); grid = -1; return; }
        hipOccupancyMaxActiveBlocksPerMultiprocessor(&per_cu, (const void*)fwd_megakernel, 512, LDS_BYTES);
        if (per_cu < 1) { fprintf(stderr, "kernel_launch: occupancy query says %d blocks/CU\n", per_cu); per_cu = 1; }
        (void)hipGetLastError();
        grid = cus * per_cu;
    }
    if (grid < 0) return;
    Args a{};
    for (int i = 0; i < 15; ++i) a.in[i] = (const float*)d_in[i];
    a.out = (float*)d_out; a.ws = (unsigned char*)d_ws;
    if (N_LAUNCHES == 1) {
        a.ph_lo = 0; a.ph_hi = 6;
        if (hipMemsetAsync((unsigned char*)d_ws + WS_BAR, 0, XCD_BAR_WORDS * 4, stream) != hipSuccess) fprintf(stderr, "kernel_launch: memset of the barrier words failed\n");
        void* args[] = {&a};
        hipError_t e = hipLaunchCooperativeKernel((const void*)fwd_megakernel, dim3(grid), dim3(512), args, LDS_BYTES, stream);
        if (e != hipSuccess) fprintf(stderr, "cooperative launch failed: %s (grid %d)\n", hipGetErrorString(e), grid);
    } else {
        for (int p = 0; p < 6; ++p) { a.ph_lo = p; a.ph_hi = p + 1; hipLaunchKernelGGL(fwd_megakernel, dim3(grid), dim3(512), LDS_BYTES, stream, a); }
    }
}
```

```cpp
#include <hip/hip_runtime.h>
#include <hip/hip_cooperative_groups.h>
#include <cstdio>
namespace cg = cooperative_groups;

#define LAS __attribute__((address_space(3)))
typedef unsigned short bf16_t;
typedef short bf16x8 __attribute__((ext_vector_type(8)));
typedef float f32x4 __attribute__((ext_vector_type(4)));
typedef float f32x16 __attribute__((ext_vector_type(16)));
typedef unsigned u32x4 __attribute__((ext_vector_type(4)));
typedef unsigned u32x2 __attribute__((ext_vector_type(2)));

#ifndef PROBE_DUP
#define PROBE_DUP -1
#endif
#ifndef N_LAUNCHES
#define N_LAUNCHES 1
#endif

constexpr int MP = 8 * 4096, MS = 8 * 8192, MTOK = MP + MS;
constexpr int DM = 1024, NIN = 5632, DFF = 4096;
constexpr float EPS = 1e-6f;
constexpr float LOG2E = 1.4426950408889634f;
constexpr size_t MiB = 1u << 20;
constexpr size_t WS_WT = 0, WS_WOT = 12 * MiB, WS_W1T = 14 * MiB, WS_W2T = 22 * MiB;
constexpr size_t WS_Q = 32 * MiB;
constexpr size_t WS_U = 224 * MiB;
constexpr size_t WS_SA = 416 * MiB, WS_SB = 608 * MiB;
constexpr size_t WS_K = 800 * MiB;
constexpr size_t WS_VT = 848 * MiB;
constexpr size_t WS_HID = 224 * MiB;
constexpr size_t WS_PART = 992 * MiB;
constexpr size_t WS_WSB = 31 * MiB;
constexpr size_t WS_BAR = 1000 * MiB;
constexpr size_t WS_END = 1001 * MiB;
constexpr size_t DO_H = 0, DO_GVT = 192 * MiB;

constexpr int KT_PITCH = 272, VT_PITCH = 264;
constexpr int R_KT = 0, R_VT = 34816, R_GV = 68608;
constexpr int EX_WAVE = 17408, EX_T2 = 8704;
constexpr int R_TB = 139264, TB_N = 320, R_RSTD = R_TB + 8 * TB_N * 4, R_RED = R_RSTD + 512;
constexpr int LDS_BYTES = 155648;
static_assert(R_RED + 4096 <= LDS_BYTES, "lds map");

__device__ __forceinline__ unsigned cvt_pk_bf16(float lo, float hi) { unsigned r; asm volatile("v_cvt_pk_bf16_f32 %0, %1, %2" : "=v"(r) : "v"(lo), "v"(hi)); return r; }
__device__ __forceinline__ float bf_lo(unsigned w) { return __uint_as_float(w << 16); }
__device__ __forceinline__ float bf_hi(unsigned w) { return __uint_as_float(w & 0xffff0000u); }
typedef float f32x2 __attribute__((ext_vector_type(2)));
template <int CTRL> __device__ __forceinline__ float dpp(float x) { return __builtin_bit_cast(float, __builtin_amdgcn_mov_dpp(__builtin_bit_cast(int, x), CTRL, 0xf, 0xf, true)); }
__device__ __forceinline__ float row16_sum(float x) { x += dpp<0xB1>(x); x += dpp<0x4E>(x); x += dpp<0x141>(x); x += dpp<0x128>(x); return x; }
__device__ __forceinline__ float x16_sum(float x) { auto s = __builtin_amdgcn_permlane16_swap(__float_as_uint(x), __float_as_uint(x), false, false); return __uint_as_float(s[0]) + __uint_as_float(s[1]); }
__device__ __forceinline__ float x32_sum(float x) { auto s = __builtin_amdgcn_permlane32_swap(__float_as_uint(x), __float_as_uint(x), false, false); return __uint_as_float(s[0]) + __uint_as_float(s[1]); }
__device__ __forceinline__ float x32_max(float x) { auto s = __builtin_amdgcn_permlane32_swap(__float_as_uint(x), __float_as_uint(x), false, false); return fmaxf(__uint_as_float(s[0]), __uint_as_float(s[1])); }
__device__ __forceinline__ f32x2 gelu2(f32x2 x) { const f32x2 u = x * x, p = u * (0.044715f * -2.302208198f) + (-2.302208198f), t = x * p; f32x2 e; e.x = __builtin_amdgcn_exp2f(t.x); e.y = __builtin_amdgcn_exp2f(t.y);
    const f32x2 d = e + 1.0f; f32x2 r; r.x = __builtin_amdgcn_rcpf(d.x); r.y = __builtin_amdgcn_rcpf(d.y); return x * r; }
__device__ __forceinline__ f32x2 sigmoid2(f32x2 x) { const f32x2 t = x * (-LOG2E); f32x2 e; e.x = __builtin_amdgcn_exp2f(t.x); e.y = __builtin_amdgcn_exp2f(t.y);
    const f32x2 d = e + 1.0f; f32x2 r; r.x = __builtin_amdgcn_rcpf(d.x); r.y = __builtin_amdgcn_rcpf(d.y); return r; }
__device__ __forceinline__ float gelu_tanh(float x) { const float t = x * (1.0f + 0.044715f * x * x) * (-2.302208198f); return x * __builtin_amdgcn_rcpf(1.0f + __builtin_amdgcn_exp2f(t)); }
__device__ __forceinline__ float sigmoidf(float x) { return __builtin_amdgcn_rcpf(1.0f + __builtin_amdgcn_exp2f(-LOG2E * x)); }

namespace pg8 {
constexpr int BM = 256, BK = 64, HALF = 128, HTB = HALF * BK * 2, STAGE_BYTES = 8 * HTB, NXCD = 8, WGM = 8;
__host__ __device__ __forceinline__ int lds_byte(int r, int c) { const int st = (r >> 4) * 2 + (c >> 5), rr = r & 15, cc = c & 31, ob = rr * 64 + cc * 2; return st * 1024 + (ob ^ (((ob >> 9) & 1) << 5)); }
__host__ __device__ __forceinline__ void stage_rc(int b, int& R, int& C) { const int st = b / 1024, sb = b % 1024, swz = sb ^ (((sb >> 9) & 1) << 5); R = (st >> 1) * 16 + swz / 64; C = (st & 1) * 32 + (swz % 64) / 2; }
__host__ __device__ __forceinline__ int perm32(int rho) { const int n = rho >> 4, i = rho & 15; return 8 * (i >> 2) + 4 * n + (i & 3); }
struct Unit { int pm, pn; };
struct StaticOrder {
    int nM, nN, nwg, G, c;
    __device__ void init(int M, int N, int G_, int c_) { nM = M / BM; nN = N / BM; nwg = nM * nN; G = G_; c = c_; }
    __device__ bool next(int i, Unit& u) const {
        const long L = (long)i * G + c; if (L >= nwg) return false;
        int wgid = (int)L; { const int q = nwg / NXCD, r = nwg % NXCD, xcd = wgid % NXCD, off = wgid / NXCD; wgid = (xcd < r ? xcd * (q + 1) : r * (q + 1) + (xcd - r) * q) + off; }
        const int nig = WGM * nN, gid = wgid / nig, fm = gid * WGM, gsz = (nM - fm) < WGM ? (nM - fm) : WGM;
        u.pm = fm + ((wgid % nig) % gsz); u.pn = (wgid % nig) / gsz; return true;
    }
};
struct PlainPtrs { const bf16_t* A; const bf16_t* Bt; int K;
    __device__ __forceinline__ void get(const Unit& u, const char*& a, const char*& b) const { a = (const char*)A + (size_t)u.pm * 512 * K; b = (const char*)Bt + (size_t)u.pn * 512 * K; } };

template <class Epi, class Ptrs>
__device__ __forceinline__ void gemm_phase(LAS unsigned char* lds, const int K, const StaticOrder& S, const Ptrs& P, const Epi& E) {
    const int tid = threadIdx.x, wid = __builtin_amdgcn_readfirstlane(tid >> 6), lane = tid & 63, wr = wid >> 2, wc = wid & 3, fr = lane & 15, fq = lane >> 4;
    const int nt = K / BK;
    unsigned voffA[2], voffB[2];
#pragma unroll
    for (int i = 0; i < 2; ++i) { int R, C; stage_rc(tid * 16 + i * 8192, R, C); const int Rb = (R & ~31) + perm32(R & 31);
        voffA[i] = (unsigned)(R * K + C) * 2u; voffB[i] = (unsigned)(Rb * K + C) * 2u; }
    const size_t kstep = (size_t)(BK * 2);
    const size_t hstep = (size_t)HALF * K * 2;
    const unsigned ldsw = (unsigned)wid * 1024u;
    const int aoff = lds_byte(wr * 64 + fr, fq * 8), boff = lds_byte(wc * 32 + fr, fq * 8);
#define PG8_SA(b, h) (((b) * 2 + (h)) * HTB)
#define PG8_SB(b, h) ((4 + (b) * 2 + (h)) * HTB)
#define PG8_STAGE(bufoff, gbase, voff) do { _Pragma("unroll") for (int _i = 0; _i < 2; ++_i) \
        __builtin_amdgcn_global_load_lds((const unsigned*)((const char*)(gbase) + (voff)[_i]), (LAS unsigned*)(lds + (bufoff) + ldsw + _i * 8192), 16, 0, 0); } while (0)
#define PG8_LDA(dst, b, h) do { _Pragma("unroll") for (int m = 0; m < 4; ++m) _Pragma("unroll") for (int k = 0; k < 2; ++k) dst[m][k] = *(const LAS bf16x8*)(lds + PG8_SA(b, h) + aoff + m * 2048 + k * 1024); } while (0)
#define PG8_LDB(dst, b, h) do { _Pragma("unroll") for (int n = 0; n < 2; ++n) _Pragma("unroll") for (int k = 0; k < 2; ++k) dst[n][k] = *(const LAS bf16x8*)(lds + PG8_SB(b, h) + boff + n * 2048 + k * 1024); } while (0)
#define PG8_MMA(ai, bj, At, Bt) do { __builtin_amdgcn_s_setprio(1); _Pragma("unroll") for (int m = 0; m < 4; ++m) _Pragma("unroll") for (int n = 0; n < 2; ++n) _Pragma("unroll") for (int k = 0; k < 2; ++k) \
        acc[ai][bj][m][n] = __builtin_amdgcn_mfma_f32_16x16x32_bf16(Bt[n][k], At[m][k], acc[ai][bj][m][n], 0, 0, 0); __builtin_amdgcn_s_setprio(0); } while (0)
#define PG8_WAIT_V(n) asm volatile("s_waitcnt vmcnt(" #n ")" ::: "memory")
#define PG8_WAIT_L(n) asm volatile("s_waitcnt lgkmcnt(" #n ")" ::: "memory")
#define PG8_BAR __builtin_amdgcn_s_barrier()
#define PG8_SCHED __builtin_amdgcn_sched_barrier(0)
    Unit cur, nxt; int ui = 0;
    if (!S.next(0, cur)) return;
    f32x4 acc[2][2][4][2];
#pragma unroll
    for (int a = 0; a < 2; ++a)
#pragma unroll
        for (int b = 0; b < 2; ++b)
#pragma unroll
            for (int m = 0; m < 4; ++m)
#pragma unroll
                for (int n = 0; n < 2; ++n) acc[a][b][m][n] = (f32x4){0.f, 0.f, 0.f, 0.f};
    bf16x8 At[4][2], B0[2][2], B1[2][2];
    const char* cA; const char* cB; P.get(cur, cA, cB);
    PG8_STAGE(PG8_SB(0, 0), cB, voffB); PG8_STAGE(PG8_SA(0, 0), cA, voffA); PG8_STAGE(PG8_SB(0, 1), cB + hstep, voffB); PG8_STAGE(PG8_SA(0, 1), cA + hstep, voffA);
    if (wr == 1) PG8_BAR;
    PG8_WAIT_V(4); PG8_BAR;
    PG8_STAGE(PG8_SB(1, 0), cB + kstep, voffB); PG8_STAGE(PG8_SA(1, 0), cA + kstep, voffA); PG8_STAGE(PG8_SB(1, 1), cB + hstep + kstep, voffB);
    PG8_WAIT_V(6); PG8_BAR;
    for (;;) {
        const bool has_next = S.next(ui + 1, nxt);
        const char* nA = cA; const char* nB = cB; if (has_next) P.get(nxt, nA, nB);
        for (int t = 0; t < nt; t += 2) {
            const bool last = (t == nt - 2);
            const char* a1 = cA + (size_t)(t + 1) * kstep;
            const char* a2 = last ? nA : cA + (size_t)(t + 2) * kstep; const char* b2 = last ? nB : cB + (size_t)(t + 2) * kstep;
            const char* a3 = a2 + kstep; const char* b3 = b2 + kstep;
            PG8_LDB(B0, 0, 0); PG8_SCHED; PG8_LDA(At, 0, 0); PG8_STAGE(PG8_SA(1, 1), a1 + hstep, voffA);
            PG8_WAIT_L(8); PG8_BAR; PG8_WAIT_L(0); PG8_MMA(0, 0, At, B0); PG8_BAR; PG8_SCHED;
            PG8_LDB(B1, 0, 1); PG8_STAGE(PG8_SB(0, 0), b2, voffB);
            PG8_BAR; PG8_WAIT_L(0); PG8_MMA(0, 1, At, B1); PG8_BAR;
            PG8_LDA(At, 0, 1); PG8_STAGE(PG8_SA(0, 0), a2, voffA);
            PG8_BAR; PG8_WAIT_L(0); PG8_MMA(1, 0, At, B0); PG8_BAR; PG8_SCHED;
            PG8_STAGE(PG8_SB(0, 1), b2 + hstep, voffB);
            PG8_WAIT_V(6); PG8_BAR; PG8_MMA(1, 1, At, B1); PG8_BAR;
            PG8_LDB(B0, 1, 0); PG8_SCHED; PG8_LDA(At, 1, 0); PG8_STAGE(PG8_SA(0, 1), a2 + hstep, voffA);
            PG8_WAIT_L(8); PG8_BAR; PG8_WAIT_L(0); PG8_MMA(0, 0, At, B0); PG8_BAR; PG8_SCHED;
            PG8_LDB(B1, 1, 1); PG8_STAGE(PG8_SB(1, 0), b3, voffB);
            PG8_BAR; PG8_WAIT_L(0); PG8_MMA(0, 1, At, B1); PG8_BAR;
            PG8_LDA(At, 1, 1); PG8_STAGE(PG8_SA(1, 0), a3, voffA);
            PG8_BAR; PG8_WAIT_L(0); PG8_MMA(1, 0, At, B0); PG8_BAR; PG8_SCHED;
            PG8_STAGE(PG8_SB(1, 1), b3 + hstep, voffB);
            PG8_WAIT_V(6); PG8_BAR; PG8_MMA(1, 1, At, B1); PG8_BAR;
        }
        E(acc, cur, ui, wr, wc, fr, fq);
        if (!has_next) break;
#pragma unroll
        for (int a = 0; a < 2; ++a)
#pragma unroll
            for (int b = 0; b < 2; ++b)
#pragma unroll
                for (int m = 0; m < 4; ++m)
#pragma unroll
                    for (int n = 0; n < 2; ++n) acc[a][b][m][n] = (f32x4){0.f, 0.f, 0.f, 0.f};
        cur = nxt; cA = nA; cB = nB; ++ui;
    }
    PG8_WAIT_V(0);
    if (wr == 0) PG8_BAR;
    PG8_BAR;
#undef PG8_SA
#undef PG8_SB
#undef PG8_STAGE
#undef PG8_LDA
#undef PG8_LDB
#undef PG8_MMA
#undef PG8_WAIT_V
#undef PG8_WAIT_L
#undef PG8_BAR
#undef PG8_SCHED
}
}
using pg8::Unit;

struct Args { const float* in[15]; float* out; unsigned char* ws; int ph_lo, ph_hi; };
enum { I_XP = 0, I_XS, I_RELB, I_N1G, I_WIN, I_SGUG, I_WS, I_BS, I_QG, I_KG, I_SINK, I_WO, I_N2G, I_W1, I_W2 };

struct P1Ptrs { const bf16_t* H; const bf16_t* Wt;
    __device__ __forceinline__ void get(const Unit& u, const char*& a, const char*& b) const {
        const char* hp = (const char*)H + (size_t)u.pm * 512 * DM; const char* wp = (const char*)Wt + (size_t)u.pn * 512 * DM;
        if (u.pn < 17) { a = hp; b = wp; } else { a = wp; b = hp; } } };
__device__ __forceinline__ u32x4 pack8(f32x4 v0, f32x4 v1) { u32x4 w; w.x = cvt_pk_bf16(v0[0], v0[1]); w.y = cvt_pk_bf16(v0[2], v0[3]); w.z = cvt_pk_bf16(v1[0], v1[1]); w.w = cvt_pk_bf16(v1[2], v1[3]); return w; }
__device__ __forceinline__ f32x2 g1_2(f32x2 x, f32x2 g) { const f32x2 u = x * x, p = u * (0.044715f * -2.302208198f) + (-2.302208198f), t = x * p, tg = g * (-LOG2E);
    f32x2 e1, e2; e1.x = __builtin_amdgcn_exp2f(t.x); e1.y = __builtin_amdgcn_exp2f(t.y); e2.x = __builtin_amdgcn_exp2f(tg.x); e2.y = __builtin_amdgcn_exp2f(tg.y);
    const f32x2 d = (e1 + 1.0f) * (e2 + 1.0f); f32x2 r; r.x = __builtin_amdgcn_rcpf(d.x); r.y = __builtin_amdgcn_rcpf(d.y); return x * r; }
__device__ __forceinline__ f32x4 g1_4(f32x4 v, f32x4 g) { const f32x2 a = g1_2((f32x2){v[0], v[1]}, (f32x2){g[0], g[1]}), b = g1_2((f32x2){v[2], v[3]}, (f32x2){g[2], g[3]}); return (f32x4){a.x, a.y, b.x, b.y}; }
__device__ __forceinline__ f32x4 gelu4(f32x4 v) { const f32x2 a = gelu2((f32x2){v[0], v[1]}), b = gelu2((f32x2){v[2], v[3]}); return (f32x4){a.x, a.y, b.x, b.y}; }
__device__ __forceinline__ f32x4 sigmoid4(f32x4 v) { const f32x2 a = sigmoid2((f32x2){v[0], v[1]}), b = sigmoid2((f32x2){v[2], v[3]}); return (f32x4){a.x, a.y, b.x, b.y}; }
struct EpiP1 {
    unsigned char* ws; unsigned char* dout;
    __device__ __forceinline__ void operator()(const f32x4 (&acc)[2][2][4][2], const Unit& u, int ui, int wr, int wc, int fr, int fq) const {
        const int pn = u.pn;
        if (pn < 8) {
            bf16_t* base = (bf16_t*)(ws + WS_U) + (size_t)(u.pm * 256 + wr * 64 + fr) * DM + pn * 128 + wc * 32 + 8 * fq;
#pragma unroll
            for (int ai = 0; ai < 2; ++ai)
#pragma unroll
                for (int m = 0; m < 4; ++m) {
                    const f32x4 g0 = g1_4(acc[ai][0][m][0], acc[ai][1][m][0]), g1 = g1_4(acc[ai][0][m][1], acc[ai][1][m][1]);
                    *(u32x4*)(base + (size_t)(ai * 128 + m * 16) * DM) = pack8(g0, g1); }
            return; }
        if (pn >= 17 && pn < 21) {
            bf16_t* base = (bf16_t*)(dout + DO_GVT) + (size_t)((pn - 17) * 256 + wr * 64 + fr) * MTOK + u.pm * 256 + wc * 32 + 8 * fq;
            float* pp = (float*)(ws + WS_PART) + (size_t)(u.pm * 256 + wc * 32 + 8 * fq) * 8 + (pn - 17) * 2 + wr;
#pragma unroll
            for (int bj = 0; bj < 2; ++bj) { f32x4 sq0 = {0.f, 0.f, 0.f, 0.f}, sq1 = {0.f, 0.f, 0.f, 0.f};
#pragma unroll
                for (int ai = 0; ai < 2; ++ai)
#pragma unroll
                    for (int m = 0; m < 4; ++m) { const f32x4 g0 = gelu4(acc[ai][bj][m][0]), g1 = gelu4(acc[ai][bj][m][1]);
                        sq0 += g0 * g0; sq1 += g1 * g1;
                        *(u32x4*)(base + (size_t)(ai * 128 + m * 16) * MTOK + bj * 128) = pack8(g0, g1); }
#pragma unroll
                for (int j = 0; j < 4; ++j) { const float t0 = row16_sum(sq0[j]), t1 = row16_sum(sq1[j]); if (fr == 0) { pp[(size_t)(bj * 128 + j) * 8] = t0; pp[(size_t)(bj * 128 + 4 + j) * 8] = t1; } } }
            return; }
        bf16_t* base; size_t ld; int row0, col0, act;
        if (pn < 12)      { base = (bf16_t*)(ws + WS_Q);  ld = DM;  row0 = u.pm * 256; col0 = (pn - 8) * 256;  act = 0; }
        else if (pn < 13) { base = (bf16_t*)(ws + WS_K);  ld = 256; row0 = u.pm * 256; col0 = 0;               act = 0; }
        else if (pn < 17) { base = (bf16_t*)(ws + WS_SB); ld = DM;  row0 = u.pm * 256; col0 = (pn - 13) * 256; act = 2; }
        else              { base = (bf16_t*)(ws + WS_VT); ld = MTOK; row0 = 0; col0 = u.pm * 256; act = 0; }
        const int r0 = row0 + wr * 64 + fr, c0 = col0 + wc * 32 + 8 * fq;
#pragma unroll
        for (int ai = 0; ai < 2; ++ai)
#pragma unroll
            for (int m = 0; m < 4; ++m) { bf16_t* rowp = base + (size_t)(r0 + ai * 128 + m * 16) * ld + c0;
#pragma unroll
                for (int bj = 0; bj < 2; ++bj) { f32x4 v0 = acc[ai][bj][m][0], v1 = acc[ai][bj][m][1];
                    if (act == 2) { v0 = sigmoid4(v0); v1 = sigmoid4(v1); }
                    *(u32x4*)(rowp + bj * 128) = pack8(v0, v1); } }
    }
};
struct EpiWo {
    const float* xp; const float* xs; bf16_t* xb; float* part;
    __device__ __forceinline__ void operator()(const f32x4 (&acc)[2][2][4][2], const Unit& u, int ui, int wr, int wc, int fr, int fq) const {
        const int row0 = u.pm * 256 + wr * 64 + fr, col0 = u.pn * 256 + wc * 32 + 8 * fq;
        const float* xb0 = (u.pm * 256 < MP) ? xp : xs - (size_t)MP * DM;
#pragma unroll
        for (int ai = 0; ai < 2; ++ai) {
            f32x4 xv[4][2][2];
#pragma unroll
            for (int m = 0; m < 4; ++m)
#pragma unroll
                for (int bj = 0; bj < 2; ++bj) { const float* p = xb0 + (size_t)(row0 + ai * 128 + m * 16) * DM + col0 + bj * 128; xv[m][bj][0] = *(const f32x4*)p; xv[m][bj][1] = *(const f32x4*)(p + 4); }
#pragma unroll
            for (int m = 0; m < 4; ++m) { const int row = row0 + ai * 128 + m * 16; const size_t off = (size_t)row * DM + col0; float ss = 0.f;
#pragma unroll
                for (int bj = 0; bj < 2; ++bj) {
                    const f32x4 v0 = acc[ai][bj][m][0] + xv[m][bj][0], v1 = acc[ai][bj][m][1] + xv[m][bj][1];
                    u32x4 w; w.x = cvt_pk_bf16(v0[0], v0[1]); w.y = cvt_pk_bf16(v0[2], v0[3]); w.z = cvt_pk_bf16(v1[0], v1[1]); w.w = cvt_pk_bf16(v1[2], v1[3]);
                    *(u32x4*)(xb + off + bj * 128) = w;
                    ss += (v0[0] * v0[0] + v0[1] * v0[1]) + (v0[2] * v0[2] + v0[3] * v0[3]) + (v1[0] * v1[0] + v1[1] * v1[1]) + (v1[2] * v1[2] + v1[3] * v1[3]); }
                ss = x32_sum(x16_sum(ss));
                if (fq == 0) part[(size_t)row * 16 + u.pn * 4 + wc] = ss; }
        }
    }
};
struct EpiFF1 {
    bf16_t* hid;
    __device__ __forceinline__ void operator()(const f32x4 (&acc)[2][2][4][2], const Unit& u, int ui, int wr, int wc, int fr, int fq) const {
        const int row0 = u.pm * 256 + wr * 64 + fr, col0 = u.pn * 256 + wc * 32 + 8 * fq;
#pragma unroll
        for (int ai = 0; ai < 2; ++ai)
#pragma unroll
            for (int m = 0; m < 4; ++m) { bf16_t* rowp = hid + (size_t)(row0 + ai * 128 + m * 16) * DFF + col0;
#pragma unroll
                for (int bj = 0; bj < 2; ++bj) { f32x4 v0 = acc[ai][bj][m][0], v1 = acc[ai][bj][m][1];
#pragma unroll
                    for (int j = 0; j < 4; ++j) { const float a = fmaxf(v0[j], 0.f), b = fmaxf(v1[j], 0.f); v0[j] = a * a; v1[j] = b * b; }
                    u32x4 w; w.x = cvt_pk_bf16(v0[0], v0[1]); w.y = cvt_pk_bf16(v0[2], v0[3]); w.z = cvt_pk_bf16(v1[0], v1[1]); w.w = cvt_pk_bf16(v1[2], v1[3]);
                    *(u32x4*)(rowp + bj * 128) = w; } }
    }
};
constexpr int R_FF2TAB = 131072;
struct EpiFF2 {
    float* out; const bf16_t* xb; const LAS float* tab;
    __device__ __forceinline__ void operator()(const f32x4 (&acc)[2][2][4][2], const Unit& u, int ui, int wr, int wc, int fr, int fq) const {
        const int rl0 = wr * 64 + fr, col0 = u.pn * 256 + wc * 32 + 8 * fq;
        u32x4 xv[2][4][2];
#pragma unroll
        for (int ai = 0; ai < 2; ++ai)
#pragma unroll
            for (int m = 0; m < 4; ++m)
#pragma unroll
                for (int bj = 0; bj < 2; ++bj) xv[ai][m][bj] = *(const u32x4*)(xb + (size_t)(u.pm * 256 + rl0 + ai * 128 + m * 16) * DM + col0 + bj * 128);
#pragma unroll
        for (int ai = 0; ai < 2; ++ai)
#pragma unroll
            for (int m = 0; m < 4; ++m) { const int rl = rl0 + ai * 128 + m * 16; float* rowp = out + (size_t)(u.pm * 256 + rl) * DM + col0;
                const float r2 = tab[ui * 256 + rl];
#pragma unroll
                for (int bj = 0; bj < 2; ++bj) { const u32x4 x = xv[ai][m][bj];
                    const f32x4 x0 = {bf_lo(x.x), bf_hi(x.x), bf_lo(x.y), bf_hi(x.y)}, x1 = {bf_lo(x.z), bf_hi(x.z), bf_lo(x.w), bf_hi(x.w)};
                    *(f32x4*)(rowp + bj * 128) = acc[ai][bj][m][0] * r2 + x0; *(f32x4*)(rowp + bj * 128 + 4) = acc[ai][bj][m][1] * r2 + x1; } }
    }
};

__device__ __forceinline__ void p0_transpose_blk(const float* W, int ldw, const float* kscale, bf16_t* WT, int K, int k0, int n0src, int n0dst, LAS float* scr, int lane) {
    float wv[32];
#pragma unroll
    for (int i = 0; i < 32; ++i) wv[i] = W[(size_t)(k0 + 2 * i + (lane >> 5)) * ldw + n0src + (lane & 31)];
    if (kscale) {
#pragma unroll
        for (int i = 0; i < 32; ++i) wv[i] *= kscale[k0 + 2 * i + (lane >> 5)]; }
#pragma unroll
    for (int i = 0; i < 32; ++i) scr[(2 * i + (lane >> 5)) * 33 + (lane & 31)] = wv[i];
    asm volatile("s_waitcnt lgkmcnt(0)" ::: "memory");
    const int c = lane & 7;
#pragma unroll
    for (int j = 0; j < 4; ++j) { const int n = (lane >> 3) + 8 * j; const LAS float* s = scr + (8 * c) * 33 + n;
        u32x4 o; o.x = cvt_pk_bf16(s[0 * 33], s[1 * 33]); o.y = cvt_pk_bf16(s[2 * 33], s[3 * 33]); o.z = cvt_pk_bf16(s[4 * 33], s[5 * 33]); o.w = cvt_pk_bf16(s[6 * 33], s[7 * 33]);
        *(u32x4*)(WT + (size_t)(n0dst + n) * K + k0 + 8 * c) = o; }
    asm volatile("s_waitcnt lgkmcnt(0)" ::: "memory");
}
__device__ __forceinline__ int win_src_col(int d) {
    if (d < 2048) { const int j = d >> 8, w = d & 255; return w < 128 ? 128 * j + w : 3584 + 128 * j + (w - 128); }
    if (d < 3072) return 2048 + (d - 2048);
    if (d < 3328) return 3072 + (d - 3072);
    if (d < 4352) return 4608 + (d - 3328);
    if (d < 5376) return 1024 + (d - 4352);
    return 3328 + (d - 5376);
}
__device__ __forceinline__ float wave_sum(float v) { return x32_sum(x16_sum(row16_sum(v))); }
__device__ __forceinline__ void p0_phase(LAS unsigned char* lds, const Args& a, int vcu, int G, int wave, int lane) {
    LAS float* scr = (LAS float*)(lds + wave * 16384);
    const int gw = vcu * 8 + wave, NGW = G * 8;
    bf16_t* Wt = (bf16_t*)(a.ws + WS_WT);
    const float* win = a.in[I_WIN];
    constexpr int I_IN = 16 * (NIN / 32), I_O = 16 * 32, I_1 = 16 * (DFF / 32), I_2 = 64 * 32;
    for (int it = gw; it < I_IN + I_O + I_1 + I_2; it += NGW) {
        int r = it;
        if (r < I_IN) { const int kb = r / (NIN / 32), nb = r % (NIN / 32); p0_transpose_blk(win, NIN, nullptr, Wt, DM, 64 * kb, win_src_col(32 * nb), 32 * nb, scr, lane); continue; }
        r -= I_IN;
        if (r < I_O) { const int kb = r / 32, nb = r % 32; p0_transpose_blk(a.in[I_WO], DM, nullptr, (bf16_t*)(a.ws + WS_WOT), DM, 64 * kb, 32 * nb, 32 * nb, scr, lane); continue; } r -= I_O;
        if (r < I_1) { const int kb = r / 128, nb = r % 128; p0_transpose_blk(a.in[I_W1], DFF, a.in[I_N2G], (bf16_t*)(a.ws + WS_W1T), DM, 64 * kb, 32 * nb, 32 * nb, scr, lane); continue; } r -= I_1;
        { const int kb = r / 32, nb = r % 32; p0_transpose_blk(a.in[I_W2], DM, nullptr, (bf16_t*)(a.ws + WS_W2T), DFF, 64 * kb, 32 * nb, 32 * nb, scr, lane); }
    }
    { const int gt = gw * 64 + lane; if (gt < 8 * 128 * 128 / 8) { const f32x4 w0 = ((const f32x4*)a.in[I_WS])[2 * gt], w1 = ((const f32x4*)a.in[I_WS])[2 * gt + 1]; ((u32x4*)(a.ws + WS_WSB))[gt] = pack8(w0, w1); } }
    bf16_t* H = (bf16_t*)((unsigned char*)a.out + DO_H);
    const f32x4* g4 = (const f32x4*)a.in[I_N1G] + lane;
    f32x4 g[4];
#pragma unroll
    for (int j = 0; j < 4; ++j) g[j] = g4[64 * j];
    for (int m = gw; m < MTOK; m += NGW) {
        const float* xrow = (m < MP) ? a.in[I_XP] + (size_t)m * DM : a.in[I_XS] + (size_t)(m - MP) * DM;
        const f32x4* xr = (const f32x4*)xrow + lane;
        f32x4 v[4]; float s = 0.f;
#pragma unroll
        for (int j = 0; j < 4; ++j) { v[j] = xr[64 * j]; s += (v[j].x * v[j].x + v[j].y * v[j].y) + (v[j].z * v[j].z + v[j].w * v[j].w); }
        const float rstd = __builtin_amdgcn_rsqf(wave_sum(s) * (1.f / DM) + EPS);
        u32x2* o8 = (u32x2*)(H + (size_t)m * DM) + lane;
#pragma unroll
        for (int j = 0; j < 4; ++j) { const f32x4 y = v[j] * rstd * g[j]; u32x2 w; w.x = cvt_pk_bf16(y.x, y.y); w.y = cvt_pk_bf16(y.z, y.w); o8[64 * j] = w; }
    }
}

__device__ __forceinline__ int t5_bucket(int rel) {
    const int n = rel < 0 ? -rel : rel; int b = rel > 0 ? 16 : 0;
    if (n < 8) return b + n;
    int k = (n >= 12) + (n >= 16) + (n >= 23) + (n >= 32) + (n >= 46) + (n >= 64) + (n >= 91);
    return b + 8 + k;
}
__device__ __forceinline__ u32x4 ldg16(const void* ubase, unsigned voff) { return *(const u32x4*)((const char*)ubase + voff); }
__device__ __forceinline__ void p2_unit_info(int unit, int& tok0, int& kb_lo, int& kb_hi) {
    tok0 = unit * 128; int n, nblk; if (unit < MP / 128) { n = unit & 31; nblk = 32; } else { n = (unit - MP / 128) & 63; nblk = 64; }
    kb_lo = (n > 0) ? -1 : 0; kb_hi = (n < nblk - 1) ? 1 : 0;
}
#define P2_BAR() do { asm volatile("s_waitcnt lgkmcnt(0)" ::: "memory"); __builtin_amdgcn_s_barrier(); asm volatile("" ::: "memory"); } while (0)
__device__ __forceinline__ void p2_phase(LAS unsigned char* lds, const Args& a, int vcu, int G, bf16_t* Mout) {
    const int tid = threadIdx.x, wave = __builtin_amdgcn_readfirstlane(tid >> 6), lane = tid & 63, c = lane & 31, h = lane >> 5;
    const int hsel = wave >> 2, qt = hsel ? 3 - (wave & 3) : (wave & 3);
    const bf16_t* Qg = (const bf16_t*)(a.ws + WS_Q); const bf16_t* Kg = (const bf16_t*)(a.ws + WS_K); const bf16_t* VTg = (const bf16_t*)(a.ws + WS_VT);
    const bf16_t* GVTg = (const bf16_t*)((unsigned char*)a.out + DO_GVT);
    const bf16_t* Ug = (const bf16_t*)(a.ws + WS_U); const bf16_t* SBg = (const bf16_t*)(a.ws + WS_SB);
    LAS float* tb = (LAS float*)(lds + R_TB); LAS float* rstd_l = (LAS float*)(lds + R_RSTD); LAS float* red = (LAS float*)(lds + R_RED);
    constexpr int NU = MTOK / 128;
    for (int i = tid; i < 8 * TB_N; i += 512) { const int hd = i / TB_N, rel = (i % TB_N) - 160; const int ar = rel < 0 ? -rel : rel;
        tb[i] = (ar <= 128) ? a.in[I_RELB][t5_bucket(rel) * 8 + hd] * LOG2E : -1e30f; }
    if (vcu >= NU) { P2_BAR(); return; }
    const int srow = tid >> 4, sch = tid & 15;
    const f32x4 kg0 = *(const f32x4*)(a.in[I_KG] + sch * 8), kg1 = *(const f32x4*)(a.in[I_KG] + sch * 8 + 4);
    u32x4 Kraw[4], Vraw[4];
    const unsigned offK = (unsigned)(srow * 256 + sch * 8) * 2u, offV = (unsigned)(srow * MTOK + sch * 8) * 2u;
    const unsigned offGV = (unsigned)((lane >> 4) * MTOK + (((lane & 15) ^ ((4 * wave + (lane >> 4)) & 15)) * 8)) * 2u;
    const unsigned offQ = (unsigned)(c * DM + 8 * h) * 2u, offP0 = (unsigned)((tid >> 4) * MTOK + 8 * (tid & 15)) * 2u, offC = (unsigned)((lane >> 4) * DM + (lane & 15) * 8) * 2u;
#define P2_PREFETCH(u_tok0, u_pr, u_kb) do { const int _kt0 = (u_tok0) + (u_kb) * 128, _kvh = (u_pr) >> 1; \
        const char* _kb0 = (const char*)(Kg + (size_t)_kt0 * 256 + _kvh * 128); const char* _vb0 = (const char*)(VTg + (size_t)(_kvh * 128) * MTOK + _kt0); \
        _Pragma("unroll") for (int i = 0; i < 4; ++i) Kraw[i] = ldg16(_kb0 + (size_t)i * (32 * 256 * 2), offK); \
        _Pragma("unroll") for (int i = 0; i < 4; ++i) Vraw[i] = ldg16(_vb0 + (size_t)i * ((size_t)32 * MTOK * 2), offV); } while (0)
    { int t0_, lo_, hi_; p2_unit_info(vcu, t0_, lo_, hi_); P2_PREFETCH(t0_, 0, lo_); }
    for (int unit = vcu; unit < NU; unit += G) {
        int tok0, kb_lo, kb_hi; p2_unit_info(unit, tok0, kb_lo, kb_hi);
        {
            P2_BAR();
            if (tid < 128) { const f32x4* pp = (const f32x4*)((const float*)(a.ws + WS_PART) + (size_t)(tok0 + tid) * 8); const f32x4 p0 = pp[0], p1 = pp[1];
                rstd_l[tid] = __builtin_amdgcn_rsqf((((p0[0] + p0[1]) + (p0[2] + p0[3])) + ((p1[0] + p1[1]) + (p1[2] + p1[3]))) * (1.0f / 1024.0f) + EPS); }
        }
        for (int pr = 0; pr < 4; ++pr) {
        const int hd = 2 * pr + hsel;
        bf16x8 Qf[8]; f32x16 O[4]; float m_run, l_run;
        {
            const char* qb = (const char*)(Qg + (size_t)(tok0 + 32 * qt) * DM + hd * 128); u32x4 raw[8]; float ss = 0.f;
#pragma unroll
            for (int s = 0; s < 8; ++s) raw[s] = ldg16(qb + 32 * s, offQ);
#pragma unroll
            for (int s = 0; s < 8; ++s)
#pragma unroll
                for (int e = 0; e < 4; ++e) { const float lo = bf_lo(raw[s][e]), hi = bf_hi(raw[s][e]); ss += lo * lo + hi * hi; }
            ss = x32_sum(ss);
            const float sc = __builtin_amdgcn_rsqf(ss * (1.0f / 128.0f) + EPS) * (0.08838834764831845f * LOG2E);
            const float* qg = a.in[I_QG] + 8 * h;
#pragma unroll
            for (int s = 0; s < 8; ++s) { const f32x4 g0 = *(const f32x4*)(qg + 16 * s), g1 = *(const f32x4*)(qg + 16 * s + 4); u32x4 w;
                w.x = cvt_pk_bf16(bf_lo(raw[s][0]) * sc * g0[0], bf_hi(raw[s][0]) * sc * g0[1]); w.y = cvt_pk_bf16(bf_lo(raw[s][1]) * sc * g0[2], bf_hi(raw[s][1]) * sc * g0[3]);
                w.z = cvt_pk_bf16(bf_lo(raw[s][2]) * sc * g1[0], bf_hi(raw[s][2]) * sc * g1[1]); w.w = cvt_pk_bf16(bf_lo(raw[s][3]) * sc * g1[2], bf_hi(raw[s][3]) * sc * g1[3]);
                Qf[s] = __builtin_bit_cast(bf16x8, w); }
            m_run = a.in[I_SINK][hd] * LOG2E; l_run = (h == 0) ? 1.0f : 0.0f;
#pragma unroll
            for (int dt = 0; dt < 4; ++dt)
#pragma unroll
                for (int i = 0; i < 16; ++i) O[dt][i] = 0.f;
        }
        for (int kb = kb_lo; kb <= kb_hi; ++kb) {
        if (kb == kb_lo + 1) asm volatile("s_waitcnt vmcnt(0)" ::: "memory");
        P2_BAR();
#pragma unroll
        for (int i = 0; i < 4; ++i) { const u32x4 w = Kraw[i]; float v[8]; float ss = 0.f;
#pragma unroll
            for (int e = 0; e < 4; ++e) { v[2 * e] = bf_lo(w[e]); v[2 * e + 1] = bf_hi(w[e]); ss += v[2 * e] * v[2 * e] + v[2 * e + 1] * v[2 * e + 1]; }
            ss = row16_sum(ss);
            const float sc = __builtin_amdgcn_rsqf(ss * (1.0f / 128.0f) + EPS);
            u32x4 o; o.x = cvt_pk_bf16(v[0] * sc * kg0[0], v[1] * sc * kg0[1]); o.y = cvt_pk_bf16(v[2] * sc * kg0[2], v[3] * sc * kg0[3]);
            o.z = cvt_pk_bf16(v[4] * sc * kg1[0], v[5] * sc * kg1[1]); o.w = cvt_pk_bf16(v[6] * sc * kg1[2], v[7] * sc * kg1[3]);
            *(LAS u32x4*)(lds + R_KT + (srow + 32 * i) * KT_PITCH + sch * 16) = o; }
#pragma unroll
        for (int i = 0; i < 4; ++i) { const u32x4 w = Vraw[i]; LAS u32x2* p = (LAS u32x2*)(lds + R_VT + (srow + 32 * i) * VT_PITCH + sch * 16); p[0] = (u32x2){w.x, w.y}; p[1] = (u32x2){w.z, w.w}; }
        if (kb == kb_lo) {
#pragma unroll
            for (int i = 0; i < 8; ++i) {
                __builtin_amdgcn_global_load_lds((const unsigned*)((const char*)(GVTg + (size_t)(pr * 256 + 32 * i + 4 * wave) * MTOK + tok0) + offGV), (LAS unsigned*)(lds + R_GV + (32 * i + 4 * wave) * 256), 16, 0, 0); } }
        int nunit = unit, npr = pr, nkb = kb + 1, ntok0 = tok0, nkb_lo = kb_lo, nkb_hi = kb_hi;
        if (nkb > kb_hi) { npr = pr + 1; if (npr == 4) { npr = 0; nunit = unit + G; if (nunit < NU) p2_unit_info(nunit, ntok0, nkb_lo, nkb_hi); } nkb = nkb_lo; }
        const bool has_next = nunit < NU;
        if (has_next) P2_PREFETCH(ntok0, npr, nkb);
        P2_BAR();
        {
            const int kt_lo = (kb < 0) ? qt : 0, kt_hi = (kb > 0) ? qt : 3;
            for (int kt = kt_lo; kt <= kt_hi; ++kt) {
                f32x16 s;
#pragma unroll
                for (int i = 0; i < 16; ++i) s[i] = 0.f;
#pragma unroll
                for (int s8 = 0; s8 < 8; ++s8) { const bf16x8 kf = *(const LAS bf16x8*)(lds + R_KT + (32 * kt + c) * KT_PITCH + (16 * s8 + 8 * h) * 2);
                    s = __builtin_amdgcn_mfma_f32_32x32x16_bf16(kf, Qf[s8], s, 0, 0, 0); }
                u32x2 vlo[4], vhi[4];
#pragma unroll
                for (int dt = 0; dt < 2; ++dt)
#pragma unroll
                    for (int s2 = 0; s2 < 2; ++s2) { const LAS unsigned char* vp = lds + R_VT + (32 * dt + c) * VT_PITCH + (32 * kt + 16 * s2 + 4 * h) * 2;
                        vlo[dt * 2 + s2] = *(const LAS u32x2*)vp; vhi[dt * 2 + s2] = *(const LAS u32x2*)(vp + 16); }
                __builtin_amdgcn_sched_barrier(0);
                const LAS float* tbp = tb + hd * TB_N + (kb * 128 + 32 * kt + 4 * h - 32 * qt - c + 160);
                float mx = -3.0e38f;
#pragma unroll
                for (int i = 0; i < 16; ++i) { s[i] += tbp[8 * (i >> 2) + (i & 3)]; mx = fmaxf(mx, s[i]); }
                mx = x32_max(mx);
                const float m_new = fmaxf(m_run, mx), alpha = __builtin_amdgcn_exp2f(m_run - m_new); m_run = m_new;
                float ls = 0.f;
#pragma unroll
                for (int i = 0; i < 16; ++i) { s[i] = __builtin_amdgcn_exp2f(s[i] - m_new); ls += s[i]; }
                l_run = l_run * alpha + ls;
                if (__builtin_amdgcn_ballot_w64(alpha != 1.0f) != 0ull) {
#pragma unroll
                    for (int dt = 0; dt < 4; ++dt)
#pragma unroll
                        for (int i = 0; i < 16; ++i) O[dt][i] *= alpha; }
                bf16x8 Pf[2];
#pragma unroll
                for (int s2 = 0; s2 < 2; ++s2) { u32x4 w; w.x = cvt_pk_bf16(s[8 * s2 + 0], s[8 * s2 + 1]); w.y = cvt_pk_bf16(s[8 * s2 + 2], s[8 * s2 + 3]);
                    w.z = cvt_pk_bf16(s[8 * s2 + 4], s[8 * s2 + 5]); w.w = cvt_pk_bf16(s[8 * s2 + 6], s[8 * s2 + 7]); Pf[s2] = __builtin_bit_cast(bf16x8, w); }
                __builtin_amdgcn_sched_barrier(0);
                u32x2 wlo[4], whi[4];
#pragma unroll
                for (int dt = 2; dt < 4; ++dt)
#pragma unroll
                    for (int s2 = 0; s2 < 2; ++s2) { const LAS unsigned char* vp = lds + R_VT + (32 * dt + c) * VT_PITCH + (32 * kt + 16 * s2 + 4 * h) * 2;
                        wlo[(dt - 2) * 2 + s2] = *(const LAS u32x2*)vp; whi[(dt - 2) * 2 + s2] = *(const LAS u32x2*)(vp + 16); }
#pragma unroll
                for (int dt = 0; dt < 2; ++dt)
#pragma unroll
                    for (int s2 = 0; s2 < 2; ++s2) { const u32x4 w = {vlo[dt * 2 + s2].x, vlo[dt * 2 + s2].y, vhi[dt * 2 + s2].x, vhi[dt * 2 + s2].y};
                        O[dt] = __builtin_amdgcn_mfma_f32_32x32x16_bf16(__builtin_bit_cast(bf16x8, w), Pf[s2], O[dt], 0, 0, 0); }
                __builtin_amdgcn_sched_barrier(0);
#pragma unroll
                for (int dt = 2; dt < 4; ++dt)
#pragma unroll
                    for (int s2 = 0; s2 < 2; ++s2) { const u32x4 w = {wlo[(dt - 2) * 2 + s2].x, wlo[(dt - 2) * 2 + s2].y, whi[(dt - 2) * 2 + s2].x, whi[(dt - 2) * 2 + s2].y};
                        O[dt] = __builtin_amdgcn_mfma_f32_32x32x16_bf16(__builtin_bit_cast(bf16x8, w), Pf[s2], O[dt], 0, 0, 0); }
                __builtin_amdgcn_sched_barrier(0);
            }
        }
        }
        {
            const float inv = __builtin_amdgcn_rcpf(x32_sum(l_run));
            u32x2 t2[4][4];
#pragma unroll
            for (int dt = 0; dt < 4; ++dt)
#pragma unroll
                for (int g4 = 0; g4 < 4; ++g4) { t2[dt][g4].x = cvt_pk_bf16(O[dt][4 * g4] * inv, O[dt][4 * g4 + 1] * inv); t2[dt][g4].y = cvt_pk_bf16(O[dt][4 * g4 + 2] * inv, O[dt][4 * g4 + 3] * inv); }
            bf16x8 Wf[8];
            { const bf16_t* wrow = (const bf16_t*)(a.ws + WS_WSB) + (size_t)(hd * 128 + 32 * qt + c) * 128 + 8 * h;
#pragma unroll
              for (int s8 = 0; s8 < 8; ++s8) { const u32x4 wv = *(const u32x4*)(wrow + 16 * s8);
                  const f32x4 r0 = *(const LAS f32x4*)(rstd_l + 16 * s8 + 8 * h), r1 = *(const LAS f32x4*)(rstd_l + 16 * s8 + 8 * h + 4);
                  u32x4 w; w.x = cvt_pk_bf16(bf_lo(wv.x) * r0[0], bf_hi(wv.x) * r0[1]); w.y = cvt_pk_bf16(bf_lo(wv.y) * r0[2], bf_hi(wv.y) * r0[3]);
                  w.z = cvt_pk_bf16(bf_lo(wv.z) * r1[0], bf_hi(wv.z) * r1[1]); w.w = cvt_pk_bf16(bf_lo(wv.w) * r1[2], bf_hi(wv.w) * r1[3]); Wf[s8] = __builtin_bit_cast(bf16x8, w); } }
            const float bsp = a.in[I_BS][hd * 128 + 32 * qt + c];
            u32x2 t1[4][4];
#pragma unroll
            for (int ct = 0; ct < 4; ++ct) { f32x16 acc;
#pragma unroll
                for (int i = 0; i < 16; ++i) acc[i] = 0.f;
#pragma unroll
                for (int s8 = 0; s8 < 8; ++s8) { const int grow = hsel * 128 + 32 * ct + c; const bf16x8 gf = *(const LAS bf16x8*)(lds + R_GV + grow * 256 + (((2 * s8 + h) ^ (grow & 15)) * 16));
                    acc = __builtin_amdgcn_mfma_f32_32x32x16_bf16(gf, Wf[s8], acc, 0, 0, 0); }
#pragma unroll
                for (int g4 = 0; g4 < 4; ++g4) { const f32x4 gn = *(const f32x4*)(a.in[I_SGUG] + hd * 128 + 32 * ct + 8 * g4 + 4 * h);
                    t1[ct][g4].x = cvt_pk_bf16(acc[4 * g4] * gn[0] + bsp, acc[4 * g4 + 1] * gn[1] + bsp); t1[ct][g4].y = cvt_pk_bf16(acc[4 * g4 + 2] * gn[2] + bsp, acc[4 * g4 + 3] * gn[3] + bsp); } }
            const int tl0 = lane >> 4, ch8 = lane & 15;
            const size_t gu0 = ((size_t)(tok0 + 32 * qt) * DM + hd * 128) * 2;
            __builtin_amdgcn_sched_barrier(0);
            u32x4 cu[4], cb[4];
#pragma unroll
            for (int k = 0; k < 4; ++k) { const size_t go = gu0 + (size_t)(4 * k) * DM * 2; cu[k] = ldg16((const char*)Ug + go, offC); cb[k] = ldg16((const char*)SBg + go, offC); }
            P2_BAR();
            LAS unsigned char* ex = lds + wave * EX_WAVE;
#pragma unroll
            for (int ct = 0; ct < 4; ++ct)
#pragma unroll
                for (int g4 = 0; g4 < 4; ++g4) { const int off = c * KT_PITCH + (32 * ct + 8 * g4 + 4 * h) * 2;
                    *(LAS u32x2*)(ex + off) = t1[ct][g4]; *(LAS u32x2*)(ex + EX_T2 + off) = t2[ct][g4]; }
            asm volatile("s_waitcnt lgkmcnt(0)" ::: "memory");
#pragma unroll
            for (int bt = 0; bt < 2; ++bt) {
                if (bt == 1) {
#pragma unroll
                    for (int k = 0; k < 4; ++k) { const size_t go = gu0 + (size_t)(16 + 4 * k) * DM * 2; cu[k] = ldg16((const char*)Ug + go, offC); cb[k] = ldg16((const char*)SBg + go, offC); } }
#pragma unroll
                for (int k = 0; k < 4; ++k) { const int tl = tl0 + 4 * k + 16 * bt;
                    const u32x4 xu = cu[k], xb = cb[k];
                    const u32x4 a1 = *(const LAS u32x4*)(ex + tl * KT_PITCH + ch8 * 16), a2 = *(const LAS u32x4*)(ex + EX_T2 + tl * KT_PITCH + ch8 * 16);
                    u32x4 o;
#pragma unroll
                    for (int e = 0; e < 4; ++e) {
                        const float lo = bf_lo(xu[e]) * bf_lo(a1[e]) + bf_lo(xb[e]) * bf_lo(a2[e]);
                        const float hi = bf_hi(xu[e]) * bf_hi(a1[e]) + bf_hi(xb[e]) * bf_hi(a2[e]);
                        o[e] = cvt_pk_bf16(lo, hi); }
                    *(u32x4*)((char*)Mout + gu0 + (size_t)(4 * k + 16 * bt) * DM * 2 + offC) = o; }
            }
        }
        }
    }
#undef P2_PREFETCH
    __syncthreads();
}


#define XB_TMO      128
#define XB_XCNT(j)  (256  + 64 * (j))
#define XB_XSUB(j)  (1280 + 64 * (j))
#define XB_XGEN(j)  (2304 + 64 * (j))
#define XB_TOP      3328
#define XB_TOPGEN   3392
#define XCD_BAR_WORDS 3456
#define XB_SPIN_CAP (1u << 22)
__device__ __forceinline__ unsigned xb_ld(unsigned* p)              { return __hip_atomic_load(p, __ATOMIC_RELAXED, __HIP_MEMORY_SCOPE_AGENT); }
__device__ __forceinline__ unsigned xb_add(unsigned* p, unsigned v) { return __hip_atomic_fetch_add(p, v, __ATOMIC_RELAXED, __HIP_MEMORY_SCOPE_AGENT); }
__device__ __forceinline__ unsigned xb_xcc_id() { return (unsigned)__builtin_amdgcn_s_getreg((3 << 11) | 20) & 0xFu; }
#define XB_SPIN(cond, bar) do { unsigned _sp = 0; while (cond) { __builtin_amdgcn_s_sleep(1); \
    if ((++_sp & 255u) == 0u) { if (xb_ld(&(bar)[XB_TMO])) break; if (_sp > XB_SPIN_CAP) { atomicAdd(&(bar)[XB_TMO], 1u); break; } } } } while (0)
struct XcdBarrier { unsigned* bar; unsigned x; volatile LAS unsigned* st; };
__device__ __forceinline__ XcdBarrier xcd_barrier_post(unsigned* bar, volatile LAS unsigned* st) {
    XcdBarrier b; b.bar = bar; b.x = xb_xcc_id(); b.st = st;
    if (threadIdx.x == 0) (void)xb_add(&bar[XB_XCNT(b.x)], 1u);
    return b;
}
__device__ __forceinline__ void xcd_barrier_complete(unsigned* bar, unsigned x, unsigned& nloc, unsigned& nx) {
    const unsigned G = gridDim.x * gridDim.y * gridDim.z;
    unsigned sum, cnt, mine, sp = 0u;
    for (;;) {
        sum = 0u; cnt = 0u; mine = 0u;
#pragma unroll
        for (unsigned j = 0; j < 16; ++j) { const unsigned c = xb_ld(&bar[XB_XCNT(j)]); sum += c; cnt += (c > 0u) ? 1u : 0u; mine = (j == x) ? c : mine; }
        if (sum == G) break;
        __builtin_amdgcn_s_sleep(1);
        if ((++sp & 255u) == 0u) { if (xb_ld(&bar[XB_TMO])) break; if (sp > XB_SPIN_CAP) { atomicAdd(&bar[XB_TMO], 1u); break; } }
    }
    nloc = mine > 0u ? mine : 1u; nx = cnt > 0u ? cnt : 1u;
}
__device__ __forceinline__ void xcd_barrier(const XcdBarrier& b) {
    asm volatile("s_waitcnt vmcnt(0)" ::: "memory");
    __syncthreads();
    if (threadIdx.x == 0) {
        unsigned* bar = b.bar;
        __builtin_amdgcn_s_waitcnt(0);
        unsigned nloc = b.st[0], nx = b.st[1];
        if (nloc == 0u) { xcd_barrier_complete(bar, b.x, nloc, nx); b.st[0] = nloc; b.st[1] = nx; }
        const unsigned old = xb_add(&bar[XB_XSUB(b.x)], 1u);
        const unsigned gen = old / nloc;
        if (old + 1u == (gen + 1u) * nloc) {
            __builtin_amdgcn_fence(__ATOMIC_RELEASE, "agent");
            asm volatile("s_waitcnt vmcnt(0)" ::: "memory");
            const unsigned og = xb_add(&bar[XB_TOP], 1u);
            const unsigned tg = og / nx;
            if (og + 1u == (tg + 1u) * nx) xb_add(&bar[XB_TOPGEN], 1u);
            else XB_SPIN(xb_ld(&bar[XB_TOPGEN]) == tg, bar);
            __builtin_amdgcn_fence(__ATOMIC_ACQUIRE, "agent");
            xb_add(&bar[XB_XGEN(b.x)], 1u);
            asm volatile("s_waitcnt vmcnt(0)" ::: "memory");
        } else {
            XB_SPIN(xb_ld(&bar[XB_XGEN(b.x)]) == gen, bar);
            __builtin_amdgcn_fence(__ATOMIC_ACQUIRE, "agent");
            asm volatile("s_waitcnt vmcnt(0)" ::: "memory");
        }
    }
    __syncthreads();
}
__global__ void __launch_bounds__(512, 2) fwd_megakernel(Args a) {
    extern __shared__ __attribute__((aligned(16))) unsigned char shm[];
    LAS unsigned char* lds = (LAS unsigned char*)shm;
    const int tid = threadIdx.x, lane = tid & 63, wave = __builtin_amdgcn_readfirstlane(tid >> 6);
    const int G = gridDim.x, bx = blockIdx.x;
    const int vcu = (G % 8 == 0) ? (bx % 8) * (G / 8) + bx / 8 : bx;
    const int lo = a.ph_lo, hi = a.ph_hi;
#define IN(k) (lo <= (k) && (k) < hi)
#define SEAM(k) do { if (IN(k) && IN((k) + 1)) { xcd_barrier(gbar); } } while (0)
    volatile LAS unsigned* bst = (volatile LAS unsigned*)(lds + LDS_BYTES - 16);
    if (tid == 0) { bst[0] = 0u; bst[1] = 0u; }
    __syncthreads();
    XcdBarrier gbar; gbar.bar = (unsigned*)(a.ws + WS_BAR); gbar.x = 0; gbar.st = bst;
    if (hi - lo > 1) gbar = xcd_barrier_post((unsigned*)(a.ws + WS_BAR), bst);
    if (hi > 100) cg::this_grid().sync();
    if (IN(0)) for (int rep = (PROBE_DUP == 0 ? 0 : 1); rep < 2; ++rep) { p0_phase(lds, a, vcu, G, wave, lane); __syncthreads(); }
    SEAM(0);
    if (IN(1)) for (int rep = (PROBE_DUP == 1 ? 0 : 1); rep < 2; ++rep) {
        pg8::StaticOrder S; S.init(MTOK, NIN, G, bx);
        P1Ptrs P{(const bf16_t*)((unsigned char*)a.out + DO_H), (const bf16_t*)(a.ws + WS_WT)};
        EpiP1 E{a.ws, (unsigned char*)a.out};
        pg8::gemm_phase(lds, DM, S, P, E);
    }
    SEAM(1);
    if (IN(2)) for (int rep = (PROBE_DUP == 2 ? 0 : 1); rep < 2; ++rep) p2_phase(lds, a, vcu, G, rep == 0 ? (bf16_t*)((unsigned char*)a.out + DO_H) : (bf16_t*)(a.ws + WS_U));
    SEAM(2);
    if (IN(3)) for (int rep = (PROBE_DUP == 3 ? 0 : 1); rep < 2; ++rep) {
        pg8::StaticOrder S; S.init(MTOK, DM, G, bx);
        pg8::PlainPtrs P{(const bf16_t*)(a.ws + WS_U), (const bf16_t*)(a.ws + WS_WOT), DM};
        EpiWo E{a.in[I_XP], a.in[I_XS], (bf16_t*)(a.ws + WS_Q), (float*)(a.ws + WS_PART)};
        pg8::gemm_phase(lds, DM, S, P, E);
    }
    SEAM(3);
    if (IN(4)) for (int rep = (PROBE_DUP == 4 ? 0 : 1); rep < 2; ++rep) {
        pg8::StaticOrder S; S.init(MTOK, DFF, G, bx);
        pg8::PlainPtrs P{(const bf16_t*)(a.ws + WS_Q), (const bf16_t*)(a.ws + WS_W1T), DM};
        EpiFF1 E{(bf16_t*)(a.ws + WS_HID)};
        pg8::gemm_phase(lds, DM, S, P, E);
    }
    SEAM(4);
    if (IN(5)) for (int rep = (PROBE_DUP == 5 ? 0 : 1); rep < 2; ++rep) {
        pg8::StaticOrder S; S.init(MTOK, DM, G, bx);
        pg8::PlainPtrs P{(const bf16_t*)(a.ws + WS_HID), (const bf16_t*)(a.ws + WS_W2T), DFF};
        LAS float* tab = (LAS float*)(lds + R_FF2TAB);
        for (int i = 0; i < 8; ++i) { Unit u; if (!S.next(i, u)) break;
            if (tid < 256) { const f32x4* pp = (const f32x4*)((const float*)(a.ws + WS_PART) + (size_t)(u.pm * 256 + tid) * 16); const f32x4 p0 = pp[0], p1 = pp[1], p2 = pp[2], p3 = pp[3];
                const float ss = ((p0[0] + p0[1]) + (p0[2] + p0[3])) + ((p1[0] + p1[1]) + (p1[2] + p1[3])) + ((p2[0] + p2[1]) + (p2[2] + p2[3])) + ((p3[0] + p3[1]) + (p3[2] + p3[3]));
                tab[i * 256 + tid] = __builtin_amdgcn_rcpf(ss * (1.0f / DM) + EPS); } }
        __syncthreads();
        EpiFF2 E{a.out, (const bf16_t*)(a.ws + WS_Q), tab};
        pg8::gemm_phase(lds, DFF, S, P, E);
    }
#undef IN
#undef SEAM
}

extern "C" void kernel_launch(void* const* d_in, const int* in_sizes, int n_in, void* d_out, int out_size, void* d_ws, size_t ws_size, hipStream_t stream) {
    static int grid = 0;
    if (grid == 0) {
        if (n_in != 15 || out_size != MTOK * DM || ws_size < WS_END) { fprintf(stderr, "kernel_launch: unexpected shapes (n_in %d out %d ws %zu)\n", n_in, out_size, ws_size); grid = -1; return; }
        int dev = 0, cus = 0, per_cu = 0;
        hipGetDevice(&dev); hipDeviceGetAttribute(&cus, hipDeviceAttributeMultiprocessorCount, dev);
        if (hipFuncSetAttribute((const void*)fwd_megakernel, hipFuncAttributeMaxDynamicSharedMemorySize, LDS_BYTES) != hipSuccess) { fprintf(stderr, "kernel_launch: hipFuncSetAttribute failed\n"); grid = -1; return; }
        hipOccupancyMaxActiveBlocksPerMultiprocessor(&per_cu, (const void*)fwd_megakernel, 512, LDS_BYTES);
        if (per_cu < 1) { fprintf(stderr, "kernel_launch: occupancy query says %d blocks/CU\n", per_cu); per_cu = 1; }
        (void)hipGetLastError();
        grid = cus * per_cu;
    }
    if (grid < 0) return;
    Args a{};
    for (int i = 0; i < 15; ++i) a.in[i] = (const float*)d_in[i];
    a.out = (float*)d_out; a.ws = (unsigned char*)d_ws;
    if (N_LAUNCHES == 1) {
        a.ph_lo = 0; a.ph_hi = 6;
        if (hipMemsetAsync((unsigned char*)d_ws + WS_BAR, 0, XCD_BAR_WORDS * 4, stream) != hipSuccess) fprintf(stderr, "kernel_launch: memset of the barrier words failed\n");
        void* args[] = {&a};
        hipError_t e = hipLaunchCooperativeKernel((const void*)fwd_megakernel, dim3(grid), dim3(512), args, LDS_BYTES, stream);
        if (e != hipSuccess) fprintf(stderr, "cooperative launch failed: %s (grid %d)\n", hipGetErrorString(e), grid);
    } else {
        for (int p = 0; p < 6; ++p) { a.ph_lo = p; a.ph_hi = p + 1; hipLaunchKernelGGL(fwd_megakernel, dim3(grid), dim3(512), LDS_BYTES, stream, a); }
    }
}
```

```cpp
#include <hip/hip_runtime.h>
#include <hip/hip_cooperative_groups.h>
#include <cstdio>
namespace cg = cooperative_groups;

#define LAS __attribute__((address_space(3)))
typedef unsigned short bf16_t;
typedef short bf16x8 __attribute__((ext_vector_type(8)));
typedef float f32x4 __attribute__((ext_vector_type(4)));
typedef float f32x16 __attribute__((ext_vector_type(16)));
typedef unsigned u32x4 __attribute__((ext_vector_type(4)));
typedef unsigned u32x2 __attribute__((ext_vector_type(2)));

#ifndef PROBE_DUP
#define PROBE_DUP -1
#endif
#ifndef N_LAUNCHES
#define N_LAUNCHES 1
#endif

constexpr int MP = 8 * 4096, MS = 8 * 8192, MTOK = MP + MS;
constexpr int DM = 1024, NIN = 5632, DFF = 4096;
constexpr float EPS = 1e-6f;
constexpr float LOG2E = 1.4426950408889634f;
constexpr size_t MiB = 1u << 20;
constexpr size_t WS_WT = 0, WS_WOT = 12 * MiB, WS_W1T = 14 * MiB, WS_W2T = 22 * MiB;
constexpr size_t WS_Q = 32 * MiB;
constexpr size_t WS_U = 224 * MiB;
constexpr size_t WS_SA = 416 * MiB, WS_SB = 608 * MiB;
constexpr size_t WS_K = 800 * MiB;
constexpr size_t WS_VT = 848 * MiB;
constexpr size_t WS_HID = 224 * MiB;
constexpr size_t WS_PART = 992 * MiB;
constexpr size_t WS_WSB = 31 * MiB;
constexpr size_t WS_BAR = 1000 * MiB;
constexpr size_t WS_END = 1001 * MiB;
constexpr size_t DO_H = 0, DO_GVT = 192 * MiB;

constexpr int KT_PITCH = 272, VT_PITCH = 264;
constexpr int R_KT = 0, R_VT = 34816, R_GV = 68608;
constexpr int EX_WAVE = 17408, EX_T2 = 8704;
constexpr int R_TB = 139264, TB_N = 320, R_RSTD = R_TB + 8 * TB_N * 4, R_RED = R_RSTD + 512;
constexpr int LDS_BYTES = 155648;
static_assert(R_RED + 4096 <= LDS_BYTES, "lds map");

__device__ __forceinline__ unsigned cvt_pk_bf16(float lo, float hi) { unsigned r; asm volatile("v_cvt_pk_bf16_f32 %0, %1, %2" : "=v"(r) : "v"(lo), "v"(hi)); return r; }
__device__ __forceinline__ float bf_lo(unsigned w) { return __uint_as_float(w << 16); }
__device__ __forceinline__ float bf_hi(unsigned w) { return __uint_as_float(w & 0xffff0000u); }
typedef float f32x2 __attribute__((ext_vector_type(2)));
template <int CTRL> __device__ __forceinline__ float dpp(float x) { return __builtin_bit_cast(float, __builtin_amdgcn_mov_dpp(__builtin_bit_cast(int, x), CTRL, 0xf, 0xf, true)); }
__device__ __forceinline__ float row16_sum(float x) { x += dpp<0xB1>(x); x += dpp<0x4E>(x); x += dpp<0x141>(x); x += dpp<0x128>(x); return x; }
__device__ __forceinline__ float x16_sum(float x) { auto s = __builtin_amdgcn_permlane16_swap(__float_as_uint(x), __float_as_uint(x), false, false); return __uint_as_float(s[0]) + __uint_as_float(s[1]); }
__device__ __forceinline__ float x32_sum(float x) { auto s = __builtin_amdgcn_permlane32_swap(__float_as_uint(x), __float_as_uint(x), false, false); return __uint_as_float(s[0]) + __uint_as_float(s[1]); }
__device__ __forceinline__ float x32_max(float x) { auto s = __builtin_amdgcn_permlane32_swap(__float_as_uint(x), __float_as_uint(x), false, false); return fmaxf(__uint_as_float(s[0]), __uint_as_float(s[1])); }
__device__ __forceinline__ f32x2 gelu2(f32x2 x) { const f32x2 u = x * x, p = u * (0.044715f * -2.302208198f) + (-2.302208198f), t = x * p; f32x2 e; e.x = __builtin_amdgcn_exp2f(t.x); e.y = __builtin_amdgcn_exp2f(t.y);
    const f32x2 d = e + 1.0f; f32x2 r; r.x = __builtin_amdgcn_rcpf(d.x); r.y = __builtin_amdgcn_rcpf(d.y); return x * r; }
__device__ __forceinline__ f32x2 sigmoid2(f32x2 x) { const f32x2 t = x * (-LOG2E); f32x2 e; e.x = __builtin_amdgcn_exp2f(t.x); e.y = __builtin_amdgcn_exp2f(t.y);
    const f32x2 d = e + 1.0f; f32x2 r; r.x = __builtin_amdgcn_rcpf(d.x); r.y = __builtin_amdgcn_rcpf(d.y); return r; }
__device__ __forceinline__ float gelu_tanh(float x) { const float t = x * (1.0f + 0.044715f * x * x) * (-2.302208198f); return x * __builtin_amdgcn_rcpf(1.0f + __builtin_amdgcn_exp2f(t)); }
__device__ __forceinline__ float sigmoidf(float x) { return __builtin_amdgcn_rcpf(1.0f + __builtin_amdgcn_exp2f(-LOG2E * x)); }

namespace pg8 {
constexpr int BM = 256, BK = 64, HALF = 128, HTB = HALF * BK * 2, STAGE_BYTES = 8 * HTB, NXCD = 8, WGM = 8;
__host__ __device__ __forceinline__ int lds_byte(int r, int c) { const int st = (r >> 4) * 2 + (c >> 5), rr = r & 15, cc = c & 31, ob = rr * 64 + cc * 2; return st * 1024 + (ob ^ (((ob >> 9) & 1) << 5)); }
__host__ __device__ __forceinline__ void stage_rc(int b, int& R, int& C) { const int st = b / 1024, sb = b % 1024, swz = sb ^ (((sb >> 9) & 1) << 5); R = (st >> 1) * 16 + swz / 64; C = (st & 1) * 32 + (swz % 64) / 2; }
__host__ __device__ __forceinline__ int perm32(int rho) { const int n = rho >> 4, i = rho & 15; return 8 * (i >> 2) + 4 * n + (i & 3); }
struct Unit { int pm, pn; };
struct StaticOrder {
    int nM, nN, nwg, G, c, rev;
    __device__ void init(int M, int N, int G_, int c_, int rev_ = 0) { nM = M / BM; nN = N / BM; nwg = nM * nN; G = G_; c = c_; rev = (rev_ && nwg % G_ == 0) ? nwg / G_ : 0; }
    __device__ bool next(int i, Unit& u) const {
        if (rev && i >= rev) return false;
        const long L = (long)(rev ? rev - 1 - i : i) * G + c; if (L >= nwg) return false;
        int wgid = (int)L; { const int q = nwg / NXCD, r = nwg % NXCD, xcd = wgid % NXCD, off = wgid / NXCD; wgid = (xcd < r ? xcd * (q + 1) : r * (q + 1) + (xcd - r) * q) + off; }
        const int nig = WGM * nN, gid = wgid / nig, fm = gid * WGM, gsz = (nM - fm) < WGM ? (nM - fm) : WGM;
        u.pm = fm + ((wgid % nig) % gsz); u.pn = (wgid % nig) / gsz; return true;
    }
};
struct PlainPtrs { const bf16_t* A; const bf16_t* Bt; int K;
    __device__ __forceinline__ void get(const Unit& u, const char*& a, const char*& b) const { a = (const char*)A + (size_t)u.pm * 512 * K; b = (const char*)Bt + (size_t)u.pn * 512 * K; } };

template <class Epi, class Ptrs>
__device__ __forceinline__ void gemm_phase(LAS unsigned char* lds, const int K, const StaticOrder& S, const Ptrs& P, const Epi& E) {
    const int tid = threadIdx.x, wid = __builtin_amdgcn_readfirstlane(tid >> 6), lane = tid & 63, wr = wid >> 2, wc = wid & 3, fr = lane & 15, fq = lane >> 4;
    const int nt = K / BK;
    unsigned voffA[2], voffB[2];
#pragma unroll
    for (int i = 0; i < 2; ++i) { int R, C; stage_rc(tid * 16 + i * 8192, R, C); const int Rb = (R & ~31) + perm32(R & 31);
        voffA[i] = (unsigned)(R * K + C) * 2u; voffB[i] = (unsigned)(Rb * K + C) * 2u; }
    const size_t kstep = (size_t)(BK * 2);
    const size_t hstep = (size_t)HALF * K * 2;
    const unsigned ldsw = (unsigned)wid * 1024u;
    const int aoff = lds_byte(wr * 64 + fr, fq * 8), boff = lds_byte(wc * 32 + fr, fq * 8);
#define PG8_SA(b, h) (((b) * 2 + (h)) * HTB)
#define PG8_SB(b, h) ((4 + (b) * 2 + (h)) * HTB)
#define PG8_STAGE(bufoff, gbase, voff) do { _Pragma("unroll") for (int _i = 0; _i < 2; ++_i) \
        __builtin_amdgcn_global_load_lds((const unsigned*)((const char*)(gbase) + (voff)[_i]), (LAS unsigned*)(lds + (bufoff) + ldsw + _i * 8192), 16, 0, 0); } while (0)
#define PG8_LDA(dst, b, h) do { _Pragma("unroll") for (int m = 0; m < 4; ++m) _Pragma("unroll") for (int k = 0; k < 2; ++k) dst[m][k] = *(const LAS bf16x8*)(lds + PG8_SA(b, h) + aoff + m * 2048 + k * 1024); } while (0)
#define PG8_LDB(dst, b, h) do { _Pragma("unroll") for (int n = 0; n < 2; ++n) _Pragma("unroll") for (int k = 0; k < 2; ++k) dst[n][k] = *(const LAS bf16x8*)(lds + PG8_SB(b, h) + boff + n * 2048 + k * 1024); } while (0)
#define PG8_MMA(ai, bj, At, Bt) do { __builtin_amdgcn_s_setprio(1); _Pragma("unroll") for (int m = 0; m < 4; ++m) _Pragma("unroll") for (int n = 0; n < 2; ++n) _Pragma("unroll") for (int k = 0; k < 2; ++k) \
        acc[ai][bj][m][n] = __builtin_amdgcn_mfma_f32_16x16x32_bf16(Bt[n][k], At[m][k], acc[ai][bj][m][n], 0, 0, 0); __builtin_amdgcn_s_setprio(0); } while (0)
#define PG8_WAIT_V(n) asm volatile("s_waitcnt vmcnt(" #n ")" ::: "memory")
#define PG8_WAIT_L(n) asm volatile("s_waitcnt lgkmcnt(" #n ")" ::: "memory")
#define PG8_BAR __builtin_amdgcn_s_barrier()
#define PG8_SCHED __builtin_amdgcn_sched_barrier(0)
    Unit cur, nxt; int ui = 0;
    if (!S.next(0, cur)) return;
    f32x4 acc[2][2][4][2];
#pragma unroll
    for (int a = 0; a < 2; ++a)
#pragma unroll
        for (int b = 0; b < 2; ++b)
#pragma unroll
            for (int m = 0; m < 4; ++m)
#pragma unroll
                for (int n = 0; n < 2; ++n) acc[a][b][m][n] = (f32x4){0.f, 0.f, 0.f, 0.f};
    bf16x8 At[4][2], B0[2][2], B1[2][2];
    const char* cA; const char* cB; P.get(cur, cA, cB);
    PG8_STAGE(PG8_SB(0, 0), cB, voffB); PG8_STAGE(PG8_SA(0, 0), cA, voffA); PG8_STAGE(PG8_SB(0, 1), cB + hstep, voffB); PG8_STAGE(PG8_SA(0, 1), cA + hstep, voffA);
    if (wr == 1) PG8_BAR;
    PG8_WAIT_V(4); PG8_BAR;
    PG8_STAGE(PG8_SB(1, 0), cB + kstep, voffB); PG8_STAGE(PG8_SA(1, 0), cA + kstep, voffA); PG8_STAGE(PG8_SB(1, 1), cB + hstep + kstep, voffB);
    PG8_WAIT_V(6); PG8_BAR;
    for (;;) {
        const bool has_next = S.next(ui + 1, nxt);
        const char* nA = cA; const char* nB = cB; if (has_next) P.get(nxt, nA, nB);
        for (int t = 0; t < nt; t += 2) {
            const bool last = (t == nt - 2);
            const char* a1 = cA + (size_t)(t + 1) * kstep;
            const char* a2 = last ? nA : cA + (size_t)(t + 2) * kstep; const char* b2 = last ? nB : cB + (size_t)(t + 2) * kstep;
            const char* a3 = a2 + kstep; const char* b3 = b2 + kstep;
            PG8_LDB(B0, 0, 0); PG8_SCHED; PG8_LDA(At, 0, 0); PG8_STAGE(PG8_SA(1, 1), a1 + hstep, voffA);
            PG8_WAIT_L(8); PG8_BAR; PG8_WAIT_L(0); PG8_MMA(0, 0, At, B0); PG8_BAR; PG8_SCHED;
            PG8_LDB(B1, 0, 1); PG8_STAGE(PG8_SB(0, 0), b2, voffB);
            PG8_BAR; PG8_WAIT_L(0); PG8_MMA(0, 1, At, B1); PG8_BAR;
            PG8_LDA(At, 0, 1); PG8_STAGE(PG8_SA(0, 0), a2, voffA);
            PG8_BAR; PG8_WAIT_L(0); PG8_MMA(1, 0, At, B0); PG8_BAR; PG8_SCHED;
            PG8_STAGE(PG8_SB(0, 1), b2 + hstep, voffB);
            PG8_WAIT_V(6); PG8_BAR; PG8_MMA(1, 1, At, B1); PG8_BAR;
            PG8_LDB(B0, 1, 0); PG8_SCHED; PG8_LDA(At, 1, 0); PG8_STAGE(PG8_SA(0, 1), a2 + hstep, voffA);
            PG8_WAIT_L(8); PG8_BAR; PG8_WAIT_L(0); PG8_MMA(0, 0, At, B0); PG8_BAR; PG8_SCHED;
            PG8_LDB(B1, 1, 1); PG8_STAGE(PG8_SB(1, 0), b3, voffB);
            PG8_BAR; PG8_WAIT_L(0); PG8_MMA(0, 1, At, B1); PG8_BAR;
            PG8_LDA(At, 1, 1); PG8_STAGE(PG8_SA(1, 0), a3, voffA);
            PG8_BAR; PG8_WAIT_L(0); PG8_MMA(1, 0, At, B0); PG8_BAR; PG8_SCHED;
            PG8_STAGE(PG8_SB(1, 1), b3 + hstep, voffB);
            PG8_WAIT_V(6); PG8_BAR; PG8_MMA(1, 1, At, B1); PG8_BAR;
        }
        E(acc, cur, ui, wr, wc, fr, fq);
        if (!has_next) break;
#pragma unroll
        for (int a = 0; a < 2; ++a)
#pragma unroll
            for (int b = 0; b < 2; ++b)
#pragma unroll
                for (int m = 0; m < 4; ++m)
#pragma unroll
                    for (int n = 0; n < 2; ++n) acc[a][b][m][n] = (f32x4){0.f, 0.f, 0.f, 0.f};
        cur = nxt; cA = nA; cB = nB; ++ui;
    }
    PG8_WAIT_V(0);
    if (wr == 0) PG8_BAR;
    PG8_BAR;
#undef PG8_SA
#undef PG8_SB
#undef PG8_STAGE
#undef PG8_LDA
#undef PG8_LDB
#undef PG8_MMA
#undef PG8_WAIT_V
#undef PG8_WAIT_L
#undef PG8_BAR
#undef PG8_SCHED
}
}
using pg8::Unit;

struct Args { const float* in[15]; float* out; unsigned char* ws; int ph_lo, ph_hi; };
enum { I_XP = 0, I_XS, I_RELB, I_N1G, I_WIN, I_SGUG, I_WS, I_BS, I_QG, I_KG, I_SINK, I_WO, I_N2G, I_W1, I_W2 };

struct P1Ptrs { const bf16_t* H; const bf16_t* Wt;
    __device__ __forceinline__ void get(const Unit& u, const char*& a, const char*& b) const {
        const char* hp = (const char*)H + (size_t)u.pm * 512 * DM; const char* wp = (const char*)Wt + (size_t)u.pn * 512 * DM;
        if (u.pn < 17) { a = hp; b = wp; } else { a = wp; b = hp; } } };
__device__ __forceinline__ u32x4 pack8(f32x4 v0, f32x4 v1) { u32x4 w; w.x = cvt_pk_bf16(v0[0], v0[1]); w.y = cvt_pk_bf16(v0[2], v0[3]); w.z = cvt_pk_bf16(v1[0], v1[1]); w.w = cvt_pk_bf16(v1[2], v1[3]); return w; }
__device__ __forceinline__ f32x2 g1_2(f32x2 x, f32x2 g) { const f32x2 u = x * x, p = u * (0.044715f * -2.302208198f) + (-2.302208198f), t = x * p, tg = g * (-LOG2E);
    f32x2 e1, e2; e1.x = __builtin_amdgcn_exp2f(t.x); e1.y = __builtin_amdgcn_exp2f(t.y); e2.x = __builtin_amdgcn_exp2f(tg.x); e2.y = __builtin_amdgcn_exp2f(tg.y);
    const f32x2 d = (e1 + 1.0f) * (e2 + 1.0f); f32x2 r; r.x = __builtin_amdgcn_rcpf(d.x); r.y = __builtin_amdgcn_rcpf(d.y); return x * r; }
__device__ __forceinline__ f32x4 g1_4(f32x4 v, f32x4 g) { const f32x2 a = g1_2((f32x2){v[0], v[1]}, (f32x2){g[0], g[1]}), b = g1_2((f32x2){v[2], v[3]}, (f32x2){g[2], g[3]}); return (f32x4){a.x, a.y, b.x, b.y}; }
__device__ __forceinline__ f32x4 gelu4(f32x4 v) { const f32x2 a = gelu2((f32x2){v[0], v[1]}), b = gelu2((f32x2){v[2], v[3]}); return (f32x4){a.x, a.y, b.x, b.y}; }
__device__ __forceinline__ f32x4 sigmoid4(f32x4 v) { const f32x2 a = sigmoid2((f32x2){v[0], v[1]}), b = sigmoid2((f32x2){v[2], v[3]}); return (f32x4){a.x, a.y, b.x, b.y}; }
struct EpiP1 {
    unsigned char* ws; unsigned char* dout;
    __device__ __forceinline__ void operator()(const f32x4 (&acc)[2][2][4][2], const Unit& u, int ui, int wr, int wc, int fr, int fq) const {
        const int pn = u.pn;
        if (pn < 8) {
            bf16_t* base = (bf16_t*)(ws + WS_U) + (size_t)(u.pm * 256 + wr * 64 + fr) * DM + pn * 128 + wc * 32 + 8 * fq;
#pragma unroll
            for (int ai = 0; ai < 2; ++ai)
#pragma unroll
                for (int m = 0; m < 4; ++m) {
                    const f32x4 g0 = g1_4(acc[ai][0][m][0], acc[ai][1][m][0]), g1 = g1_4(acc[ai][0][m][1], acc[ai][1][m][1]);
                    *(u32x4*)(base + (size_t)(ai * 128 + m * 16) * DM) = pack8(g0, g1); }
            return; }
        if (pn >= 17 && pn < 21) {
            bf16_t* base = (bf16_t*)(dout + DO_GVT) + (size_t)((pn - 17) * 256 + wr * 64 + fr) * MTOK + u.pm * 256 + wc * 32 + 8 * fq;
            float* pp = (float*)(ws + WS_PART) + (size_t)(u.pm * 256 + wc * 32 + 8 * fq) * 8 + (pn - 17) * 2 + wr;
#pragma unroll
            for (int bj = 0; bj < 2; ++bj) { f32x4 sq0 = {0.f, 0.f, 0.f, 0.f}, sq1 = {0.f, 0.f, 0.f, 0.f};
#pragma unroll
                for (int ai = 0; ai < 2; ++ai)
#pragma unroll
                    for (int m = 0; m < 4; ++m) { const f32x4 g0 = gelu4(acc[ai][bj][m][0]), g1 = gelu4(acc[ai][bj][m][1]);
                        sq0 += g0 * g0; sq1 += g1 * g1;
                        *(u32x4*)(base + (size_t)(ai * 128 + m * 16) * MTOK + bj * 128) = pack8(g0, g1); }
#pragma unroll
                for (int j = 0; j < 4; ++j) { const float t0 = row16_sum(sq0[j]), t1 = row16_sum(sq1[j]); if (fr == 0) { pp[(size_t)(bj * 128 + j) * 8] = t0; pp[(size_t)(bj * 128 + 4 + j) * 8] = t1; } } }
            return; }
        bf16_t* base; size_t ld; int row0, col0, act;
        if (pn < 12)      { base = (bf16_t*)(ws + WS_Q);  ld = DM;  row0 = u.pm * 256; col0 = (pn - 8) * 256;  act = 0; }
        else if (pn < 13) { base = (bf16_t*)(ws + WS_K);  ld = 256; row0 = u.pm * 256; col0 = 0;               act = 0; }
        else if (pn < 17) { base = (bf16_t*)(ws + WS_SB); ld = DM;  row0 = u.pm * 256; col0 = (pn - 13) * 256; act = 2; }
        else              { base = (bf16_t*)(ws + WS_VT); ld = MTOK; row0 = 0; col0 = u.pm * 256; act = 0; }
        const int r0 = row0 + wr * 64 + fr, c0 = col0 + wc * 32 + 8 * fq;
#pragma unroll
        for (int ai = 0; ai < 2; ++ai)
#pragma unroll
            for (int m = 0; m < 4; ++m) { bf16_t* rowp = base + (size_t)(r0 + ai * 128 + m * 16) * ld + c0;
#pragma unroll
                for (int bj = 0; bj < 2; ++bj) { f32x4 v0 = acc[ai][bj][m][0], v1 = acc[ai][bj][m][1];
                    if (act == 2) { v0 = sigmoid4(v0); v1 = sigmoid4(v1); }
                    *(u32x4*)(rowp + bj * 128) = pack8(v0, v1); } }
    }
};
struct EpiWo {
    const float* xp; const float* xs; bf16_t* xb; float* part;
    __device__ __forceinline__ void operator()(const f32x4 (&acc)[2][2][4][2], const Unit& u, int ui, int wr, int wc, int fr, int fq) const {
        const int row0 = u.pm * 256 + wr * 64 + fr, col0 = u.pn * 256 + wc * 32 + 8 * fq;
        const float* xb0 = (u.pm * 256 < MP) ? xp : xs - (size_t)MP * DM;
#pragma unroll
        for (int ai = 0; ai < 2; ++ai) {
            f32x4 xv[4][2][2];
#pragma unroll
            for (int m = 0; m < 4; ++m)
#pragma unroll
                for (int bj = 0; bj < 2; ++bj) { const float* p = xb0 + (size_t)(row0 + ai * 128 + m * 16) * DM + col0 + bj * 128; xv[m][bj][0] = *(const f32x4*)p; xv[m][bj][1] = *(const f32x4*)(p + 4); }
#pragma unroll
            for (int m = 0; m < 4; ++m) { const int row = row0 + ai * 128 + m * 16; const size_t off = (size_t)row * DM + col0; float ss = 0.f;
#pragma unroll
                for (int bj = 0; bj < 2; ++bj) {
                    const f32x4 v0 = acc[ai][bj][m][0] + xv[m][bj][0], v1 = acc[ai][bj][m][1] + xv[m][bj][1];
                    u32x4 w; w.x = cvt_pk_bf16(v0[0], v0[1]); w.y = cvt_pk_bf16(v0[2], v0[3]); w.z = cvt_pk_bf16(v1[0], v1[1]); w.w = cvt_pk_bf16(v1[2], v1[3]);
                    *(u32x4*)(xb + off + bj * 128) = w;
                    ss += (v0[0] * v0[0] + v0[1] * v0[1]) + (v0[2] * v0[2] + v0[3] * v0[3]) + (v1[0] * v1[0] + v1[1] * v1[1]) + (v1[2] * v1[2] + v1[3] * v1[3]); }
                ss = x32_sum(x16_sum(ss));
                if (fq == 0) part[(size_t)row * 16 + u.pn * 4 + wc] = ss; }
        }
    }
};
struct EpiFF1 {
    bf16_t* hid;
    __device__ __forceinline__ void operator()(const f32x4 (&acc)[2][2][4][2], const Unit& u, int ui, int wr, int wc, int fr, int fq) const {
        const int row0 = u.pm * 256 + wr * 64 + fr, col0 = u.pn * 256 + wc * 32 + 8 * fq;
#pragma unroll
        for (int ai = 0; ai < 2; ++ai)
#pragma unroll
            for (int m = 0; m < 4; ++m) { bf16_t* rowp = hid + (size_t)(row0 + ai * 128 + m * 16) * DFF + col0;
#pragma unroll
                for (int bj = 0; bj < 2; ++bj) { f32x4 v0 = acc[ai][bj][m][0], v1 = acc[ai][bj][m][1];
#pragma unroll
                    for (int j = 0; j < 4; ++j) { const float a = fmaxf(v0[j], 0.f), b = fmaxf(v1[j], 0.f); v0[j] = a * a; v1[j] = b * b; }
                    u32x4 w; w.x = cvt_pk_bf16(v0[0], v0[1]); w.y = cvt_pk_bf16(v0[2], v0[3]); w.z = cvt_pk_bf16(v1[0], v1[1]); w.w = cvt_pk_bf16(v1[2], v1[3]);
                    *(u32x4*)(rowp + bj * 128) = w; } }
    }
};
constexpr int R_FF2TAB = 131072;
struct EpiFF2 {
    float* out; const bf16_t* xb; const LAS float* tab;
    __device__ __forceinline__ void operator()(const f32x4 (&acc)[2][2][4][2], const Unit& u, int ui, int wr, int wc, int fr, int fq) const {
        const int rl0 = wr * 64 + fr, col0 = u.pn * 256 + wc * 32 + 8 * fq;
        u32x4 xv[2][4][2];
#pragma unroll
        for (int ai = 0; ai < 2; ++ai)
#pragma unroll
            for (int m = 0; m < 4; ++m)
#pragma unroll
                for (int bj = 0; bj < 2; ++bj) xv[ai][m][bj] = *(const u32x4*)(xb + (size_t)(u.pm * 256 + rl0 + ai * 128 + m * 16) * DM + col0 + bj * 128);
#pragma unroll
        for (int ai = 0; ai < 2; ++ai)
#pragma unroll
            for (int m = 0; m < 4; ++m) { const int rl = rl0 + ai * 128 + m * 16; float* rowp = out + (size_t)(u.pm * 256 + rl) * DM + col0;
                const float r2 = tab[ui * 256 + rl];
#pragma unroll
                for (int bj = 0; bj < 2; ++bj) { const u32x4 x = xv[ai][m][bj];
                    const f32x4 x0 = {bf_lo(x.x), bf_hi(x.x), bf_lo(x.y), bf_hi(x.y)}, x1 = {bf_lo(x.z), bf_hi(x.z), bf_lo(x.w), bf_hi(x.w)};
                    *(f32x4*)(rowp + bj * 128) = acc[ai][bj][m][0] * r2 + x0; *(f32x4*)(rowp + bj * 128 + 4) = acc[ai][bj][m][1] * r2 + x1; } }
    }
};

__device__ __forceinline__ void p0_transpose_blk(const float* W, int ldw, const float* kscale, bf16_t* WT, int K, int k0, int n0src, int n0dst, LAS float* scr, int lane) {
    float wv[32];
#pragma unroll
    for (int i = 0; i < 32; ++i) wv[i] = W[(size_t)(k0 + 2 * i + (lane >> 5)) * ldw + n0src + (lane & 31)];
    if (kscale) {
#pragma unroll
        for (int i = 0; i < 32; ++i) wv[i] *= kscale[k0 + 2 * i + (lane >> 5)]; }
#pragma unroll
    for (int i = 0; i < 32; ++i) scr[(2 * i + (lane >> 5)) * 33 + (lane & 31)] = wv[i];
    asm volatile("s_waitcnt lgkmcnt(0)" ::: "memory");
    const int c = lane & 7;
#pragma unroll
    for (int j = 0; j < 4; ++j) { const int n = (lane >> 3) + 8 * j; const LAS float* s = scr + (8 * c) * 33 + n;
        u32x4 o; o.x = cvt_pk_bf16(s[0 * 33], s[1 * 33]); o.y = cvt_pk_bf16(s[2 * 33], s[3 * 33]); o.z = cvt_pk_bf16(s[4 * 33], s[5 * 33]); o.w = cvt_pk_bf16(s[6 * 33], s[7 * 33]);
        *(u32x4*)(WT + (size_t)(n0dst + n) * K + k0 + 8 * c) = o; }
    asm volatile("s_waitcnt lgkmcnt(0)" ::: "memory");
}
__device__ __forceinline__ int win_src_col(int d) {
    if (d < 2048) { const int j = d >> 8, w = d & 255; return w < 128 ? 128 * j + w : 3584 + 128 * j + (w - 128); }
    if (d < 3072) return 2048 + (d - 2048);
    if (d < 3328) return 3072 + (d - 3072);
    if (d < 4352) return 4608 + (d - 3328);
    if (d < 5376) return 1024 + (d - 4352);
    return 3328 + (d - 5376);
}
__device__ __forceinline__ float wave_sum(float v) { return x32_sum(x16_sum(row16_sum(v))); }
__device__ __forceinline__ void p0_phase(LAS unsigned char* lds, const Args& a, int vcu, int G, int wave, int lane) {
    LAS float* scr = (LAS float*)(lds + wave * 16384);
    const int gw = vcu * 8 + wave, NGW = G * 8;
    bf16_t* Wt = (bf16_t*)(a.ws + WS_WT);
    const float* win = a.in[I_WIN];
    constexpr int I_IN = 16 * (NIN / 32), I_O = 16 * 32, I_1 = 16 * (DFF / 32), I_2 = 64 * 32;
    for (int it = gw; it < I_IN + I_O + I_1 + I_2; it += NGW) {
        int r = it;
        if (r < I_IN) { const int kb = r / (NIN / 32), nb = r % (NIN / 32); p0_transpose_blk(win, NIN, nullptr, Wt, DM, 64 * kb, win_src_col(32 * nb), 32 * nb, scr, lane); continue; }
        r -= I_IN;
        if (r < I_O) { const int kb = r / 32, nb = r % 32; p0_transpose_blk(a.in[I_WO], DM, nullptr, (bf16_t*)(a.ws + WS_WOT), DM, 64 * kb, 32 * nb, 32 * nb, scr, lane); continue; } r -= I_O;
        if (r < I_1) { const int kb = r / 128, nb = r % 128; p0_transpose_blk(a.in[I_W1], DFF, a.in[I_N2G], (bf16_t*)(a.ws + WS_W1T), DM, 64 * kb, 32 * nb, 32 * nb, scr, lane); continue; } r -= I_1;
        { const int kb = r / 32, nb = r % 32; p0_transpose_blk(a.in[I_W2], DM, nullptr, (bf16_t*)(a.ws + WS_W2T), DFF, 64 * kb, 32 * nb, 32 * nb, scr, lane); }
    }
    { const int gt = gw * 64 + lane; if (gt < 8 * 128 * 128 / 8) { const f32x4 w0 = ((const f32x4*)a.in[I_WS])[2 * gt], w1 = ((const f32x4*)a.in[I_WS])[2 * gt + 1]; ((u32x4*)(a.ws + WS_WSB))[gt] = pack8(w0, w1); } }
    bf16_t* H = (bf16_t*)((unsigned char*)a.out + DO_H);
    const f32x4* g4 = (const f32x4*)a.in[I_N1G] + lane;
    f32x4 g[4];
#pragma unroll
    for (int j = 0; j < 4; ++j) g[j] = g4[64 * j];
    for (int m = gw; m < MTOK; m += NGW) {
        const float* xrow = (m < MP) ? a.in[I_XP] + (size_t)m * DM : a.in[I_XS] + (size_t)(m - MP) * DM;
        const f32x4* xr = (const f32x4*)xrow + lane;
        f32x4 v[4]; float s = 0.f;
#pragma unroll
        for (int j = 0; j < 4; ++j) { v[j] = xr[64 * j]; s += (v[j].x * v[j].x + v[j].y * v[j].y) + (v[j].z * v[j].z + v[j].w * v[j].w); }
        const float rstd = __builtin_amdgcn_rsqf(wave_sum(s) * (1.f / DM) + EPS);
        u32x2* o8 = (u32x2*)(H + (size_t)m * DM) + lane;
#pragma unroll
        for (int j = 0; j < 4; ++j) { const f32x4 y = v[j] * rstd * g[j]; u32x2 w; w.x = cvt_pk_bf16(y.x, y.y); w.y = cvt_pk_bf16(y.z, y.w); o8[64 * j] = w; }
    }
}

__device__ __forceinline__ int t5_bucket(int rel) {
    const int n = rel < 0 ? -rel : rel; int b = rel > 0 ? 16 : 0;
    if (n < 8) return b + n;
    int k = (n >= 12) + (n >= 16) + (n >= 23) + (n >= 32) + (n >= 46) + (n >= 64) + (n >= 91);
    return b + 8 + k;
}
__device__ __forceinline__ u32x4 ldg16(const void* ubase, unsigned voff) { return *(const u32x4*)((const char*)ubase + voff); }
__device__ __forceinline__ void p2_unit_info(int unit, int& tok0, int& kb_lo, int& kb_hi) {
    tok0 = unit * 128; int n, nblk; if (unit < MP / 128) { n = unit & 31; nblk = 32; } else { n = (unit - MP / 128) & 63; nblk = 64; }
    kb_lo = (n > 0) ? -1 : 0; kb_hi = (n < nblk - 1) ? 1 : 0;
}
#define P2_BAR() do { asm volatile("s_waitcnt lgkmcnt(0)" ::: "memory"); __builtin_amdgcn_s_barrier(); asm volatile("" ::: "memory"); } while (0)
__device__ __forceinline__ void p2_phase(LAS unsigned char* lds, const Args& a, int vcu, int G, bf16_t* Mout) {
    const int tid = threadIdx.x, wave = __builtin_amdgcn_readfirstlane(tid >> 6), lane = tid & 63, c = lane & 31, h = lane >> 5;
    const int hsel = wave >> 2, qt = hsel ? 3 - (wave & 3) : (wave & 3);
    const bf16_t* Qg = (const bf16_t*)(a.ws + WS_Q); const bf16_t* Kg = (const bf16_t*)(a.ws + WS_K); const bf16_t* VTg = (const bf16_t*)(a.ws + WS_VT);
    const bf16_t* GVTg = (const bf16_t*)((unsigned char*)a.out + DO_GVT);
    const bf16_t* Ug = (const bf16_t*)(a.ws + WS_U); const bf16_t* SBg = (const bf16_t*)(a.ws + WS_SB);
    LAS float* tb = (LAS float*)(lds + R_TB); LAS float* rstd_l = (LAS float*)(lds + R_RSTD); LAS float* red = (LAS float*)(lds + R_RED);
    constexpr int NU = MTOK / 128;
    for (int i = tid; i < 8 * TB_N; i += 512) { const int hd = i / TB_N, rel = (i % TB_N) - 160; const int ar = rel < 0 ? -rel : rel;
        tb[i] = (ar <= 128) ? a.in[I_RELB][t5_bucket(rel) * 8 + hd] * LOG2E : -1e30f; }
    const int bxg = blockIdx.x;
    const bool ord256 = (G == 256);
    const int n_my = ord256 ? 3 : (vcu < NU ? (NU - 1 - vcu) / G + 1 : 0);
#define P2_UNIT(i) (ord256 ? 96 * (bxg & 7) + 95 - ((bxg >> 3) + 32 * (i)) : vcu + G * (i))
    if (n_my == 0) { P2_BAR(); return; }
    const int srow = tid >> 4, sch = tid & 15;
    const f32x4 kg0 = *(const f32x4*)(a.in[I_KG] + sch * 8), kg1 = *(const f32x4*)(a.in[I_KG] + sch * 8 + 4);
    u32x4 Kraw[4], Vraw[4];
    const unsigned offK = (unsigned)(srow * 256 + sch * 8) * 2u, offV = (unsigned)(srow * MTOK + sch * 8) * 2u;
    const unsigned offGV = (unsigned)((lane >> 4) * MTOK + (((lane & 15) ^ ((4 * wave + (lane >> 4)) & 15)) * 8)) * 2u;
    const unsigned offQ = (unsigned)(c * DM + 8 * h) * 2u, offP0 = (unsigned)((tid >> 4) * MTOK + 8 * (tid & 15)) * 2u, offC = (unsigned)((lane >> 4) * DM + (lane & 15) * 8) * 2u;
#define P2_PREFETCH(u_tok0, u_pr, u_kb) do { const int _kt0 = (u_tok0) + (u_kb) * 128, _kvh = (u_pr) >> 1; \
        const char* _kb0 = (const char*)(Kg + (size_t)_kt0 * 256 + _kvh * 128); const char* _vb0 = (const char*)(VTg + (size_t)(_kvh * 128) * MTOK + _kt0); \
        _Pragma("unroll") for (int i = 0; i < 4; ++i) Kraw[i] = ldg16(_kb0 + (size_t)i * (32 * 256 * 2), offK); \
        _Pragma("unroll") for (int i = 0; i < 4; ++i) Vraw[i] = ldg16(_vb0 + (size_t)i * ((size_t)32 * MTOK * 2), offV); } while (0)
    { int t0_, lo_, hi_; p2_unit_info(P2_UNIT(0), t0_, lo_, hi_); P2_PREFETCH(t0_, 0, lo_); }
    for (int uix = 0; uix < n_my; ++uix) { const int unit = P2_UNIT(uix);
        int tok0, kb_lo, kb_hi; p2_unit_info(unit, tok0, kb_lo, kb_hi);
        {
            P2_BAR();
            if (tid < 128) { const f32x4* pp = (const f32x4*)((const float*)(a.ws + WS_PART) + (size_t)(tok0 + tid) * 8); const f32x4 p0 = pp[0], p1 = pp[1];
                rstd_l[tid] = __builtin_amdgcn_rsqf((((p0[0] + p0[1]) + (p0[2] + p0[3])) + ((p1[0] + p1[1]) + (p1[2] + p1[3]))) * (1.0f / 1024.0f) + EPS); }
        }
        for (int pr = 0; pr < 4; ++pr) {
        const int hd = 2 * pr + hsel;
        bf16x8 Qf[8]; f32x16 O[4]; float m_run, l_run;
        {
            const char* qb = (const char*)(Qg + (size_t)(tok0 + 32 * qt) * DM + hd * 128); u32x4 raw[8]; float ss = 0.f;
#pragma unroll
            for (int s = 0; s < 8; ++s) raw[s] = ldg16(qb + 32 * s, offQ);
#pragma unroll
            for (int s = 0; s < 8; ++s)
#pragma unroll
                for (int e = 0; e < 4; ++e) { const float lo = bf_lo(raw[s][e]), hi = bf_hi(raw[s][e]); ss += lo * lo + hi * hi; }
            ss = x32_sum(ss);
            const float sc = __builtin_amdgcn_rsqf(ss * (1.0f / 128.0f) + EPS) * (0.08838834764831845f * LOG2E);
            const float* qg = a.in[I_QG] + 8 * h;
#pragma unroll
            for (int s = 0; s < 8; ++s) { const f32x4 g0 = *(const f32x4*)(qg + 16 * s), g1 = *(const f32x4*)(qg + 16 * s + 4); u32x4 w;
                w.x = cvt_pk_bf16(bf_lo(raw[s][0]) * sc * g0[0], bf_hi(raw[s][0]) * sc * g0[1]); w.y = cvt_pk_bf16(bf_lo(raw[s][1]) * sc * g0[2], bf_hi(raw[s][1]) * sc * g0[3]);
                w.z = cvt_pk_bf16(bf_lo(raw[s][2]) * sc * g1[0], bf_hi(raw[s][2]) * sc * g1[1]); w.w = cvt_pk_bf16(bf_lo(raw[s][3]) * sc * g1[2], bf_hi(raw[s][3]) * sc * g1[3]);
                Qf[s] = __builtin_bit_cast(bf16x8, w); }
            m_run = a.in[I_SINK][hd] * LOG2E; l_run = (h == 0) ? 1.0f : 0.0f;
#pragma unroll
            for (int dt = 0; dt < 4; ++dt)
#pragma unroll
                for (int i = 0; i < 16; ++i) O[dt][i] = 0.f;
        }
        for (int kb = kb_lo; kb <= kb_hi; ++kb) {
        if (kb == kb_lo + 1) asm volatile("s_waitcnt vmcnt(0)" ::: "memory");
        P2_BAR();
#pragma unroll
        for (int i = 0; i < 4; ++i) { const u32x4 w = Kraw[i]; float v[8]; float ss = 0.f;
#pragma unroll
            for (int e = 0; e < 4; ++e) { v[2 * e] = bf_lo(w[e]); v[2 * e + 1] = bf_hi(w[e]); ss += v[2 * e] * v[2 * e] + v[2 * e + 1] * v[2 * e + 1]; }
            ss = row16_sum(ss);
            const float sc = __builtin_amdgcn_rsqf(ss * (1.0f / 128.0f) + EPS);
            u32x4 o; o.x = cvt_pk_bf16(v[0] * sc * kg0[0], v[1] * sc * kg0[1]); o.y = cvt_pk_bf16(v[2] * sc * kg0[2], v[3] * sc * kg0[3]);
            o.z = cvt_pk_bf16(v[4] * sc * kg1[0], v[5] * sc * kg1[1]); o.w = cvt_pk_bf16(v[6] * sc * kg1[2], v[7] * sc * kg1[3]);
            *(LAS u32x4*)(lds + R_KT + (srow + 32 * i) * KT_PITCH + sch * 16) = o; }
#pragma unroll
        for (int i = 0; i < 4; ++i) { const u32x4 w = Vraw[i]; LAS u32x2* p = (LAS u32x2*)(lds + R_VT + (srow + 32 * i) * VT_PITCH + sch * 16); p[0] = (u32x2){w.x, w.y}; p[1] = (u32x2){w.z, w.w}; }
        if (kb == kb_lo) {
#pragma unroll
            for (int i = 0; i < 8; ++i) {
                __builtin_amdgcn_global_load_lds((const unsigned*)((const char*)(GVTg + (size_t)(pr * 256 + 32 * i + 4 * wave) * MTOK + tok0) + offGV), (LAS unsigned*)(lds + R_GV + (32 * i + 4 * wave) * 256), 16, 0, 0); } }
        int nunit = unit, npr = pr, nkb = kb + 1, ntok0 = tok0, nkb_lo = kb_lo, nkb_hi = kb_hi;
        if (nkb > kb_hi) { npr = pr + 1; if (npr == 4) { npr = 0; nunit = (uix + 1 < n_my) ? P2_UNIT(uix + 1) : NU; if (nunit < NU) p2_unit_info(nunit, ntok0, nkb_lo, nkb_hi); } nkb = nkb_lo; }
        const bool has_next = nunit < NU;
        if (has_next) P2_PREFETCH(ntok0, npr, nkb);
        P2_BAR();
        {
            const int kt_lo = (kb < 0) ? qt : 0, kt_hi = (kb > 0) ? qt : 3;
            for (int kt = kt_lo; kt <= kt_hi; ++kt) {
                f32x16 s;
#pragma unroll
                for (int i = 0; i < 16; ++i) s[i] = 0.f;
#pragma unroll
                for (int s8 = 0; s8 < 8; ++s8) { const bf16x8 kf = *(const LAS bf16x8*)(lds + R_KT + (32 * kt + c) * KT_PITCH + (16 * s8 + 8 * h) * 2);
                    s = __builtin_amdgcn_mfma_f32_32x32x16_bf16(kf, Qf[s8], s, 0, 0, 0); }
                u32x2 vlo[4], vhi[4];
#pragma unroll
                for (int dt = 0; dt < 2; ++dt)
#pragma unroll
                    for (int s2 = 0; s2 < 2; ++s2) { const LAS unsigned char* vp = lds + R_VT + (32 * dt + c) * VT_PITCH + (32 * kt + 16 * s2 + 4 * h) * 2;
                        vlo[dt * 2 + s2] = *(const LAS u32x2*)vp; vhi[dt * 2 + s2] = *(const LAS u32x2*)(vp + 16); }
                __builtin_amdgcn_sched_barrier(0);
                const LAS float* tbp = tb + hd * TB_N + (kb * 128 + 32 * kt + 4 * h - 32 * qt - c + 160);
                float mx = -3.0e38f;
#pragma unroll
                for (int i = 0; i < 16; ++i) { s[i] += tbp[8 * (i >> 2) + (i & 3)]; mx = fmaxf(mx, s[i]); }
                mx = x32_max(mx);
                const float m_new = fmaxf(m_run, mx), alpha = __builtin_amdgcn_exp2f(m_run - m_new); m_run = m_new;
                float ls = 0.f;
#pragma unroll
                for (int i = 0; i < 16; ++i) { s[i] = __builtin_amdgcn_exp2f(s[i] - m_new); ls += s[i]; }
                l_run = l_run * alpha + ls;
                if (__builtin_amdgcn_ballot_w64(alpha != 1.0f) != 0ull) {
#pragma unroll
                    for (int dt = 0; dt < 4; ++dt)
#pragma unroll
                        for (int i = 0; i < 16; ++i) O[dt][i] *= alpha; }
                bf16x8 Pf[2];
#pragma unroll
                for (int s2 = 0; s2 < 2; ++s2) { u32x4 w; w.x = cvt_pk_bf16(s[8 * s2 + 0], s[8 * s2 + 1]); w.y = cvt_pk_bf16(s[8 * s2 + 2], s[8 * s2 + 3]);
                    w.z = cvt_pk_bf16(s[8 * s2 + 4], s[8 * s2 + 5]); w.w = cvt_pk_bf16(s[8 * s2 + 6], s[8 * s2 + 7]); Pf[s2] = __builtin_bit_cast(bf16x8, w); }
                __builtin_amdgcn_sched_barrier(0);
                u32x2 wlo[4], whi[4];
#pragma unroll
                for (int dt = 2; dt < 4; ++dt)
#pragma unroll
                    for (int s2 = 0; s2 < 2; ++s2) { const LAS unsigned char* vp = lds + R_VT + (32 * dt + c) * VT_PITCH + (32 * kt + 16 * s2 + 4 * h) * 2;
                        wlo[(dt - 2) * 2 + s2] = *(const LAS u32x2*)vp; whi[(dt - 2) * 2 + s2] = *(const LAS u32x2*)(vp + 16); }
#pragma unroll
                for (int dt = 0; dt < 2; ++dt)
#pragma unroll
                    for (int s2 = 0; s2 < 2; ++s2) { const u32x4 w = {vlo[dt * 2 + s2].x, vlo[dt * 2 + s2].y, vhi[dt * 2 + s2].x, vhi[dt * 2 + s2].y};
                        O[dt] = __builtin_amdgcn_mfma_f32_32x32x16_bf16(__builtin_bit_cast(bf16x8, w), Pf[s2], O[dt], 0, 0, 0); }
                __builtin_amdgcn_sched_barrier(0);
#pragma unroll
                for (int dt = 2; dt < 4; ++dt)
#pragma unroll
                    for (int s2 = 0; s2 < 2; ++s2) { const u32x4 w = {wlo[(dt - 2) * 2 + s2].x, wlo[(dt - 2) * 2 + s2].y, whi[(dt - 2) * 2 + s2].x, whi[(dt - 2) * 2 + s2].y};
                        O[dt] = __builtin_amdgcn_mfma_f32_32x32x16_bf16(__builtin_bit_cast(bf16x8, w), Pf[s2], O[dt], 0, 0, 0); }
                __builtin_amdgcn_sched_barrier(0);
            }
        }
        }
        {
            const float inv = __builtin_amdgcn_rcpf(x32_sum(l_run));
            u32x2 t2[4][4];
#pragma unroll
            for (int dt = 0; dt < 4; ++dt)
#pragma unroll
                for (int g4 = 0; g4 < 4; ++g4) { t2[dt][g4].x = cvt_pk_bf16(O[dt][4 * g4] * inv, O[dt][4 * g4 + 1] * inv); t2[dt][g4].y = cvt_pk_bf16(O[dt][4 * g4 + 2] * inv, O[dt][4 * g4 + 3] * inv); }
            bf16x8 Wf[8];
            { const bf16_t* wrow = (const bf16_t*)(a.ws + WS_WSB) + (size_t)(hd * 128 + 32 * qt + c) * 128 + 8 * h;
#pragma unroll
              for (int s8 = 0; s8 < 8; ++s8) { const u32x4 wv = *(const u32x4*)(wrow + 16 * s8);
                  const f32x4 r0 = *(const LAS f32x4*)(rstd_l + 16 * s8 + 8 * h), r1 = *(const LAS f32x4*)(rstd_l + 16 * s8 + 8 * h + 4);
                  u32x4 w; w.x = cvt_pk_bf16(bf_lo(wv.x) * r0[0], bf_hi(wv.x) * r0[1]); w.y = cvt_pk_bf16(bf_lo(wv.y) * r0[2], bf_hi(wv.y) * r0[3]);
                  w.z = cvt_pk_bf16(bf_lo(wv.z) * r1[0], bf_hi(wv.z) * r1[1]); w.w = cvt_pk_bf16(bf_lo(wv.w) * r1[2], bf_hi(wv.w) * r1[3]); Wf[s8] = __builtin_bit_cast(bf16x8, w); } }
            const float bsp = a.in[I_BS][hd * 128 + 32 * qt + c];
            u32x2 t1[4][4];
#pragma unroll
            for (int ct = 0; ct < 4; ++ct) { f32x16 acc;
#pragma unroll
                for (int i = 0; i < 16; ++i) acc[i] = 0.f;
#pragma unroll
                for (int s8 = 0; s8 < 8; ++s8) { const int grow = hsel * 128 + 32 * ct + c; const bf16x8 gf = *(const LAS bf16x8*)(lds + R_GV + grow * 256 + (((2 * s8 + h) ^ (grow & 15)) * 16));
                    acc = __builtin_amdgcn_mfma_f32_32x32x16_bf16(gf, Wf[s8], acc, 0, 0, 0); }
#pragma unroll
                for (int g4 = 0; g4 < 4; ++g4) { const f32x4 gn = *(const f32x4*)(a.in[I_SGUG] + hd * 128 + 32 * ct + 8 * g4 + 4 * h);
                    t1[ct][g4].x = cvt_pk_bf16(acc[4 * g4] * gn[0] + bsp, acc[4 * g4 + 1] * gn[1] + bsp); t1[ct][g4].y = cvt_pk_bf16(acc[4 * g4 + 2] * gn[2] + bsp, acc[4 * g4 + 3] * gn[3] + bsp); } }
            const int tl0 = lane >> 4, ch8 = lane & 15;
            const size_t gu0 = ((size_t)(tok0 + 32 * qt) * DM + hd * 128) * 2;
            __builtin_amdgcn_sched_barrier(0);
            u32x4 cu[4], cb[4];
#pragma unroll
            for (int k = 0; k < 4; ++k) { const size_t go = gu0 + (size_t)(4 * k) * DM * 2; cu[k] = ldg16((const char*)Ug + go, offC); cb[k] = ldg16((const char*)SBg + go, offC); }
            P2_BAR();
            LAS unsigned char* ex = lds + wave * EX_WAVE;
#pragma unroll
            for (int ct = 0; ct < 4; ++ct)
#pragma unroll
                for (int g4 = 0; g4 < 4; ++g4) { const int off = c * KT_PITCH + (32 * ct + 8 * g4 + 4 * h) * 2;
                    *(LAS u32x2*)(ex + off) = t1[ct][g4]; *(LAS u32x2*)(ex + EX_T2 + off) = t2[ct][g4]; }
            asm volatile("s_waitcnt lgkmcnt(0)" ::: "memory");
#pragma unroll
            for (int bt = 0; bt < 2; ++bt) {
                if (bt == 1) {
#pragma unroll
                    for (int k = 0; k < 4; ++k) { const size_t go = gu0 + (size_t)(16 + 4 * k) * DM * 2; cu[k] = ldg16((const char*)Ug + go, offC); cb[k] = ldg16((const char*)SBg + go, offC); } }
#pragma unroll
                for (int k = 0; k < 4; ++k) { const int tl = tl0 + 4 * k + 16 * bt;
                    const u32x4 xu = cu[k], xb = cb[k];
                    const u32x4 a1 = *(const LAS u32x4*)(ex + tl * KT_PITCH + ch8 * 16), a2 = *(const LAS u32x4*)(ex + EX_T2 + tl * KT_PITCH + ch8 * 16);
                    u32x4 o;
#pragma unroll
                    for (int e = 0; e < 4; ++e) {
                        const float lo = bf_lo(xu[e]) * bf_lo(a1[e]) + bf_lo(xb[e]) * bf_lo(a2[e]);
                        const float hi = bf_hi(xu[e]) * bf_hi(a1[e]) + bf_hi(xb[e]) * bf_hi(a2[e]);
                        o[e] = cvt_pk_bf16(lo, hi); }
                    *(u32x4*)((char*)Mout + gu0 + (size_t)(4 * k + 16 * bt) * DM * 2 + offC) = o; }
            }
        }
        }
    }
#undef P2_PREFETCH
#undef P2_UNIT
    __syncthreads();
}


#define XB_TMO      128
#define XB_XCNT(j)  (256  + 64 * (j))
#define XB_XSUB(j)  (1280 + 64 * (j))
#define XB_XGEN(j)  (2304 + 64 * (j))
#define XB_TOP      3328
#define XB_TOPGEN   3392
#define XCD_BAR_WORDS 3456
#define XB_SPIN_CAP (1u << 22)
__device__ __forceinline__ unsigned xb_ld(unsigned* p)              { return __hip_atomic_load(p, __ATOMIC_RELAXED, __HIP_MEMORY_SCOPE_AGENT); }
__device__ __forceinline__ unsigned xb_add(unsigned* p, unsigned v) { return __hip_atomic_fetch_add(p, v, __ATOMIC_RELAXED, __HIP_MEMORY_SCOPE_AGENT); }
__device__ __forceinline__ unsigned xb_xcc_id() { return (unsigned)__builtin_amdgcn_s_getreg((3 << 11) | 20) & 0xFu; }
#define XB_SPIN(cond, bar) do { unsigned _sp = 0; while (cond) { __builtin_amdgcn_s_sleep(1); \
    if ((++_sp & 255u) == 0u) { if (xb_ld(&(bar)[XB_TMO])) break; if (_sp > XB_SPIN_CAP) { atomicAdd(&(bar)[XB_TMO], 1u); break; } } } } while (0)
struct XcdBarrier { unsigned* bar; unsigned x; volatile LAS unsigned* st; };
__device__ __forceinline__ XcdBarrier xcd_barrier_post(unsigned* bar, volatile LAS unsigned* st) {
    XcdBarrier b; b.bar = bar; b.x = xb_xcc_id(); b.st = st;
    if (threadIdx.x == 0) (void)xb_add(&bar[XB_XCNT(b.x)], 1u);
    return b;
}
__device__ __forceinline__ void xcd_barrier_complete(unsigned* bar, unsigned x, unsigned& nloc, unsigned& nx) {
    const unsigned G = gridDim.x * gridDim.y * gridDim.z;
    unsigned sum, cnt, mine, sp = 0u;
    for (;;) {
        sum = 0u; cnt = 0u; mine = 0u;
#pragma unroll
        for (unsigned j = 0; j < 16; ++j) { const unsigned c = xb_ld(&bar[XB_XCNT(j)]); sum += c; cnt += (c > 0u) ? 1u : 0u; mine = (j == x) ? c : mine; }
        if (sum == G) break;
        __builtin_amdgcn_s_sleep(1);
        if ((++sp & 255u) == 0u) { if (xb_ld(&bar[XB_TMO])) break; if (sp > XB_SPIN_CAP) { atomicAdd(&bar[XB_TMO], 1u); break; } }
    }
    nloc = mine > 0u ? mine : 1u; nx = cnt > 0u ? cnt : 1u;
}
__device__ __forceinline__ void xcd_barrier(const XcdBarrier& b) {
    asm volatile("s_waitcnt vmcnt(0)" ::: "memory");
    __syncthreads();
    if (threadIdx.x == 0) {
        unsigned* bar = b.bar;
        __builtin_amdgcn_s_waitcnt(0);
        unsigned nloc = b.st[0], nx = b.st[1];
        if (nloc == 0u) { xcd_barrier_complete(bar, b.x, nloc, nx); b.st[0] = nloc; b.st[1] = nx; }
        const unsigned old = xb_add(&bar[XB_XSUB(b.x)], 1u);
        const unsigned gen = old / nloc;
        if (old + 1u == (gen + 1u) * nloc) {
            __builtin_amdgcn_fence(__ATOMIC_RELEASE, "agent");
            asm volatile("s_waitcnt vmcnt(0)" ::: "memory");
            const unsigned og = xb_add(&bar[XB_TOP], 1u);
            const unsigned tg = og / nx;
            if (og + 1u == (tg + 1u) * nx) xb_add(&bar[XB_TOPGEN], 1u);
            else XB_SPIN(xb_ld(&bar[XB_TOPGEN]) == tg, bar);
            __builtin_amdgcn_fence(__ATOMIC_ACQUIRE, "agent");
            xb_add(&bar[XB_XGEN(b.x)], 1u);
            asm volatile("s_waitcnt vmcnt(0)" ::: "memory");
        } else {
            XB_SPIN(xb_ld(&bar[XB_XGEN(b.x)]) == gen, bar);
            __builtin_amdgcn_fence(__ATOMIC_ACQUIRE, "agent");
            asm volatile("s_waitcnt vmcnt(0)" ::: "memory");
        }
    }
    __syncthreads();
}
__global__ void __launch_bounds__(512, 2) fwd_megakernel(Args a) {
    extern __shared__ __attribute__((aligned(16))) unsigned char shm[];
    LAS unsigned char* lds = (LAS unsigned char*)shm;
    const int tid = threadIdx.x, lane = tid & 63, wave = __builtin_amdgcn_readfirstlane(tid >> 6);
    const int G = gridDim.x, bx = blockIdx.x;
    const int vcu = (G % 8 == 0) ? (bx % 8) * (G / 8) + bx / 8 : bx;
    const int lo = a.ph_lo, hi = a.ph_hi;
#define IN(k) (lo <= (k) && (k) < hi)
#define SEAM(k) do { if (IN(k) && IN((k) + 1)) { xcd_barrier(gbar); } } while (0)
    volatile LAS unsigned* bst = (volatile LAS unsigned*)(lds + LDS_BYTES - 16);
    if (tid == 0) { bst[0] = 0u; bst[1] = 0u; }
    __syncthreads();
    XcdBarrier gbar; gbar.bar = (unsigned*)(a.ws + WS_BAR); gbar.x = 0; gbar.st = bst;
    if (hi - lo > 1) gbar = xcd_barrier_post((unsigned*)(a.ws + WS_BAR), bst);
    if (hi > 100) cg::this_grid().sync();
    if (IN(0)) for (int rep = (PROBE_DUP == 0 ? 0 : 1); rep < 2; ++rep) { p0_phase(lds, a, vcu, G, wave, lane); __syncthreads(); }
    SEAM(0);
    if (IN(1)) for (int rep = (PROBE_DUP == 1 ? 0 : 1); rep < 2; ++rep) {
        pg8::StaticOrder S; S.init(MTOK, NIN, G, bx);
        P1Ptrs P{(const bf16_t*)((unsigned char*)a.out + DO_H), (const bf16_t*)(a.ws + WS_WT)};
        EpiP1 E{a.ws, (unsigned char*)a.out};
        pg8::gemm_phase(lds, DM, S, P, E);
    }
    SEAM(1);
    if (IN(2)) for (int rep = (PROBE_DUP == 2 ? 0 : 1); rep < 2; ++rep) p2_phase(lds, a, vcu, G, rep == 0 ? (bf16_t*)((unsigned char*)a.out + DO_H) : (bf16_t*)(a.ws + WS_U));
    SEAM(2);
    if (IN(3)) for (int rep = (PROBE_DUP == 3 ? 0 : 1); rep < 2; ++rep) {
        pg8::StaticOrder S; S.init(MTOK, DM, G, bx);
        pg8::PlainPtrs P{(const bf16_t*)(a.ws + WS_U), (const bf16_t*)(a.ws + WS_WOT), DM};
        EpiWo E{a.in[I_XP], a.in[I_XS], (bf16_t*)(a.ws + WS_Q), (float*)(a.ws + WS_PART)};
        pg8::gemm_phase(lds, DM, S, P, E);
    }
    SEAM(3);
    if (IN(4)) for (int rep = (PROBE_DUP == 4 ? 0 : 1); rep < 2; ++rep) {
        pg8::StaticOrder S; S.init(MTOK, DFF, G, bx);
        pg8::PlainPtrs P{(const bf16_t*)(a.ws + WS_Q), (const bf16_t*)(a.ws + WS_W1T), DM};
        EpiFF1 E{(bf16_t*)(a.ws + WS_HID)};
        pg8::gemm_phase(lds, DM, S, P, E);
    }
    SEAM(4);
    if (IN(5)) for (int rep = (PROBE_DUP == 5 ? 0 : 1); rep < 2; ++rep) {
        pg8::StaticOrder S; S.init(MTOK, DM, G, bx, 0);
        pg8::PlainPtrs P{(const bf16_t*)(a.ws + WS_HID), (const bf16_t*)(a.ws + WS_W2T), DFF};
        LAS float* tab = (LAS float*)(lds + R_FF2TAB);
        for (int i = 0; i < 8; ++i) { Unit u; if (!S.next(i, u)) break;
            if (tid < 256) { const f32x4* pp = (const f32x4*)((const float*)(a.ws + WS_PART) + (size_t)(u.pm * 256 + tid) * 16); const f32x4 p0 = pp[0], p1 = pp[1], p2 = pp[2], p3 = pp[3];
                const float ss = ((p0[0] + p0[1]) + (p0[2] + p0[3])) + ((p1[0] + p1[1]) + (p1[2] + p1[3])) + ((p2[0] + p2[1]) + (p2[2] + p2[3])) + ((p3[0] + p3[1]) + (p3[2] + p3[3]));
                tab[i * 256 + tid] = __builtin_amdgcn_rcpf(ss * (1.0f / DM) + EPS); } }
        __syncthreads();
        EpiFF2 E{a.out, (const bf16_t*)(a.ws + WS_Q), tab};
        pg8::gemm_phase(lds, DFF, S, P, E);
    }
#undef IN
#undef SEAM
}

extern "C" void kernel_launch(void* const* d_in, const int* in_sizes, int n_in, void* d_out, int out_size, void* d_ws, size_t ws_size, hipStream_t stream) {
    static int grid = 0;
    if (grid == 0) {
        if (n_in != 15 || out_size != MTOK * DM || ws_size < WS_END) { fprintf(stderr, "kernel_launch: unexpected shapes (n_in %d out %d ws %zu)\n", n_in, out_size, ws_size); grid = -1; return; }
        int dev = 0, cus = 0, per_cu = 0;
        hipGetDevice(&dev); hipDeviceGetAttribute(&cus, hipDeviceAttributeMultiprocessorCount, dev);
        if (hipFuncSetAttribute((const void*)fwd_megakernel, hipFuncAttributeMaxDynamicSharedMemorySize, LDS_BYTES) != hipSuccess) { fprintf(stderr, "kernel_launch: hipFuncSetAttribute failed\n"); grid = -1; return; }
        hipOccupancyMaxActiveBlocksPerMultiprocessor(&per_cu, (const void*)fwd_megakernel, 512, LDS_BYTES);
        if (per_cu < 1) { fprintf(stderr, "kernel_launch: occupancy query says %d blocks/CU\n", per_cu); per_cu = 1; }
        (void)hipGetLastError();
        grid = cus * per_cu;
    }
    if (grid < 0) return;
    Args a{};
    for (int i = 0; i < 15; ++i) a.in[i] = (const float*)d_in[i];
    a.out = (float*)d_out; a.ws = (unsigned char*)d_ws;
    if (N_LAUNCHES == 1) {
        a.ph_lo = 0; a.ph_hi = 6;
        if (hipMemsetAsync((unsigned char*)d_ws + WS_BAR, 0, XCD_BAR_WORDS * 4, stream) != hipSuccess) fprintf(stderr, "kernel_launch: memset of the barrier words failed\n");
        void* args[] = {&a};
        hipError_t e = hipLaunchCooperativeKernel((const void*)fwd_megakernel, dim3(grid), dim3(512), args, LDS_BYTES, stream);
        if (e != hipSuccess) fprintf(stderr, "cooperative launch failed: %s (grid %d)\n", hipGetErrorString(e), grid);
    } else {
        for (int p = 0; p < 6; ++p) { a.ph_lo = p; a.ph_hi = p + 1; hipLaunchKernelGGL(fwd_megakernel, dim3(grid), dim3(512), LDS_BYTES, stream, a); }
    }
}
```

```cpp
#include <hip/hip_runtime.h>
#include <hip/hip_cooperative_groups.h>
#include <cstdio>
namespace cg = cooperative_groups;

#define LAS __attribute__((address_space(3)))
typedef unsigned short bf16_t;
typedef short bf16x8 __attribute__((ext_vector_type(8)));
typedef float f32x4 __attribute__((ext_vector_type(4)));
typedef float f32x16 __attribute__((ext_vector_type(16)));
typedef unsigned u32x4 __attribute__((ext_vector_type(4)));
typedef unsigned u32x2 __attribute__((ext_vector_type(2)));

#ifndef PROBE_DUP
#define PROBE_DUP -1
#endif
#ifndef N_LAUNCHES
#define N_LAUNCHES 1
#endif

constexpr int MP = 8 * 4096, MS = 8 * 8192, MTOK = MP + MS;
constexpr int DM = 1024, NIN = 5632, DFF = 4096;
constexpr float EPS = 1e-6f;
constexpr float LOG2E = 1.4426950408889634f;
constexpr size_t MiB = 1u << 20;
constexpr size_t WS_WT = 0, WS_WOT = 12 * MiB, WS_W1T = 14 * MiB, WS_W2T = 22 * MiB;
constexpr size_t WS_Q = 32 * MiB;
constexpr size_t WS_U = 224 * MiB;
constexpr size_t WS_SA = 416 * MiB, WS_SB = 608 * MiB;
constexpr size_t WS_K = 800 * MiB;
constexpr size_t WS_VT = 848 * MiB;
constexpr size_t WS_HID = 224 * MiB;
constexpr size_t WS_PART = 992 * MiB;
constexpr size_t WS_WSB = 31 * MiB;
constexpr size_t WS_BAR = 1000 * MiB;
constexpr size_t WS_END = 1001 * MiB;
constexpr size_t DO_H = 0, DO_GVT = 192 * MiB;

constexpr int KT_PITCH = 272, VT_PITCH = 264;
constexpr int R_KT = 0, R_VT = 34816, R_GV = 68608;
constexpr int EX_WAVE = 17408, EX_T2 = 8704;
constexpr int R_TB = 139264, TB_N = 320, R_RSTD = R_TB + 8 * TB_N * 4, R_RED = R_RSTD + 512;
constexpr int LDS_BYTES = 155648;
static_assert(R_RED + 4096 <= LDS_BYTES, "lds map");

__device__ __forceinline__ unsigned cvt_pk_bf16(float lo, float hi) { unsigned r; asm volatile("v_cvt_pk_bf16_f32 %0, %1, %2" : "=v"(r) : "v"(lo), "v"(hi)); return r; }
__device__ __forceinline__ float bf_lo(unsigned w) { return __uint_as_float(w << 16); }
__device__ __forceinline__ float bf_hi(unsigned w) { return __uint_as_float(w & 0xffff0000u); }
typedef float f32x2 __attribute__((ext_vector_type(2)));
template <int CTRL> __device__ __forceinline__ float dpp(float x) { return __builtin_bit_cast(float, __builtin_amdgcn_mov_dpp(__builtin_bit_cast(int, x), CTRL, 0xf, 0xf, true)); }
__device__ __forceinline__ float row16_sum(float x) { x += dpp<0xB1>(x); x += dpp<0x4E>(x); x += dpp<0x141>(x); x += dpp<0x128>(x); return x; }
__device__ __forceinline__ float x16_sum(float x) { auto s = __builtin_amdgcn_permlane16_swap(__float_as_uint(x), __float_as_uint(x), false, false); return __uint_as_float(s[0]) + __uint_as_float(s[1]); }
__device__ __forceinline__ float x32_sum(float x) { auto s = __builtin_amdgcn_permlane32_swap(__float_as_uint(x), __float_as_uint(x), false, false); return __uint_as_float(s[0]) + __uint_as_float(s[1]); }
__device__ __forceinline__ float x32_max(float x) { auto s = __builtin_amdgcn_permlane32_swap(__float_as_uint(x), __float_as_uint(x), false, false); return fmaxf(__uint_as_float(s[0]), __uint_as_float(s[1])); }
__device__ __forceinline__ f32x2 gelu2(f32x2 x) { const f32x2 u = x * x, p = u * (0.044715f * -2.302208198f) + (-2.302208198f), t = x * p; f32x2 e; e.x = __builtin_amdgcn_exp2f(t.x); e.y = __builtin_amdgcn_exp2f(t.y);
    const f32x2 d = e + 1.0f; f32x2 r; r.x = __builtin_amdgcn_rcpf(d.x); r.y = __builtin_amdgcn_rcpf(d.y); return x * r; }
__device__ __forceinline__ f32x2 sigmoid2(f32x2 x) { const f32x2 t = x * (-LOG2E); f32x2 e; e.x = __builtin_amdgcn_exp2f(t.x); e.y = __builtin_amdgcn_exp2f(t.y);
    const f32x2 d = e + 1.0f; f32x2 r; r.x = __builtin_amdgcn_rcpf(d.x); r.y = __builtin_amdgcn_rcpf(d.y); return r; }
__device__ __forceinline__ float gelu_tanh(float x) { const float t = x * (1.0f + 0.044715f * x * x) * (-2.302208198f); return x * __builtin_amdgcn_rcpf(1.0f + __builtin_amdgcn_exp2f(t)); }
__device__ __forceinline__ float sigmoidf(float x) { return __builtin_amdgcn_rcpf(1.0f + __builtin_amdgcn_exp2f(-LOG2E * x)); }

namespace pg8 {
constexpr int BM = 256, BK = 64, HALF = 128, HTB = HALF * BK * 2, STAGE_BYTES = 8 * HTB, NXCD = 8, WGM = 8;
__host__ __device__ __forceinline__ int lds_byte(int r, int c) { const int st = (r >> 4) * 2 + (c >> 5), rr = r & 15, cc = c & 31, ob = rr * 64 + cc * 2; return st * 1024 + (ob ^ (((ob >> 9) & 1) << 5)); }
__host__ __device__ __forceinline__ void stage_rc(int b, int& R, int& C) { const int st = b / 1024, sb = b % 1024, swz = sb ^ (((sb >> 9) & 1) << 5); R = (st >> 1) * 16 + swz / 64; C = (st & 1) * 32 + (swz % 64) / 2; }
__host__ __device__ __forceinline__ int perm32(int rho) { const int n = rho >> 4, i = rho & 15; return 8 * (i >> 2) + 4 * n + (i & 3); }
struct Unit { int pm, pn; };
struct StaticOrder {
    int nM, nN, nwg, G, c, rev;
    __device__ void init(int M, int N, int G_, int c_, int rev_ = 0) { nM = M / BM; nN = N / BM; nwg = nM * nN; G = G_; c = c_; rev = (rev_ && nwg % G_ == 0) ? nwg / G_ : 0; }
    __device__ bool next(int i, Unit& u) const {
        if (rev && i >= rev) return false;
        const long L = (long)(rev ? rev - 1 - i : i) * G + c; if (L >= nwg) return false;
        int wgid = (int)L; { const int q = nwg / NXCD, r = nwg % NXCD, xcd = wgid % NXCD, off = wgid / NXCD; wgid = (xcd < r ? xcd * (q + 1) : r * (q + 1) + (xcd - r) * q) + off; }
        const int nig = WGM * nN, gid = wgid / nig, fm = gid * WGM, gsz = (nM - fm) < WGM ? (nM - fm) : WGM;
        u.pm = fm + ((wgid % nig) % gsz); u.pn = (wgid % nig) / gsz; return true;
    }
};
struct PlainPtrs { const bf16_t* A; const bf16_t* Bt; int K;
    __device__ __forceinline__ void get(const Unit& u, const char*& a, const char*& b) const { a = (const char*)A + (size_t)u.pm * 512 * K; b = (const char*)Bt + (size_t)u.pn * 512 * K; } };

template <class Epi, class Ptrs>
__device__ __forceinline__ void gemm_phase(LAS unsigned char* lds, const int K, const StaticOrder& S, const Ptrs& P, const Epi& E) {
    const int tid = threadIdx.x, wid = __builtin_amdgcn_readfirstlane(tid >> 6), lane = tid & 63, wr = wid >> 2, wc = wid & 3, fr = lane & 15, fq = lane >> 4;
    const int nt = K / BK;
    unsigned voffA[2], voffB[2];
#pragma unroll
    for (int i = 0; i < 2; ++i) { int R, C; stage_rc(tid * 16 + i * 8192, R, C); const int Rb = (R & ~31) + perm32(R & 31);
        voffA[i] = (unsigned)(R * K + C) * 2u; voffB[i] = (unsigned)(Rb * K + C) * 2u; }
    const size_t kstep = (size_t)(BK * 2);
    const size_t hstep = (size_t)HALF * K * 2;
    const unsigned ldsw = (unsigned)wid * 1024u;
    const int aoff = lds_byte(wr * 64 + fr, fq * 8), boff = lds_byte(wc * 32 + fr, fq * 8);
#define PG8_SA(b, h) (((b) * 2 + (h)) * HTB)
#define PG8_SB(b, h) ((4 + (b) * 2 + (h)) * HTB)
#define PG8_STAGE(bufoff, gbase, voff) do { _Pragma("unroll") for (int _i = 0; _i < 2; ++_i) \
        __builtin_amdgcn_global_load_lds((const unsigned*)((const char*)(gbase) + (voff)[_i]), (LAS unsigned*)(lds + (bufoff) + ldsw + _i * 8192), 16, 0, 0); } while (0)
#define PG8_LDA(dst, b, h) do { _Pragma("unroll") for (int m = 0; m < 4; ++m) _Pragma("unroll") for (int k = 0; k < 2; ++k) dst[m][k] = *(const LAS bf16x8*)(lds + PG8_SA(b, h) + aoff + m * 2048 + k * 1024); } while (0)
#define PG8_LDB(dst, b, h) do { _Pragma("unroll") for (int n = 0; n < 2; ++n) _Pragma("unroll") for (int k = 0; k < 2; ++k) dst[n][k] = *(const LAS bf16x8*)(lds + PG8_SB(b, h) + boff + n * 2048 + k * 1024); } while (0)
#define PG8_MMA(ai, bj, At, Bt) do { __builtin_amdgcn_s_setprio(1); _Pragma("unroll") for (int m = 0; m < 4; ++m) _Pragma("unroll") for (int n = 0; n < 2; ++n) _Pragma("unroll") for (int k = 0; k < 2; ++k) \
        acc[ai][bj][m][n] = __builtin_amdgcn_mfma_f32_16x16x32_bf16(Bt[n][k], At[m][k], acc[ai][bj][m][n], 0, 0, 0); __builtin_amdgcn_s_setprio(0); } while (0)
#define PG8_WAIT_V(n) asm volatile("s_waitcnt vmcnt(" #n ")" ::: "memory")
#define PG8_WAIT_L(n) asm volatile("s_waitcnt lgkmcnt(" #n ")" ::: "memory")
#define PG8_BAR __builtin_amdgcn_s_barrier()
#define PG8_SCHED __builtin_amdgcn_sched_barrier(0)
    Unit cur, nxt; int ui = 0;
    if (!S.next(0, cur)) return;
    f32x4 acc[2][2][4][2];
#pragma unroll
    for (int a = 0; a < 2; ++a)
#pragma unroll
        for (int b = 0; b < 2; ++b)
#pragma unroll
            for (int m = 0; m < 4; ++m)
#pragma unroll
                for (int n = 0; n < 2; ++n) acc[a][b][m][n] = (f32x4){0.f, 0.f, 0.f, 0.f};
    bf16x8 At[4][2], B0[2][2], B1[2][2];
    const char* cA; const char* cB; P.get(cur, cA, cB);
    PG8_STAGE(PG8_SB(0, 0), cB, voffB); PG8_STAGE(PG8_SA(0, 0), cA, voffA); PG8_STAGE(PG8_SB(0, 1), cB + hstep, voffB); PG8_STAGE(PG8_SA(0, 1), cA + hstep, voffA);
    if (wr == 1) PG8_BAR;
    PG8_WAIT_V(4); PG8_BAR;
    PG8_STAGE(PG8_SB(1, 0), cB + kstep, voffB); PG8_STAGE(PG8_SA(1, 0), cA + kstep, voffA); PG8_STAGE(PG8_SB(1, 1), cB + hstep + kstep, voffB);
    PG8_WAIT_V(6); PG8_BAR;
    for (;;) {
        const bool has_next = S.next(ui + 1, nxt);
        const char* nA = cA; const char* nB = cB; if (has_next) P.get(nxt, nA, nB);
        for (int t = 0; t < nt; t += 2) {
            const bool last = (t == nt - 2);
            const char* a1 = cA + (size_t)(t + 1) * kstep;
            const char* a2 = last ? nA : cA + (size_t)(t + 2) * kstep; const char* b2 = last ? nB : cB + (size_t)(t + 2) * kstep;
            const char* a3 = a2 + kstep; const char* b3 = b2 + kstep;
            PG8_LDB(B0, 0, 0); PG8_SCHED; PG8_LDA(At, 0, 0); PG8_STAGE(PG8_SA(1, 1), a1 + hstep, voffA);
            PG8_WAIT_L(8); PG8_BAR; PG8_WAIT_L(0); PG8_MMA(0, 0, At, B0); PG8_BAR; PG8_SCHED;
            PG8_LDB(B1, 0, 1); PG8_STAGE(PG8_SB(0, 0), b2, voffB);
            PG8_BAR; PG8_WAIT_L(0); PG8_MMA(0, 1, At, B1); PG8_BAR;
            PG8_LDA(At, 0, 1); PG8_STAGE(PG8_SA(0, 0), a2, voffA);
            PG8_BAR; PG8_WAIT_L(0); PG8_MMA(1, 0, At, B0); PG8_BAR; PG8_SCHED;
            PG8_STAGE(PG8_SB(0, 1), b2 + hstep, voffB);
            PG8_WAIT_V(6); PG8_BAR; PG8_MMA(1, 1, At, B1); PG8_BAR;
            PG8_LDB(B0, 1, 0); PG8_SCHED; PG8_LDA(At, 1, 0); PG8_STAGE(PG8_SA(0, 1), a2 + hstep, voffA);
            PG8_WAIT_L(8); PG8_BAR; PG8_WAIT_L(0); PG8_MMA(0, 0, At, B0); PG8_BAR; PG8_SCHED;
            PG8_LDB(B1, 1, 1); PG8_STAGE(PG8_SB(1, 0), b3, voffB);
            PG8_BAR; PG8_WAIT_L(0); PG8_MMA(0, 1, At, B1); PG8_BAR;
            PG8_LDA(At, 1, 1); PG8_STAGE(PG8_SA(1, 0), a3, voffA);
            PG8_BAR; PG8_WAIT_L(0); PG8_MMA(1, 0, At, B0); PG8_BAR; PG8_SCHED;
            PG8_STAGE(PG8_SB(1, 1), b3 + hstep, voffB);
            PG8_WAIT_V(6); PG8_BAR; PG8_MMA(1, 1, At, B1); PG8_BAR;
        }
        E(acc, cur, ui, wr, wc, fr, fq);
        if (!has_next) break;
#pragma unroll
        for (int a = 0; a < 2; ++a)
#pragma unroll
            for (int b = 0; b < 2; ++b)
#pragma unroll
                for (int m = 0; m < 4; ++m)
#pragma unroll
                    for (int n = 0; n < 2; ++n) acc[a][b][m][n] = (f32x4){0.f, 0.f, 0.f, 0.f};
        cur = nxt; cA = nA; cB = nB; ++ui;
    }
    PG8_WAIT_V(0);
    if (wr == 0) PG8_BAR;
    PG8_BAR;
#undef PG8_SA
#undef PG8_SB
#undef PG8_STAGE
#undef PG8_LDA
#undef PG8_LDB
#undef PG8_MMA
#undef PG8_WAIT_V
#undef PG8_WAIT_L
#undef PG8_BAR
#undef PG8_SCHED
}
}
using pg8::Unit;

struct Args { const float* in[15]; float* out; unsigned char* ws; int ph_lo, ph_hi; };
enum { I_XP = 0, I_XS, I_RELB, I_N1G, I_WIN, I_SGUG, I_WS, I_BS, I_QG, I_KG, I_SINK, I_WO, I_N2G, I_W1, I_W2 };

struct P1Ptrs { const bf16_t* H; const bf16_t* Wt;
    __device__ __forceinline__ void get(const Unit& u, const char*& a, const char*& b) const {
        const char* hp = (const char*)H + (size_t)u.pm * 512 * DM; const char* wp = (const char*)Wt + (size_t)u.pn * 512 * DM;
        if (u.pn < 17) { a = hp; b = wp; } else { a = wp; b = hp; } } };
__device__ __forceinline__ u32x4 pack8(f32x4 v0, f32x4 v1) { u32x4 w; w.x = cvt_pk_bf16(v0[0], v0[1]); w.y = cvt_pk_bf16(v0[2], v0[3]); w.z = cvt_pk_bf16(v1[0], v1[1]); w.w = cvt_pk_bf16(v1[2], v1[3]); return w; }
__device__ __forceinline__ f32x2 g1_2(f32x2 x, f32x2 g) { const f32x2 u = x * x, p = u * (0.044715f * -2.302208198f) + (-2.302208198f), t = x * p, tg = g * (-LOG2E);
    f32x2 e1, e2; e1.x = __builtin_amdgcn_exp2f(t.x); e1.y = __builtin_amdgcn_exp2f(t.y); e2.x = __builtin_amdgcn_exp2f(tg.x); e2.y = __builtin_amdgcn_exp2f(tg.y);
    const f32x2 d = (e1 + 1.0f) * (e2 + 1.0f); f32x2 r; r.x = __builtin_amdgcn_rcpf(d.x); r.y = __builtin_amdgcn_rcpf(d.y); return x * r; }
__device__ __forceinline__ f32x4 g1_4(f32x4 v, f32x4 g) { const f32x2 a = g1_2((f32x2){v[0], v[1]}, (f32x2){g[0], g[1]}), b = g1_2((f32x2){v[2], v[3]}, (f32x2){g[2], g[3]}); return (f32x4){a.x, a.y, b.x, b.y}; }
__device__ __forceinline__ f32x4 gelu4(f32x4 v) { const f32x2 a = gelu2((f32x2){v[0], v[1]}), b = gelu2((f32x2){v[2], v[3]}); return (f32x4){a.x, a.y, b.x, b.y}; }
__device__ __forceinline__ f32x4 sigmoid4(f32x4 v) { const f32x2 a = sigmoid2((f32x2){v[0], v[1]}), b = sigmoid2((f32x2){v[2], v[3]}); return (f32x4){a.x, a.y, b.x, b.y}; }
struct EpiP1 {
    unsigned char* ws; unsigned char* dout;
    __device__ __forceinline__ void operator()(const f32x4 (&acc)[2][2][4][2], const Unit& u, int ui, int wr, int wc, int fr, int fq) const {
        const int pn = u.pn;
        if (pn < 8) {
            bf16_t* base = (bf16_t*)(ws + WS_U) + (size_t)(u.pm * 256 + wr * 64 + fr) * DM + pn * 128 + wc * 32 + 8 * fq;
#pragma unroll
            for (int ai = 0; ai < 2; ++ai)
#pragma unroll
                for (int m = 0; m < 4; ++m) {
                    const f32x4 g0 = g1_4(acc[ai][0][m][0], acc[ai][1][m][0]), g1 = g1_4(acc[ai][0][m][1], acc[ai][1][m][1]);
                    *(u32x4*)(base + (size_t)(ai * 128 + m * 16) * DM) = pack8(g0, g1); }
            return; }
        if (pn >= 17 && pn < 21) {
            bf16_t* base = (bf16_t*)(dout + DO_GVT) + (size_t)((pn - 17) * 256 + wr * 64 + fr) * MTOK + u.pm * 256 + wc * 32 + 8 * fq;
            float* pp = (float*)(ws + WS_PART) + (size_t)(u.pm * 256 + wc * 32 + 8 * fq) * 8 + (pn - 17) * 2 + wr;
#pragma unroll
            for (int bj = 0; bj < 2; ++bj) { f32x4 sq0 = {0.f, 0.f, 0.f, 0.f}, sq1 = {0.f, 0.f, 0.f, 0.f};
#pragma unroll
                for (int ai = 0; ai < 2; ++ai)
#pragma unroll
                    for (int m = 0; m < 4; ++m) { const f32x4 g0 = gelu4(acc[ai][bj][m][0]), g1 = gelu4(acc[ai][bj][m][1]);
                        sq0 += g0 * g0; sq1 += g1 * g1;
                        *(u32x4*)(base + (size_t)(ai * 128 + m * 16) * MTOK + bj * 128) = pack8(g0, g1); }
#pragma unroll
                for (int j = 0; j < 4; ++j) { const float t0 = row16_sum(sq0[j]), t1 = row16_sum(sq1[j]); if (fr == 0) { pp[(size_t)(bj * 128 + j) * 8] = t0; pp[(size_t)(bj * 128 + 4 + j) * 8] = t1; } } }
            return; }
        bf16_t* base; size_t ld; int row0, col0, act;
        if (pn < 12)      { base = (bf16_t*)(ws + WS_Q);  ld = DM;  row0 = u.pm * 256; col0 = (pn - 8) * 256;  act = 0; }
        else if (pn < 13) { base = (bf16_t*)(ws + WS_K);  ld = 256; row0 = u.pm * 256; col0 = 0;               act = 0; }
        else if (pn < 17) { base = (bf16_t*)(ws + WS_SB); ld = DM;  row0 = u.pm * 256; col0 = (pn - 13) * 256; act = 2; }
        else              { base = (bf16_t*)(ws + WS_VT); ld = MTOK; row0 = 0; col0 = u.pm * 256; act = 0; }
        const int r0 = row0 + wr * 64 + fr, c0 = col0 + wc * 32 + 8 * fq;
#pragma unroll
        for (int ai = 0; ai < 2; ++ai)
#pragma unroll
            for (int m = 0; m < 4; ++m) { bf16_t* rowp = base + (size_t)(r0 + ai * 128 + m * 16) * ld + c0;
#pragma unroll
                for (int bj = 0; bj < 2; ++bj) { f32x4 v0 = acc[ai][bj][m][0], v1 = acc[ai][bj][m][1];
                    if (act == 2) { v0 = sigmoid4(v0); v1 = sigmoid4(v1); }
                    *(u32x4*)(rowp + bj * 128) = pack8(v0, v1); } }
    }
};
struct EpiWo {
    const float* xp; const float* xs; bf16_t* xb; float* part;
    __device__ __forceinline__ void operator()(const f32x4 (&acc)[2][2][4][2], const Unit& u, int ui, int wr, int wc, int fr, int fq) const {
        const int row0 = u.pm * 256 + wr * 64 + fr, col0 = u.pn * 256 + wc * 32 + 8 * fq;
        const float* xb0 = (u.pm * 256 < MP) ? xp : xs - (size_t)MP * DM;
#pragma unroll
        for (int ai = 0; ai < 2; ++ai) {
            f32x4 xv[4][2][2];
#pragma unroll
            for (int m = 0; m < 4; ++m)
#pragma unroll
                for (int bj = 0; bj < 2; ++bj) { const float* p = xb0 + (size_t)(row0 + ai * 128 + m * 16) * DM + col0 + bj * 128; xv[m][bj][0] = *(const f32x4*)p; xv[m][bj][1] = *(const f32x4*)(p + 4); }
#pragma unroll
            for (int m = 0; m < 4; ++m) { const int row = row0 + ai * 128 + m * 16; const size_t off = (size_t)row * DM + col0; float ss = 0.f;
#pragma unroll
                for (int bj = 0; bj < 2; ++bj) {
                    const f32x4 v0 = acc[ai][bj][m][0] + xv[m][bj][0], v1 = acc[ai][bj][m][1] + xv[m][bj][1];
                    u32x4 w; w.x = cvt_pk_bf16(v0[0], v0[1]); w.y = cvt_pk_bf16(v0[2], v0[3]); w.z = cvt_pk_bf16(v1[0], v1[1]); w.w = cvt_pk_bf16(v1[2], v1[3]);
                    *(u32x4*)(xb + off + bj * 128) = w;
                    ss += (v0[0] * v0[0] + v0[1] * v0[1]) + (v0[2] * v0[2] + v0[3] * v0[3]) + (v1[0] * v1[0] + v1[1] * v1[1]) + (v1[2] * v1[2] + v1[3] * v1[3]); }
                ss = x32_sum(x16_sum(ss));
                if (fq == 0) part[(size_t)row * 16 + u.pn * 4 + wc] = ss; }
        }
    }
};
struct EpiFF1 {
    bf16_t* hid;
    __device__ __forceinline__ void operator()(const f32x4 (&acc)[2][2][4][2], const Unit& u, int ui, int wr, int wc, int fr, int fq) const {
        const int row0 = u.pm * 256 + wr * 64 + fr, col0 = u.pn * 256 + wc * 32 + 8 * fq;
#pragma unroll
        for (int ai = 0; ai < 2; ++ai)
#pragma unroll
            for (int m = 0; m < 4; ++m) { bf16_t* rowp = hid + (size_t)(row0 + ai * 128 + m * 16) * DFF + col0;
#pragma unroll
                for (int bj = 0; bj < 2; ++bj) { f32x4 v0 = acc[ai][bj][m][0], v1 = acc[ai][bj][m][1];
#pragma unroll
                    for (int j = 0; j < 4; ++j) { const float a = fmaxf(v0[j], 0.f), b = fmaxf(v1[j], 0.f); v0[j] = a * a; v1[j] = b * b; }
                    u32x4 w; w.x = cvt_pk_bf16(v0[0], v0[1]); w.y = cvt_pk_bf16(v0[2], v0[3]); w.z = cvt_pk_bf16(v1[0], v1[1]); w.w = cvt_pk_bf16(v1[2], v1[3]);
                    *(u32x4*)(rowp + bj * 128) = w; } }
    }
};
constexpr int R_FF2TAB = 131072;
struct EpiFF2 {
    float* out; const bf16_t* xb; const LAS float* tab;
    __device__ __forceinline__ void operator()(const f32x4 (&acc)[2][2][4][2], const Unit& u, int ui, int wr, int wc, int fr, int fq) const {
        const int rl0 = wr * 64 + fr, col0 = u.pn * 256 + wc * 32 + 8 * fq;
        u32x4 xv[2][4][2];
#pragma unroll
        for (int ai = 0; ai < 2; ++ai)
#pragma unroll
            for (int m = 0; m < 4; ++m)
#pragma unroll
                for (int bj = 0; bj < 2; ++bj) xv[ai][m][bj] = *(const u32x4*)(xb + (size_t)(u.pm * 256 + rl0 + ai * 128 + m * 16) * DM + col0 + bj * 128);
#pragma unroll
        for (int ai = 0; ai < 2; ++ai)
#pragma unroll
            for (int m = 0; m < 4; ++m) { const int rl = rl0 + ai * 128 + m * 16; float* rowp = out + (size_t)(u.pm * 256 + rl) * DM + col0;
                const float r2 = tab[ui * 256 + rl];
#pragma unroll
                for (int bj = 0; bj < 2; ++bj) { const u32x4 x = xv[ai][m][bj];
                    const f32x4 x0 = {bf_lo(x.x), bf_hi(x.x), bf_lo(x.y), bf_hi(x.y)}, x1 = {bf_lo(x.z), bf_hi(x.z), bf_lo(x.w), bf_hi(x.w)};
                    *(f32x4*)(rowp + bj * 128) = acc[ai][bj][m][0] * r2 + x0; *(f32x4*)(rowp + bj * 128 + 4) = acc[ai][bj][m][1] * r2 + x1; } }
    }
};

__device__ __forceinline__ void p0_transpose_blk(const float* W, int ldw, const float* kscale, bf16_t* WT, int K, int k0, int n0src, int n0dst, LAS float* scr, int lane) {
    float wv[32];
#pragma unroll
    for (int i = 0; i < 32; ++i) wv[i] = W[(size_t)(k0 + 2 * i + (lane >> 5)) * ldw + n0src + (lane & 31)];
    if (kscale) {
#pragma unroll
        for (int i = 0; i < 32; ++i) wv[i] *= kscale[k0 + 2 * i + (lane >> 5)]; }
#pragma unroll
    for (int i = 0; i < 32; ++i) scr[(2 * i + (lane >> 5)) * 33 + (lane & 31)] = wv[i];
    asm volatile("s_waitcnt lgkmcnt(0)" ::: "memory");
    const int c = lane & 7;
#pragma unroll
    for (int j = 0; j < 4; ++j) { const int n = (lane >> 3) + 8 * j; const LAS float* s = scr + (8 * c) * 33 + n;
        u32x4 o; o.x = cvt_pk_bf16(s[0 * 33], s[1 * 33]); o.y = cvt_pk_bf16(s[2 * 33], s[3 * 33]); o.z = cvt_pk_bf16(s[4 * 33], s[5 * 33]); o.w = cvt_pk_bf16(s[6 * 33], s[7 * 33]);
        *(u32x4*)(WT + (size_t)(n0dst + n) * K + k0 + 8 * c) = o; }
    asm volatile("s_waitcnt lgkmcnt(0)" ::: "memory");
}
__device__ __forceinline__ int win_src_col(int d) {
    if (d < 2048) { const int j = d >> 8, w = d & 255; return w < 128 ? 128 * j + w : 3584 + 128 * j + (w - 128); }
    if (d < 3072) return 2048 + (d - 2048);
    if (d < 3328) return 3072 + (d - 3072);
    if (d < 4352) return 4608 + (d - 3328);
    if (d < 5376) return 1024 + (d - 4352);
    return 3328 + (d - 5376);
}
__device__ __forceinline__ float wave_sum(float v) { return x32_sum(x16_sum(row16_sum(v))); }
__device__ __forceinline__ void p0_phase(LAS unsigned char* lds, const Args& a, int vcu, int G, int wave, int lane) {
    LAS float* scr = (LAS float*)(lds + wave * 16384);
    const int gw = vcu * 8 + wave, NGW = G * 8;
    bf16_t* Wt = (bf16_t*)(a.ws + WS_WT);
    const float* win = a.in[I_WIN];
    constexpr int I_IN = 16 * (NIN / 32), I_O = 16 * 32, I_1 = 16 * (DFF / 32), I_2 = 64 * 32;
    for (int it = gw; it < I_IN + I_O + I_1 + I_2; it += NGW) {
        int r = it;
        if (r < I_IN) { const int kb = r / (NIN / 32), nb = r % (NIN / 32); p0_transpose_blk(win, NIN, nullptr, Wt, DM, 64 * kb, win_src_col(32 * nb), 32 * nb, scr, lane); continue; }
        r -= I_IN;
        if (r < I_O) { const int kb = r / 32, nb = r % 32; p0_transpose_blk(a.in[I_WO], DM, nullptr, (bf16_t*)(a.ws + WS_WOT), DM, 64 * kb, 32 * nb, 32 * nb, scr, lane); continue; } r -= I_O;
        if (r < I_1) { const int kb = r / 128, nb = r % 128; p0_transpose_blk(a.in[I_W1], DFF, a.in[I_N2G], (bf16_t*)(a.ws + WS_W1T), DM, 64 * kb, 32 * nb, 32 * nb, scr, lane); continue; } r -= I_1;
        { const int kb = r / 32, nb = r % 32; p0_transpose_blk(a.in[I_W2], DM, nullptr, (bf16_t*)(a.ws + WS_W2T), DFF, 64 * kb, 32 * nb, 32 * nb, scr, lane); }
    }
    { const int gt = gw * 64 + lane; if (gt < 8 * 128 * 128 / 8) { const f32x4 w0 = ((const f32x4*)a.in[I_WS])[2 * gt], w1 = ((const f32x4*)a.in[I_WS])[2 * gt + 1]; ((u32x4*)(a.ws + WS_WSB))[gt] = pack8(w0, w1); } }
    bf16_t* H = (bf16_t*)((unsigned char*)a.out + DO_H);
    const f32x4* g4 = (const f32x4*)a.in[I_N1G] + lane;
    f32x4 g[4];
#pragma unroll
    for (int j = 0; j < 4; ++j) g[j] = g4[64 * j];
    for (int m = gw; m < MTOK; m += NGW) {
        const float* xrow = (m < MP) ? a.in[I_XP] + (size_t)m * DM : a.in[I_XS] + (size_t)(m - MP) * DM;
        const f32x4* xr = (const f32x4*)xrow + lane;
        f32x4 v[4]; float s = 0.f;
#pragma unroll
        for (int j = 0; j < 4; ++j) { v[j] = xr[64 * j]; s += (v[j].x * v[j].x + v[j].y * v[j].y) + (v[j].z * v[j].z + v[j].w * v[j].w); }
        const float rstd = __builtin_amdgcn_rsqf(wave_sum(s) * (1.f / DM) + EPS);
        u32x2* o8 = (u32x2*)(H + (size_t)m * DM) + lane;
#pragma unroll
        for (int j = 0; j < 4; ++j) { const f32x4 y = v[j] * rstd * g[j]; u32x2 w; w.x = cvt_pk_bf16(y.x, y.y); w.y = cvt_pk_bf16(y.z, y.w); o8[64 * j] = w; }
    }
}

__device__ __forceinline__ int t5_bucket(int rel) {
    const int n = rel < 0 ? -rel : rel; int b = rel > 0 ? 16 : 0;
    if (n < 8) return b + n;
    int k = (n >= 12) + (n >= 16) + (n >= 23) + (n >= 32) + (n >= 46) + (n >= 64) + (n >= 91);
    return b + 8 + k;
}
__device__ __forceinline__ u32x4 ldg16(const void* ubase, unsigned voff) { return *(const u32x4*)((const char*)ubase + voff); }
__device__ __forceinline__ void p2_unit_info(int unit, int& tok0, int& kb_lo, int& kb_hi) {
    tok0 = unit * 128; int n, nblk; if (unit < MP / 128) { n = unit & 31; nblk = 32; } else { n = (unit - MP / 128) & 63; nblk = 64; }
    kb_lo = (n > 0) ? -1 : 0; kb_hi = (n < nblk - 1) ? 1 : 0;
}
__device__ __forceinline__ void p2_build_bias_table(LAS unsigned char* lds, const Args& a) {
    LAS float* tb = (LAS float*)(lds + R_TB);
    for (int i = threadIdx.x; i < 8 * TB_N; i += 512) { const int hd = i / TB_N, rel = (i % TB_N) - 160; const int ar = rel < 0 ? -rel : rel;
        tb[i] = (ar <= 128) ? a.in[I_RELB][t5_bucket(rel) * 8 + hd] * LOG2E : -1e30f; }
}
#define P2_BAR() do { asm volatile("s_waitcnt lgkmcnt(0)" ::: "memory"); __builtin_amdgcn_s_barrier(); asm volatile("" ::: "memory"); } while (0)
__device__ __forceinline__ void p2_phase(LAS unsigned char* lds, const Args& a, int vcu, int G, bf16_t* Mout) {
    const int tid = threadIdx.x, wave = __builtin_amdgcn_readfirstlane(tid >> 6), lane = tid & 63, c = lane & 31, h = lane >> 5;
    const int hsel = wave >> 2, qt = hsel ? 3 - (wave & 3) : (wave & 3);
    const bf16_t* Qg = (const bf16_t*)(a.ws + WS_Q); const bf16_t* Kg = (const bf16_t*)(a.ws + WS_K); const bf16_t* VTg = (const bf16_t*)(a.ws + WS_VT);
    const bf16_t* GVTg = (const bf16_t*)((unsigned char*)a.out + DO_GVT);
    const bf16_t* Ug = (const bf16_t*)(a.ws + WS_U); const bf16_t* SBg = (const bf16_t*)(a.ws + WS_SB);
    LAS float* tb = (LAS float*)(lds + R_TB); LAS float* rstd_l = (LAS float*)(lds + R_RSTD); LAS float* red = (LAS float*)(lds + R_RED);
    constexpr int NU = MTOK / 128;
    const int bxg = blockIdx.x;
    const bool ord256 = (G == 256);
    const int n_my = ord256 ? 3 : (vcu < NU ? (NU - 1 - vcu) / G + 1 : 0);
#define P2_UNIT(i) (ord256 ? 96 * (bxg & 7) + 95 - ((bxg >> 3) + 32 * (i)) : vcu + G * (i))
    if (n_my == 0) { P2_BAR(); return; }
    const int srow = tid >> 4, sch = tid & 15;
    const f32x4 kg0 = *(const f32x4*)(a.in[I_KG] + sch * 8), kg1 = *(const f32x4*)(a.in[I_KG] + sch * 8 + 4);
    u32x4 Kraw[4], Vraw[4];
    const unsigned offK = (unsigned)(srow * 256 + sch * 8) * 2u, offV = (unsigned)(srow * MTOK + sch * 8) * 2u;
    const unsigned offGV = (unsigned)((lane >> 4) * MTOK + (((lane & 15) ^ ((4 * wave + (lane >> 4)) & 15)) * 8)) * 2u;
    const unsigned offQ = (unsigned)(c * DM + 8 * h) * 2u, offP0 = (unsigned)((tid >> 4) * MTOK + 8 * (tid & 15)) * 2u, offC = (unsigned)((lane >> 4) * DM + (lane & 15) * 8) * 2u;
#define P2_PREFETCH(u_tok0, u_pr, u_kb) do { const int _kt0 = (u_tok0) + (u_kb) * 128, _kvh = (u_pr) >> 1; \
        const char* _kb0 = (const char*)(Kg + (size_t)_kt0 * 256 + _kvh * 128); const char* _vb0 = (const char*)(VTg + (size_t)(_kvh * 128) * MTOK + _kt0); \
        _Pragma("unroll") for (int i = 0; i < 4; ++i) Kraw[i] = ldg16(_kb0 + (size_t)i * (32 * 256 * 2), offK); \
        _Pragma("unroll") for (int i = 0; i < 4; ++i) Vraw[i] = ldg16(_vb0 + (size_t)i * ((size_t)32 * MTOK * 2), offV); } while (0)
    { int t0_, lo_, hi_; p2_unit_info(P2_UNIT(0), t0_, lo_, hi_); P2_PREFETCH(t0_, 0, lo_); }
    for (int uix = 0; uix < n_my; ++uix) { const int unit = P2_UNIT(uix);
        int tok0, kb_lo, kb_hi; p2_unit_info(unit, tok0, kb_lo, kb_hi);
        {
            P2_BAR();
            if (tid < 128) { const f32x4* pp = (const f32x4*)((const float*)(a.ws + WS_PART) + (size_t)(tok0 + tid) * 8); const f32x4 p0 = pp[0], p1 = pp[1];
                rstd_l[tid] = __builtin_amdgcn_rsqf((((p0[0] + p0[1]) + (p0[2] + p0[3])) + ((p1[0] + p1[1]) + (p1[2] + p1[3]))) * (1.0f / 1024.0f) + EPS); }
        }
        for (int pr = 0; pr < 4; ++pr) {
        const int hd = 2 * pr + hsel;
        bf16x8 Qf[8]; f32x16 O[4]; float m_run, l_run;
        {
            const char* qb = (const char*)(Qg + (size_t)(tok0 + 32 * qt) * DM + hd * 128); u32x4 raw[8]; float ss = 0.f;
#pragma unroll
            for (int s = 0; s < 8; ++s) raw[s] = ldg16(qb + 32 * s, offQ);
#pragma unroll
            for (int s = 0; s < 8; ++s)
#pragma unroll
                for (int e = 0; e < 4; ++e) { const float lo = bf_lo(raw[s][e]), hi = bf_hi(raw[s][e]); ss += lo * lo + hi * hi; }
            ss = x32_sum(ss);
            const float sc = __builtin_amdgcn_rsqf(ss * (1.0f / 128.0f) + EPS) * (0.08838834764831845f * LOG2E);
            const float* qg = a.in[I_QG] + 8 * h;
#pragma unroll
            for (int s = 0; s < 8; ++s) { const f32x4 g0 = *(const f32x4*)(qg + 16 * s), g1 = *(const f32x4*)(qg + 16 * s + 4); u32x4 w;
                w.x = cvt_pk_bf16(bf_lo(raw[s][0]) * sc * g0[0], bf_hi(raw[s][0]) * sc * g0[1]); w.y = cvt_pk_bf16(bf_lo(raw[s][1]) * sc * g0[2], bf_hi(raw[s][1]) * sc * g0[3]);
                w.z = cvt_pk_bf16(bf_lo(raw[s][2]) * sc * g1[0], bf_hi(raw[s][2]) * sc * g1[1]); w.w = cvt_pk_bf16(bf_lo(raw[s][3]) * sc * g1[2], bf_hi(raw[s][3]) * sc * g1[3]);
                Qf[s] = __builtin_bit_cast(bf16x8, w); }
            m_run = a.in[I_SINK][hd] * LOG2E; l_run = (h == 0) ? 1.0f : 0.0f;
#pragma unroll
            for (int dt = 0; dt < 4; ++dt)
#pragma unroll
                for (int i = 0; i < 16; ++i) O[dt][i] = 0.f;
        }
        for (int kb = kb_lo; kb <= kb_hi; ++kb) {
        if (kb == kb_lo + 1) asm volatile("s_waitcnt vmcnt(0)" ::: "memory");
        P2_BAR();
#pragma unroll
        for (int i = 0; i < 4; ++i) { const u32x4 w = Kraw[i]; float v[8]; float ss = 0.f;
#pragma unroll
            for (int e = 0; e < 4; ++e) { v[2 * e] = bf_lo(w[e]); v[2 * e + 1] = bf_hi(w[e]); ss += v[2 * e] * v[2 * e] + v[2 * e + 1] * v[2 * e + 1]; }
            ss = row16_sum(ss);
            const float sc = __builtin_amdgcn_rsqf(ss * (1.0f / 128.0f) + EPS);
            u32x4 o; o.x = cvt_pk_bf16(v[0] * sc * kg0[0], v[1] * sc * kg0[1]); o.y = cvt_pk_bf16(v[2] * sc * kg0[2], v[3] * sc * kg0[3]);
            o.z = cvt_pk_bf16(v[4] * sc * kg1[0], v[5] * sc * kg1[1]); o.w = cvt_pk_bf16(v[6] * sc * kg1[2], v[7] * sc * kg1[3]);
            *(LAS u32x4*)(lds + R_KT + (srow + 32 * i) * KT_PITCH + sch * 16) = o; }
#pragma unroll
        for (int i = 0; i < 4; ++i) { const u32x4 w = Vraw[i]; LAS u32x2* p = (LAS u32x2*)(lds + R_VT + (srow + 32 * i) * VT_PITCH + sch * 16); p[0] = (u32x2){w.x, w.y}; p[1] = (u32x2){w.z, w.w}; }
        if (kb == kb_lo) {
#pragma unroll
            for (int i = 0; i < 8; ++i) {
                __builtin_amdgcn_global_load_lds((const unsigned*)((const char*)(GVTg + (size_t)(pr * 256 + 32 * i + 4 * wave) * MTOK + tok0) + offGV), (LAS unsigned*)(lds + R_GV + (32 * i + 4 * wave) * 256), 16, 0, 0); } }
        int nunit = unit, npr = pr, nkb = kb + 1, ntok0 = tok0, nkb_lo = kb_lo, nkb_hi = kb_hi;
        if (nkb > kb_hi) { npr = pr + 1; if (npr == 4) { npr = 0; nunit = (uix + 1 < n_my) ? P2_UNIT(uix + 1) : NU; if (nunit < NU) p2_unit_info(nunit, ntok0, nkb_lo, nkb_hi); } nkb = nkb_lo; }
        const bool has_next = nunit < NU;
        if (has_next) P2_PREFETCH(ntok0, npr, nkb);
        P2_BAR();
        {
            const int kt_lo = (kb < 0) ? qt : 0, kt_hi = (kb > 0) ? qt : 3;
            for (int kt = kt_lo; kt <= kt_hi; ++kt) {
                f32x16 s;
#pragma unroll
                for (int i = 0; i < 16; ++i) s[i] = 0.f;
#pragma unroll
                for (int s8 = 0; s8 < 8; ++s8) { const bf16x8 kf = *(const LAS bf16x8*)(lds + R_KT + (32 * kt + c) * KT_PITCH + (16 * s8 + 8 * h) * 2);
                    s = __builtin_amdgcn_mfma_f32_32x32x16_bf16(kf, Qf[s8], s, 0, 0, 0); }
                u32x2 vlo[4], vhi[4];
#pragma unroll
                for (int dt = 0; dt < 2; ++dt)
#pragma unroll
                    for (int s2 = 0; s2 < 2; ++s2) { const LAS unsigned char* vp = lds + R_VT + (32 * dt + c) * VT_PITCH + (32 * kt + 16 * s2 + 4 * h) * 2;
                        vlo[dt * 2 + s2] = *(const LAS u32x2*)vp; vhi[dt * 2 + s2] = *(const LAS u32x2*)(vp + 16); }
                __builtin_amdgcn_sched_barrier(0);
                const LAS float* tbp = tb + hd * TB_N + (kb * 128 + 32 * kt + 4 * h - 32 * qt - c + 160);
                float mx = -3.0e38f;
#pragma unroll
                for (int i = 0; i < 16; ++i) { s[i] += tbp[8 * (i >> 2) + (i & 3)]; mx = fmaxf(mx, s[i]); }
                mx = x32_max(mx);
                const float m_new = fmaxf(m_run, mx), alpha = __builtin_amdgcn_exp2f(m_run - m_new); m_run = m_new;
                float ls = 0.f;
#pragma unroll
                for (int i = 0; i < 16; ++i) { s[i] = __builtin_amdgcn_exp2f(s[i] - m_new); ls += s[i]; }
                l_run = l_run * alpha + ls;
                if (__builtin_amdgcn_ballot_w64(alpha != 1.0f) != 0ull) {
#pragma unroll
                    for (int dt = 0; dt < 4; ++dt)
#pragma unroll
                        for (int i = 0; i < 16; ++i) O[dt][i] *= alpha; }
                bf16x8 Pf[2];
#pragma unroll
                for (int s2 = 0; s2 < 2; ++s2) { u32x4 w; w.x = cvt_pk_bf16(s[8 * s2 + 0], s[8 * s2 + 1]); w.y = cvt_pk_bf16(s[8 * s2 + 2], s[8 * s2 + 3]);
                    w.z = cvt_pk_bf16(s[8 * s2 + 4], s[8 * s2 + 5]); w.w = cvt_pk_bf16(s[8 * s2 + 6], s[8 * s2 + 7]); Pf[s2] = __builtin_bit_cast(bf16x8, w); }
                __builtin_amdgcn_sched_barrier(0);
                u32x2 wlo[4], whi[4];
#pragma unroll
                for (int dt = 2; dt < 4; ++dt)
#pragma unroll
                    for (int s2 = 0; s2 < 2; ++s2) { const LAS unsigned char* vp = lds + R_VT + (32 * dt + c) * VT_PITCH + (32 * kt + 16 * s2 + 4 * h) * 2;
                        wlo[(dt - 2) * 2 + s2] = *(const LAS u32x2*)vp; whi[(dt - 2) * 2 + s2] = *(const LAS u32x2*)(vp + 16); }
#pragma unroll
                for (int dt = 0; dt < 2; ++dt)
#pragma unroll
                    for (int s2 = 0; s2 < 2; ++s2) { const u32x4 w = {vlo[dt * 2 + s2].x, vlo[dt * 2 + s2].y, vhi[dt * 2 + s2].x, vhi[dt * 2 + s2].y};
                        O[dt] = __builtin_amdgcn_mfma_f32_32x32x16_bf16(__builtin_bit_cast(bf16x8, w), Pf[s2], O[dt], 0, 0, 0); }
                __builtin_amdgcn_sched_barrier(0);
#pragma unroll
                for (int dt = 2; dt < 4; ++dt)
#pragma unroll
                    for (int s2 = 0; s2 < 2; ++s2) { const u32x4 w = {wlo[(dt - 2) * 2 + s2].x, wlo[(dt - 2) * 2 + s2].y, whi[(dt - 2) * 2 + s2].x, whi[(dt - 2) * 2 + s2].y};
                        O[dt] = __builtin_amdgcn_mfma_f32_32x32x16_bf16(__builtin_bit_cast(bf16x8, w), Pf[s2], O[dt], 0, 0, 0); }
                __builtin_amdgcn_sched_barrier(0);
            }
        }
        }
        {
            const float inv = __builtin_amdgcn_rcpf(x32_sum(l_run));
            u32x2 t2[4][4];
#pragma unroll
            for (int dt = 0; dt < 4; ++dt)
#pragma unroll
                for (int g4 = 0; g4 < 4; ++g4) { t2[dt][g4].x = cvt_pk_bf16(O[dt][4 * g4] * inv, O[dt][4 * g4 + 1] * inv); t2[dt][g4].y = cvt_pk_bf16(O[dt][4 * g4 + 2] * inv, O[dt][4 * g4 + 3] * inv); }
            bf16x8 Wf[8];
            { const bf16_t* wrow = (const bf16_t*)(a.ws + WS_WSB) + (size_t)(hd * 128 + 32 * qt + c) * 128 + 8 * h;
#pragma unroll
              for (int s8 = 0; s8 < 8; ++s8) { const u32x4 wv = *(const u32x4*)(wrow + 16 * s8);
                  const f32x4 r0 = *(const LAS f32x4*)(rstd_l + 16 * s8 + 8 * h), r1 = *(const LAS f32x4*)(rstd_l + 16 * s8 + 8 * h + 4);
                  u32x4 w; w.x = cvt_pk_bf16(bf_lo(wv.x) * r0[0], bf_hi(wv.x) * r0[1]); w.y = cvt_pk_bf16(bf_lo(wv.y) * r0[2], bf_hi(wv.y) * r0[3]);
                  w.z = cvt_pk_bf16(bf_lo(wv.z) * r1[0], bf_hi(wv.z) * r1[1]); w.w = cvt_pk_bf16(bf_lo(wv.w) * r1[2], bf_hi(wv.w) * r1[3]); Wf[s8] = __builtin_bit_cast(bf16x8, w); } }
            const float bsp = a.in[I_BS][hd * 128 + 32 * qt + c];
            u32x2 t1[4][4];
#pragma unroll
            for (int ct = 0; ct < 4; ++ct) { f32x16 acc;
#pragma unroll
                for (int i = 0; i < 16; ++i) acc[i] = 0.f;
#pragma unroll
                for (int s8 = 0; s8 < 8; ++s8) { const int grow = hsel * 128 + 32 * ct + c; const bf16x8 gf = *(const LAS bf16x8*)(lds + R_GV + grow * 256 + (((2 * s8 + h) ^ (grow & 15)) * 16));
                    acc = __builtin_amdgcn_mfma_f32_32x32x16_bf16(gf, Wf[s8], acc, 0, 0, 0); }
#pragma unroll
                for (int g4 = 0; g4 < 4; ++g4) { const f32x4 gn = *(const f32x4*)(a.in[I_SGUG] + hd * 128 + 32 * ct + 8 * g4 + 4 * h);
                    t1[ct][g4].x = cvt_pk_bf16(acc[4 * g4] * gn[0] + bsp, acc[4 * g4 + 1] * gn[1] + bsp); t1[ct][g4].y = cvt_pk_bf16(acc[4 * g4 + 2] * gn[2] + bsp, acc[4 * g4 + 3] * gn[3] + bsp); } }
            const int tl0 = lane >> 4, ch8 = lane & 15;
            const size_t gu0 = ((size_t)(tok0 + 32 * qt) * DM + hd * 128) * 2;
            __builtin_amdgcn_sched_barrier(0);
            u32x4 cu[4], cb[4];
#pragma unroll
            for (int k = 0; k < 4; ++k) { const size_t go = gu0 + (size_t)(4 * k) * DM * 2; cu[k] = ldg16((const char*)Ug + go, offC); cb[k] = ldg16((const char*)SBg + go, offC); }
            P2_BAR();
            LAS unsigned char* ex = lds + wave * EX_WAVE;
#pragma unroll
            for (int ct = 0; ct < 4; ++ct)
#pragma unroll
                for (int g4 = 0; g4 < 4; ++g4) { const int off = c * KT_PITCH + (32 * ct + 8 * g4 + 4 * h) * 2;
                    *(LAS u32x2*)(ex + off) = t1[ct][g4]; *(LAS u32x2*)(ex + EX_T2 + off) = t2[ct][g4]; }
            asm volatile("s_waitcnt lgkmcnt(0)" ::: "memory");
#pragma unroll
            for (int bt = 0; bt < 2; ++bt) {
                if (bt == 1) {
#pragma unroll
                    for (int k = 0; k < 4; ++k) { const size_t go = gu0 + (size_t)(16 + 4 * k) * DM * 2; cu[k] = ldg16((const char*)Ug + go, offC); cb[k] = ldg16((const char*)SBg + go, offC); } }
#pragma unroll
                for (int k = 0; k < 4; ++k) { const int tl = tl0 + 4 * k + 16 * bt;
                    const u32x4 xu = cu[k], xb = cb[k];
                    const u32x4 a1 = *(const LAS u32x4*)(ex + tl * KT_PITCH + ch8 * 16), a2 = *(const LAS u32x4*)(ex + EX_T2 + tl * KT_PITCH + ch8 * 16);
                    u32x4 o;
#pragma unroll
                    for (int e = 0; e < 4; ++e) {
                        const float lo = bf_lo(xu[e]) * bf_lo(a1[e]) + bf_lo(xb[e]) * bf_lo(a2[e]);
                        const float hi = bf_hi(xu[e]) * bf_hi(a1[e]) + bf_hi(xb[e]) * bf_hi(a2[e]);
                        o[e] = cvt_pk_bf16(lo, hi); }
                    *(u32x4*)((char*)Mout + gu0 + (size_t)(4 * k + 16 * bt) * DM * 2 + offC) = o; }
            }
        }
        }
    }
#undef P2_PREFETCH
#undef P2_UNIT
    __syncthreads();
}


#define XB_TMO      128
#define XB_XCNT(j)  (256  + 64 * (j))
#define XB_XSUB(j)  (1280 + 64 * (j))
#define XB_XGEN(j)  (2304 + 64 * (j))
#define XB_TOP      3328
#define XB_TOPGEN   3392
#define XCD_BAR_WORDS 3456
#define XB_SPIN_CAP (1u << 22)
__device__ __forceinline__ unsigned xb_ld(unsigned* p)              { return __hip_atomic_load(p, __ATOMIC_RELAXED, __HIP_MEMORY_SCOPE_AGENT); }
__device__ __forceinline__ unsigned xb_add(unsigned* p, unsigned v) { return __hip_atomic_fetch_add(p, v, __ATOMIC_RELAXED, __HIP_MEMORY_SCOPE_AGENT); }
__device__ __forceinline__ unsigned xb_xcc_id() { return (unsigned)__builtin_amdgcn_s_getreg((3 << 11) | 20) & 0xFu; }
#define XB_SPIN(cond, bar) do { unsigned _sp = 0; while (cond) { __builtin_amdgcn_s_sleep(1); \
    if ((++_sp & 255u) == 0u) { if (xb_ld(&(bar)[XB_TMO])) break; if (_sp > XB_SPIN_CAP) { atomicAdd(&(bar)[XB_TMO], 1u); break; } } } } while (0)
struct XcdBarrier { unsigned* bar; unsigned x; volatile LAS unsigned* st; };
__device__ __forceinline__ XcdBarrier xcd_barrier_post(unsigned* bar, volatile LAS unsigned* st) {
    XcdBarrier b; b.bar = bar; b.x = xb_xcc_id(); b.st = st;
    if (threadIdx.x == 0) (void)xb_add(&bar[XB_XCNT(b.x)], 1u);
    return b;
}
__device__ __forceinline__ void xcd_barrier_complete(unsigned* bar, unsigned x, unsigned& nloc, unsigned& nx) {
    const unsigned G = gridDim.x * gridDim.y * gridDim.z;
    unsigned sum, cnt, mine, sp = 0u;
    for (;;) {
        sum = 0u; cnt = 0u; mine = 0u;
#pragma unroll
        for (unsigned j = 0; j < 16; ++j) { const unsigned c = xb_ld(&bar[XB_XCNT(j)]); sum += c; cnt += (c > 0u) ? 1u : 0u; mine = (j == x) ? c : mine; }
        if (sum == G) break;
        __builtin_amdgcn_s_sleep(1);
        if ((++sp & 255u) == 0u) { if (xb_ld(&bar[XB_TMO])) break; if (sp > XB_SPIN_CAP) { atomicAdd(&bar[XB_TMO], 1u); break; } }
    }
    nloc = mine > 0u ? mine : 1u; nx = cnt > 0u ? cnt : 1u;
}
__device__ __forceinline__ void xcd_barrier(const XcdBarrier& b) {
    asm volatile("s_waitcnt vmcnt(0)" ::: "memory");
    __syncthreads();
    if (threadIdx.x == 0) {
        unsigned* bar = b.bar;
        __builtin_amdgcn_s_waitcnt(0);
        unsigned nloc = b.st[0], nx = b.st[1];
        if (nloc == 0u) { xcd_barrier_complete(bar, b.x, nloc, nx); b.st[0] = nloc; b.st[1] = nx; }
        const unsigned old = xb_add(&bar[XB_XSUB(b.x)], 1u);
        const unsigned gen = old / nloc;
        if (old + 1u == (gen + 1u) * nloc) {
            __builtin_amdgcn_fence(__ATOMIC_RELEASE, "agent");
            asm volatile("s_waitcnt vmcnt(0)" ::: "memory");
            const unsigned og = xb_add(&bar[XB_TOP], 1u);
            const unsigned tg = og / nx;
            if (og + 1u == (tg + 1u) * nx) xb_add(&bar[XB_TOPGEN], 1u);
            else XB_SPIN(xb_ld(&bar[XB_TOPGEN]) == tg, bar);
            __builtin_amdgcn_fence(__ATOMIC_ACQUIRE, "agent");
            xb_add(&bar[XB_XGEN(b.x)], 1u);
            asm volatile("s_waitcnt vmcnt(0)" ::: "memory");
        } else {
            XB_SPIN(xb_ld(&bar[XB_XGEN(b.x)]) == gen, bar);
            __builtin_amdgcn_fence(__ATOMIC_ACQUIRE, "agent");
            asm volatile("s_waitcnt vmcnt(0)" ::: "memory");
        }
    }
    __syncthreads();
}
__global__ void __launch_bounds__(512, 2) fwd_megakernel(Args a) {
    extern __shared__ __attribute__((aligned(16))) unsigned char shm[];
    LAS unsigned char* lds = (LAS unsigned char*)shm;
    const int tid = threadIdx.x, lane = tid & 63, wave = __builtin_amdgcn_readfirstlane(tid >> 6);
    const int G = gridDim.x, bx = blockIdx.x;
    const int vcu = (G % 8 == 0) ? (bx % 8) * (G / 8) + bx / 8 : bx;
    const int lo = a.ph_lo, hi = a.ph_hi;
#define IN(k) (lo <= (k) && (k) < hi)
#define SEAM(k) do { if (IN(k) && IN((k) + 1)) { xcd_barrier(gbar); } } while (0)
    volatile LAS unsigned* bst = (volatile LAS unsigned*)(lds + LDS_BYTES - 16);
    if (tid == 0) { bst[0] = 0u; bst[1] = 0u; }
    __syncthreads();
    XcdBarrier gbar; gbar.bar = (unsigned*)(a.ws + WS_BAR); gbar.x = 0; gbar.st = bst;
    if (hi - lo > 1) gbar = xcd_barrier_post((unsigned*)(a.ws + WS_BAR), bst);
    if (hi > 100) cg::this_grid().sync();
    if (IN(0)) for (int rep = (PROBE_DUP == 0 ? 0 : 1); rep < 2; ++rep) { p0_phase(lds, a, vcu, G, wave, lane); __syncthreads(); }
    SEAM(0);
    if (IN(1)) for (int rep = (PROBE_DUP == 1 ? 0 : 1); rep < 2; ++rep) {
        pg8::StaticOrder S; S.init(MTOK, NIN, G, bx);
        P1Ptrs P{(const bf16_t*)((unsigned char*)a.out + DO_H), (const bf16_t*)(a.ws + WS_WT)};
        EpiP1 E{a.ws, (unsigned char*)a.out};
        pg8::gemm_phase(lds, DM, S, P, E);
    }
    if (IN(2)) p2_build_bias_table(lds, a);
    SEAM(1);
    if (IN(2)) for (int rep = (PROBE_DUP == 2 ? 0 : 1); rep < 2; ++rep) p2_phase(lds, a, vcu, G, rep == 0 ? (bf16_t*)((unsigned char*)a.out + DO_H) : (bf16_t*)(a.ws + WS_U));
    SEAM(2);
    if (IN(3)) for (int rep = (PROBE_DUP == 3 ? 0 : 1); rep < 2; ++rep) {
        pg8::StaticOrder S; S.init(MTOK, DM, G, bx);
        pg8::PlainPtrs P{(const bf16_t*)(a.ws + WS_U), (const bf16_t*)(a.ws + WS_WOT), DM};
        EpiWo E{a.in[I_XP], a.in[I_XS], (bf16_t*)(a.ws + WS_Q), (float*)(a.ws + WS_PART)};
        pg8::gemm_phase(lds, DM, S, P, E);
    }
    SEAM(3);
    if (IN(4)) for (int rep = (PROBE_DUP == 4 ? 0 : 1); rep < 2; ++rep) {
        pg8::StaticOrder S; S.init(MTOK, DFF, G, bx);
        pg8::PlainPtrs P{(const bf16_t*)(a.ws + WS_Q), (const bf16_t*)(a.ws + WS_W1T), DM};
        EpiFF1 E{(bf16_t*)(a.ws + WS_HID)};
        pg8::gemm_phase(lds, DM, S, P, E);
    }
    if (IN(5)) {
        pg8::StaticOrder S5; S5.init(MTOK, DM, G, bx, 0);
        LAS float* tab = (LAS float*)(lds + R_FF2TAB);
        for (int i = 0; i < 8; ++i) { Unit u; if (!S5.next(i, u)) break;
            if (tid < 256) { const f32x4* pp = (const f32x4*)((const float*)(a.ws + WS_PART) + (size_t)(u.pm * 256 + tid) * 16); const f32x4 p0 = pp[0], p1 = pp[1], p2 = pp[2], p3 = pp[3];
                const float ss = ((p0[0] + p0[1]) + (p0[2] + p0[3])) + ((p1[0] + p1[1]) + (p1[2] + p1[3])) + ((p2[0] + p2[1]) + (p2[2] + p2[3])) + ((p3[0] + p3[1]) + (p3[2] + p3[3]));
                tab[i * 256 + tid] = __builtin_amdgcn_rcpf(ss * (1.0f / DM) + EPS); } }
        __syncthreads();
    }
    SEAM(4);
    if (IN(5)) for (int rep = (PROBE_DUP == 5 ? 0 : 1); rep < 2; ++rep) {
        pg8::StaticOrder S; S.init(MTOK, DM, G, bx, 0);
        pg8::PlainPtrs P{(const bf16_t*)(a.ws + WS_HID), (const bf16_t*)(a.ws + WS_W2T), DFF};
        LAS float* tab = (LAS float*)(lds + R_FF2TAB);
        EpiFF2 E{a.out, (const bf16_t*)(a.ws + WS_Q), tab};
        pg8::gemm_phase(lds, DFF, S, P, E);
    }
#undef IN
#undef SEAM
}

extern "C" void kernel_launch(void* const* d_in, const int* in_sizes, int n_in, void* d_out, int out_size, void* d_ws, size_t ws_size, hipStream_t stream) {
    static int grid = 0;
    if (grid == 0) {
        if (n_in != 15 || out_size != MTOK * DM || ws_size < WS_END) { fprintf(stderr, "kernel_launch: unexpected shapes (n_in %d out %d ws %zu)\n", n_in, out_size, ws_size); grid = -1; return; }
        int dev = 0, cus = 0, per_cu = 0;
        hipGetDevice(&dev); hipDeviceGetAttribute(&cus, hipDeviceAttributeMultiprocessorCount, dev);
        if (hipFuncSetAttribute((const void*)fwd_megakernel, hipFuncAttributeMaxDynamicSharedMemorySize, LDS_BYTES) != hipSuccess) { fprintf(stderr, "kernel_launch: hipFuncSetAttribute failed\n"); grid = -1; return; }
        hipOccupancyMaxActiveBlocksPerMultiprocessor(&per_cu, (const void*)fwd_megakernel, 512, LDS_BYTES);
        if (per_cu < 1) { fprintf(stderr, "kernel_launch: occupancy query says %d blocks/CU\n", per_cu); per_cu = 1; }
        (void)hipGetLastError();
        grid = cus * per_cu;
    }
    if (grid < 0) return;
    Args a{};
    for (int i = 0; i < 15; ++i) a.in[i] = (const float*)d_in[i];
    a.out = (float*)d_out; a.ws = (unsigned char*)d_ws;
    if (N_LAUNCHES == 1) {
        a.ph_lo = 0; a.ph_hi = 6;
        if (hipMemsetAsync((unsigned char*)d_ws + WS_BAR, 0, XCD_BAR_WORDS * 4, stream) != hipSuccess) fprintf(stderr, "kernel_launch: memset of the barrier words failed\n");
        void* args[] = {&a};
        hipError_t e = hipLaunchCooperativeKernel((const void*)fwd_megakernel, dim3(grid), dim3(512), args, LDS_BYTES, stream);
        if (e != hipSuccess) fprintf(stderr, "cooperative launch failed: %s (grid %d)\n", hipGetErrorString(e), grid);
    } else {
        for (int p = 0; p < 6; ++p) { a.ph_lo = p; a.ph_hi = p + 1; hipLaunchKernelGGL(fwd_megakernel, dim3(grid), dim3(512), LDS_BYTES, stream, a); }
    }
}
```
